# Optimizing an MI355X kernel written in HIP

```python
import jax, jax.numpy as jnp
from jax import lax
import numpy as np

D_MODEL = 1024
BATCH = 4
SEQ = 8192
DEPTH = 2

N_META = 16
A_HEADS = 8
HEAD_DIM = 64
A_WIDTH = A_HEADS * HEAD_DIM
KV_RANK = 256
IDX_HEADS = 4
IDX_DIM = 64
TOPK_MAX = 256
Q_BLOCK = 128
ROPE_THETA = 500000.0
ROT_DIM = HEAD_DIM // 4
B_HEADS = 8
B_HEAD_DIM = 64
B_WIDTH = B_HEADS * B_HEAD_DIM
DECAY_LORA = 64
AAA_LORA = 64
MV_LORA = 32
GATE_LORA = 160
GN_EPS = 64e-5
FFN_HIDDEN = 4 * D_MODEL
NORM_EPS = 1e-6
A_COLS = A_WIDTH + KV_RANK + IDX_HEADS * IDX_DIM + IDX_DIM + IDX_HEADS
B_COLS = 3 * B_WIDTH + DECAY_LORA + AAA_LORA + GATE_LORA
IN_COLS = A_COLS + B_COLS

kernel_name = "hymba_dsa_rwkv7_hybrid_trunk"


def _rmsnorm(x, g):
    x32 = x.astype(jnp.float32)
    y = x32 * lax.rsqrt(jnp.mean(x32 * x32, axis=-1, keepdims=True) + NORM_EPS) * g.astype(jnp.float32)
    return y.astype(x.dtype)


def _layernorm(x, g, b):
    x32 = x.astype(jnp.float32)
    mu = jnp.mean(x32, axis=-1, keepdims=True)
    var = jnp.mean(jnp.square(x32 - mu), axis=-1, keepdims=True)
    return (x32 - mu) * lax.rsqrt(var + NORM_EPS) * g + b


def _split(z, sizes):
    return jnp.split(z, np.cumsum(sizes)[:-1].tolist(), axis=-1)


def _partial_rope(t, cos, sin):
    shp = (t.shape[1],) + (1,) * (t.ndim - 3) + (ROT_DIM // 2,)
    c = cos.reshape(shp)
    s = sin.reshape(shp)
    t1 = t[..., : ROT_DIM // 2]
    t2 = t[..., ROT_DIM // 2: ROT_DIM]
    return jnp.concatenate([t1 * c - t2 * s, t2 * c + t1 * s, t[..., ROT_DIM:]], axis=-1)


def _dsa_attention(q, k, v, qi, ki, wi, topk):
    Bn, T, H, Dh = q.shape
    nblk = -(-T // Q_BLOCK)
    pad = nblk * Q_BLOCK - T
    padT = lambda a: jnp.pad(a, [(0, 0), (0, pad)] + [(0, 0)] * (a.ndim - 2))
    qp, qip, wip = padT(q), padT(qi), padT(wi)
    key_pos = jnp.arange(T)
    bidx = jnp.arange(Bn)[:, None, None]
    scale = Dh ** -0.5
    neg = jnp.finfo(jnp.float32).min

    def block(i):
        start = i * Q_BLOCK
        qb = lax.dynamic_slice_in_dim(qp, start, Q_BLOCK, axis=1)
        qib = lax.dynamic_slice_in_dim(qip, start, Q_BLOCK, axis=1)
        wib = lax.dynamic_slice_in_dim(wip, start, Q_BLOCK, axis=1)
        qpos = start + jnp.arange(Q_BLOCK)
        causal = key_pos[None, :] <= qpos[:, None]
        logits = jnp.einsum('bqhd,bsd->bqhs', qib, ki)
        score = jnp.einsum('bqh,bqhs->bqs', wib, jax.nn.relu(logits))
        score = jnp.where(causal[None], score, -jnp.inf)
        _, idx = lax.top_k(score, topk)
        valid = idx <= qpos[None, :, None]
        ks = k[bidx, idx]
        vs = v[bidx, idx]
        s = jnp.einsum('bqhd,bqkd->bqhk', qb, ks) * scale
        s = jnp.where(valid[:, :, None, :], s, neg)
        p = jax.nn.softmax(s, axis=-1)
        return jnp.einsum('bqhk,bqkd->bqhd', p, vs)

    out = lax.map(block, jnp.arange(nblk))
    return jnp.moveaxis(out, 0, 1).reshape(Bn, nblk * Q_BLOCK, H, Dh)[:, :T]


def _rwkv7_scan(r, decay, k, v, kk, b):
    Bn, T, H, N = r.shape
    xs = tuple(jnp.moveaxis(t, 1, 0) for t in (r, decay, k, v, kk, b))

    def step(S, inp):
        r_t, w_t, k_t, v_t, kk_t, b_t = inp
        sa = jnp.einsum('bhij,bhj->bhi', S, kk_t)
        S = S * w_t[:, :, None, :] - sa[..., None] * b_t[:, :, None, :] + v_t[..., None] * k_t[:, :, None, :]
        y = jnp.einsum('bhij,bhj->bhi', S, r_t)
        return S, y

    S0 = jnp.zeros((Bn, H, N, N), jnp.float32)
    _, y = lax.scan(step, S0, xs)
    return jnp.moveaxis(y, 0, 1)


def _mixer(u, w_in_l, mu_l, kv_norm, w_uk, w_uv, idx_g, idx_b, w0, w2, a0, a2, g2,
           k_k, k_a, r_k, ln_w, ln_b, w_o, v_first, vmix, cos, sin, topk):
    Bn, T, _ = u.shape
    z = (u @ w_in_l).astype(jnp.float32)
    zA, zB = z[..., :A_COLS], z[..., A_COLS:]

    q, ckv, qi, ki, wi = _split(zA, [A_WIDTH, KV_RANK, IDX_HEADS * IDX_DIM, IDX_DIM, IDX_HEADS])
    q = _partial_rope(q.reshape(Bn, T, A_HEADS, HEAD_DIM), cos, sin)
    c = _rmsnorm(ckv, kv_norm)
    k_att = _partial_rope(c @ w_uk, cos, sin)
    v_att = c @ w_uv
    qi = _partial_rope(qi.reshape(Bn, T, IDX_HEADS, IDX_DIM), cos, sin)
    ki = _partial_rope(_layernorm(ki, idx_g, idx_b), cos, sin)
    wi = wi * (IDX_HEADS ** -0.5 * IDX_DIM ** -0.5)
    attn = _dsa_attention(q, k_att, v_att, qi, ki, wi, topk).reshape(Bn, T, A_WIDTH)

    zB_prev = jnp.pad(zB, ((0, 0), (1, 0), (0, 0)))[:, :T]
    zB = zB + (zB_prev - zB) * mu_l
    sizes = [B_WIDTH] * 3 + [DECAY_LORA, AAA_LORA, GATE_LORA] + ([MV_LORA] if vmix is not None else [])
    parts = _split(zB, sizes)
    r, k, v, xw, xa, xg = parts[:6]
    w = -jax.nn.softplus(-(w0 + jnp.tanh(xw) @ w2)) - 0.5
    decay = jnp.exp(-jnp.exp(w))
    a = jax.nn.sigmoid(a0 + xa @ a2)
    g = jax.nn.sigmoid(xg) @ g2
    if vmix is None:
        v_first = v
    else:
        v0, v2 = vmix
        v = v + (v_first - v) * jax.nn.sigmoid(v0 + parts[6] @ v2)
    hd = lambda t: t.reshape(Bn, T, B_HEADS, B_HEAD_DIM)
    kk = hd(k * k_k)
    kk = kk / jnp.maximum(jnp.linalg.norm(kk, axis=-1, keepdims=True), 1e-12)
    k = k * (1.0 + (a - 1.0) * k_a)
    rh, kh, vh = hd(r), hd(k), hd(v)
    y = _rwkv7_scan(rh, hd(decay), kh, vh, kk, kk * hd(a))
    mean = jnp.mean(y, axis=-1, keepdims=True)
    var = jnp.mean(jnp.square(y - mean), axis=-1, keepdims=True)
    y = ((y - mean) * lax.rsqrt(var + GN_EPS)).reshape(Bn, T, B_WIDTH) * ln_w + ln_b
    bonus = jnp.sum(rh * kh * r_k.reshape(B_HEADS, B_HEAD_DIM), axis=-1, keepdims=True) * vh
    y = (y + bonus.reshape(Bn, T, B_WIDTH)) * g

    out = jnp.concatenate([attn, y], axis=-1) @ w_o
    return out.astype(u.dtype), v_first


def setup_inputs(seed: int = 0) -> dict:
    key = jax.random.key(seed)
    ks = iter(jax.random.split(key, 40))
    nrm = lambda shape, scale: jax.random.normal(next(ks), shape, jnp.float32) * scale
    uni = lambda shape, lo, hi: jax.random.uniform(next(ks), shape, jnp.float32, lo, hi)
    gain = lambda shape: 1.0 + nrm(shape, 0.02)
    L1 = DEPTH - 1
    return {
        "x": nrm((BATCH, SEQ, D_MODEL), 1.0),
        "meta_tokens": nrm((N_META, D_MODEL), 1.0),
        "norm_mix_pre": gain((DEPTH, D_MODEL)),
        "norm_mix_post": gain((DEPTH, D_MODEL)),
        "norm_ffn_pre": gain((DEPTH, D_MODEL)),
        "norm_ffn_post": gain((DEPTH, D_MODEL)),
        "w_in": nrm((DEPTH, D_MODEL, IN_COLS), D_MODEL ** -0.5),
        "mu_shift": uni((DEPTH, B_COLS), 0.0, 1.0),
        "kv_norm": gain((DEPTH, KV_RANK)),
        "w_uk": nrm((DEPTH, KV_RANK, HEAD_DIM), KV_RANK ** -0.5),
        "w_uv": nrm((DEPTH, KV_RANK, HEAD_DIM), KV_RANK ** -0.5),
        "idx_k_norm_g": gain((DEPTH, IDX_DIM)),
        "idx_k_norm_b": nrm((DEPTH, IDX_DIM), 0.02),
        "time_w0": uni((DEPTH, B_WIDTH), -6.0, -1.0),
        "time_w2": nrm((DEPTH, DECAY_LORA, B_WIDTH), 0.5 * DECAY_LORA ** -0.5),
        "time_a0": nrm((DEPTH, B_WIDTH), 0.1),
        "time_a2": nrm((DEPTH, AAA_LORA, B_WIDTH), AAA_LORA ** -0.5),
        "time_g2": nrm((DEPTH, GATE_LORA, B_WIDTH), GATE_LORA ** -0.5),
        "time_k_k": 0.85 + nrm((DEPTH, B_WIDTH), 0.02),
        "time_k_a": 1.0 + nrm((DEPTH, B_WIDTH), 0.02),
        "time_r_k": nrm((DEPTH, B_WIDTH), 0.1),
        "ln_x_w": gain((DEPTH, B_WIDTH)),
        "ln_x_b": nrm((DEPTH, B_WIDTH), 0.02),
        "w_in_vmix": nrm((L1, D_MODEL, MV_LORA), D_MODEL ** -0.5),
        "mu_vmix": uni((L1, MV_LORA), 0.0, 1.0),
        "time_v0": nrm((L1, B_WIDTH), 0.1),
        "time_v2": nrm((L1, MV_LORA, B_WIDTH), MV_LORA ** -0.5),
        "w_o": nrm((DEPTH, A_WIDTH + B_WIDTH, D_MODEL), (A_WIDTH + B_WIDTH) ** -0.5),
        "w_up": nrm((DEPTH, D_MODEL, FFN_HIDDEN), D_MODEL ** -0.5),
        "w_down": nrm((DEPTH, FFN_HIDDEN, D_MODEL), FFN_HIDDEN ** -0.5),
    }


def reference(x, meta_tokens, norm_mix_pre, norm_mix_post, norm_ffn_pre, norm_ffn_post,
              w_in, mu_shift, kv_norm, w_uk, w_uv, idx_k_norm_g, idx_k_norm_b,
              time_w0, time_w2, time_a0, time_a2, time_g2, time_k_k, time_k_a, time_r_k,
              ln_x_w, ln_x_b, w_in_vmix, mu_vmix, time_v0, time_v2, w_o, w_up, w_down):
    f32 = jnp.float32
    Bn = x.shape[0]
    topk = min(TOPK_MAX, x.shape[1] // 4)
    meta = jnp.broadcast_to(meta_tokens[None].astype(x.dtype), (Bn, N_META, D_MODEL))
    h = jnp.concatenate([meta, x], axis=1)
    T = h.shape[1]
    pos = jnp.arange(T, dtype=f32)
    inv_freq = ROPE_THETA ** (-jnp.arange(0, ROT_DIM, 2, dtype=f32) / ROT_DIM)
    ang = pos[:, None] * inv_freq[None, :]
    cos, sin = jnp.cos(ang), jnp.sin(ang)

    v_first = None
    for l in range(DEPTH):
        if l == 0:
            w_in_l, mu_l, vmix = w_in[0], mu_shift[0], None
        else:
            w_in_l = jnp.concatenate([w_in[l], w_in_vmix[l - 1]], axis=1)
            mu_l = jnp.concatenate([mu_shift[l], mu_vmix[l - 1]], axis=0)
            vmix = (time_v0[l - 1], time_v2[l - 1])
        u = _rmsnorm(h, norm_mix_pre[l])
        mix, v_first = _mixer(u, w_in_l, mu_l, kv_norm[l], w_uk[l], w_uv[l],
                              idx_k_norm_g[l], idx_k_norm_b[l], time_w0[l], time_w2[l],
                              time_a0[l], time_a2[l], time_g2[l], time_k_k[l], time_k_a[l],
                              time_r_k[l], ln_x_w[l], ln_x_b[l], w_o[l], v_first, vmix,
                              cos, sin, topk)
        h = h + _rmsnorm(mix, norm_mix_post[l]).astype(h.dtype)
        u = _rmsnorm(h, norm_ffn_pre[l])
        f = jnp.square(jax.nn.relu(u @ w_up[l])) @ w_down[l]
        h = h + _rmsnorm(f, norm_ffn_post[l]).astype(h.dtype)
    return h[:, N_META:].astype(x.dtype)
```

```cpp
#include <hip/hip_runtime.h>
#include <hip/hip_cooperative_groups.h>
#include <cstdio>
#include <cstdint>
namespace cg = cooperative_groups;
namespace pg8 {
#define PG8_LAS __attribute__((address_space(3)))
typedef unsigned short bf16_t;
typedef short bf16x8 __attribute__((ext_vector_type(8)));
typedef float f32x4 __attribute__((ext_vector_type(4)));
typedef unsigned u32x4 __attribute__((ext_vector_type(4)));
typedef int i32x8 __attribute__((ext_vector_type(8)));
typedef int i32x4 __attribute__((ext_vector_type(4)));
constexpr int BM = 256, BK = 64, HALF = 128, HTB = HALF * BK * 2  , STAGE_BYTES = 8 * HTB, NXCD = 8, WGM = 8;

__host__ __device__ __forceinline__ int lds_byte(int r, int c) { const int st = (r >> 4) * 2 + (c >> 5), rr = r & 15, cc = c & 31, ob = rr * 64 + cc * 2; return st * 1024 + (ob ^ (((ob >> 9) & 1) << 5)); }
__host__ __device__ __forceinline__ void stage_rc(int b, int& R, int& C) { const int st = b / 1024, sb = b % 1024, swz = sb ^ (((sb >> 9) & 1) << 5); R = (st >> 1) * 16 + swz / 64; C = (st & 1) * 32 + (swz % 64) / 2; }
__host__ __device__ __forceinline__ int perm32(int rho) { const int n = rho >> 4, i = rho & 15; return 8 * (i >> 2) + 4 * n + (i & 3); }

struct Unit { int pm, pn; };
struct Gemm { const bf16_t* A; const bf16_t* Bt; int M, N, K; };

struct StaticOrder {
    int nM, nN, nwg, G, c;
    __host__ __device__ void init(int M, int N, int G_, int c_) { nM = M / BM; nN = N / BM; nwg = nM * nN; G = G_; c = c_; }
    __host__ __device__ bool next(int i, Unit& u) const {
        const long L = (long)i * G + c; if (L >= nwg) return false;
        int wgid = (int)L; { const int q = nwg / NXCD, r = nwg % NXCD, xcd = wgid % NXCD, off = wgid / NXCD; wgid = (xcd < r ? xcd * (q + 1) : r * (q + 1) + (xcd - r) * q) + off; }
        const int nig = WGM * nN, gid = wgid / nig, fm = gid * WGM, gsz = (nM - fm) < WGM ? (nM - fm) : WGM;
        u.pm = fm + ((wgid % nig) % gsz); u.pn = (wgid % nig) / gsz; return true;
    }
    __device__ __forceinline__ void a_ready(const Unit&) const {}
    __device__ __forceinline__ void done(const Unit&) const {}
};

__device__ __forceinline__ unsigned cvt_pk_bf16(float lo, float hi) { unsigned r; asm volatile("v_cvt_pk_bf16_f32 %0, %1, %2" : "=v"(r) : "v"(lo), "v"(hi)); return r; }
typedef float f32x2 __attribute__((ext_vector_type(2)));
template <int ACT> struct EpiBf16 {
    static constexpr bool PERM = true, AFTER_DRAIN = false;
    bf16_t* O; int ldc;
    __device__ __forceinline__ void operator()(const f32x4 (&acc)[2][2][4][2], const Unit& u, int wr, int wc, int fr, int fq) const {
        const int row0 = u.pm * BM + wr * 64 + fr; const int col0 = u.pn * BM + wc * 32 + 8 * fq;
#pragma unroll
        for (int ai = 0; ai < 2; ++ai)
#pragma unroll
            for (int m = 0; m < 4; ++m) { bf16_t* rowp = O + (size_t)(row0 + ai * HALF + m * 16) * ldc + col0;
#pragma unroll
                for (int bj = 0; bj < 2; ++bj) { f32x4 v0 = acc[ai][bj][m][0], v1 = acc[ai][bj][m][1];
                    if (ACT == 2) {
#pragma unroll
                        for (int e = 0; e < 4; ++e) { float a = fmaxf(v0[e], 0.f), b = fmaxf(v1[e], 0.f); v0[e] = a * a; v1[e] = b * b; } }
                    u32x4 w; w.x = cvt_pk_bf16(v0[0], v0[1]); w.y = cvt_pk_bf16(v0[2], v0[3]); w.z = cvt_pk_bf16(v1[0], v1[1]); w.w = cvt_pk_bf16(v1[2], v1[3]);
                    *(u32x4*)(rowp + bj * HALF) = w; } }
    }
};
typedef unsigned u32x2 __attribute__((ext_vector_type(2)));
template <int ACT> struct EpiFp8 {
    static constexpr bool PERM = true, AFTER_DRAIN = false;
    unsigned char* O; int ldc; float mul;
    __device__ __forceinline__ void operator()(const f32x4 (&acc)[2][2][4][2], const Unit& u, int wr, int wc, int fr, int fq) const {
        const int row0 = u.pm * BM + wr * 64 + fr; const int col0 = u.pn * BM + wc * 32 + 8 * fq;
#pragma unroll
        for (int ai = 0; ai < 2; ++ai)
#pragma unroll
            for (int m = 0; m < 4; ++m) { unsigned char* rowp = O + (size_t)(row0 + ai * HALF + m * 16) * ldc + col0;
#pragma unroll
                for (int bj = 0; bj < 2; ++bj) { f32x4 v0 = acc[ai][bj][m][0], v1 = acc[ai][bj][m][1];
#pragma unroll
                    for (int e = 0; e < 4; ++e) {
                        if (ACT == 2) { float a = fmaxf(v0[e], 0.f), b = fmaxf(v1[e], 0.f); v0[e] = fminf(a * a * mul, 448.f); v1[e] = fminf(b * b * mul, 448.f); }
                        else { v0[e] = __builtin_amdgcn_fmed3f(v0[e] * mul, -448.f, 448.f); v1[e] = __builtin_amdgcn_fmed3f(v1[e] * mul, -448.f, 448.f); } }
                    int lo = __builtin_amdgcn_cvt_pk_fp8_f32(v0[0], v0[1], 0, false); lo = __builtin_amdgcn_cvt_pk_fp8_f32(v0[2], v0[3], lo, true);
                    int hi = __builtin_amdgcn_cvt_pk_fp8_f32(v1[0], v1[1], 0, false); hi = __builtin_amdgcn_cvt_pk_fp8_f32(v1[2], v1[3], hi, true);
                    *(u32x2*)(rowp + bj * HALF) = (u32x2){(unsigned)lo, (unsigned)hi}; } }
    }
};
template <class Epi, class Sched, bool ALIGN_EPI = false, bool SP2 = false, bool FP8 = false, int SCW = 0x7f7f7f7f, int SCA = 0x7f7f7f7f>
__device__ __forceinline__ void gemm_phase(PG8_LAS unsigned char* lds, const Gemm g, const Sched& S, const Epi& E, const int tid_in) {
    int tid_l_ = tid_in; asm volatile("" : "+v"(tid_l_));
    const int tid = tid_l_, wid = __builtin_amdgcn_readfirstlane(tid >> 6), lane = tid & 63, wr = wid >> 2, wc = wid & 3, fr = lane & 15, fq = lane >> 4;
    const int K = g.K, nt = K / BK;
    unsigned voffA[2], voffB[2];
#pragma unroll
    for (int i = 0; i < 2; ++i) { int R, C; stage_rc(tid * 16 + i * 8192, R, C); const int Rb = Epi::PERM ? ((R & ~31) + perm32(R & 31)) : R;
        voffA[i] = (unsigned)(R * K + C) * 2u; voffB[i] = (unsigned)(Rb * K + C) * 2u; }
    const size_t kstep = (size_t)(BK * 2);
    const size_t hstep = (size_t)HALF * K * 2;
    const size_t tstep = 2 * hstep;
    const unsigned ldsw = (unsigned)wid * 1024u;
    const int aoff = lds_byte(wr * 64 + fr, fq * 8), boff = lds_byte(wc * 32 + fr, fq * 8);
#define PG8_SA(b, h) (((b) * 2 + (h)) * HTB)
#define PG8_SB(b, h) ((4 + (b) * 2 + (h)) * HTB)
#define PG8_STAGE(bufoff, gbase, voff) do { _Pragma("unroll") for (int _i = 0; _i < 2; ++_i) \
        __builtin_amdgcn_global_load_lds((const unsigned*)((const char*)(gbase) + (voff)[_i]), (PG8_LAS unsigned*)(lds + (bufoff) + ldsw + _i * 8192), 16, 0, 0); } while (0)
#define PG8_LD8(off) __builtin_shufflevector(*(const PG8_LAS i32x4*)(lds + (off)), *(const PG8_LAS i32x4*)(lds + (off) + 1024), 0, 1, 2, 3, 4, 5, 6, 7)
#define PG8_LDA(dst, b, h) do { if constexpr (FP8) { _Pragma("unroll") for (int m = 0; m < 4; ++m) dst##8[m] = PG8_LD8(PG8_SA(b, h) + aoff + m * 2048); } else { \
        _Pragma("unroll") for (int m = 0; m < 4; ++m) _Pragma("unroll") for (int k = 0; k < 2; ++k) dst[m][k] = *(const PG8_LAS bf16x8*)(lds + PG8_SA(b, h) + aoff + m * 2048 + k * 1024); } } while (0)
#define PG8_LDB(dst, b, h) do { if constexpr (FP8) { _Pragma("unroll") for (int n = 0; n < 2; ++n) dst##8[n] = PG8_LD8(PG8_SB(b, h) + boff + n * 2048); } else { \
        _Pragma("unroll") for (int n = 0; n < 2; ++n) _Pragma("unroll") for (int k = 0; k < 2; ++k) dst[n][k] = *(const PG8_LAS bf16x8*)(lds + PG8_SB(b, h) + boff + n * 2048 + k * 1024); } } while (0)
#define PG8_MMA(ai, bj, At, Bt) do { __builtin_amdgcn_s_setprio(1); if constexpr (FP8) { _Pragma("unroll") for (int m = 0; m < 4; ++m) _Pragma("unroll") for (int n = 0; n < 2; ++n) \
        asm volatile("v_mfma_scale_f32_16x16x128_f8f6f4 %0, %1, %2, %0, %3, %4 op_sel_hi:[0,0,0]" : "+v"(acc[ai][bj][m][n]) : "v"(Bt##8[n]), "v"(At##8[m]), "v"(scw_), "v"(sca_)); } else { \
        _Pragma("unroll") for (int m = 0; m < 4; ++m) _Pragma("unroll") for (int n = 0; n < 2; ++n) _Pragma("unroll") for (int k = 0; k < 2; ++k) \
        acc[ai][bj][m][n] = __builtin_amdgcn_mfma_f32_16x16x32_bf16(Bt[n][k], At[m][k], acc[ai][bj][m][n], 0, 0, 0); } __builtin_amdgcn_s_setprio(0); } while (0)
#define PG8_WAIT_V(n) asm volatile("s_waitcnt vmcnt(" #n ")" ::: "memory")
#define PG8_WAIT_L(n) asm volatile("s_waitcnt lgkmcnt(" #n ")" ::: "memory")
#define PG8_BAR __builtin_amdgcn_s_barrier()
#define PG8_SCHED __builtin_amdgcn_sched_barrier(0)
    Unit cur, nxt; int ui = 0;
    if (!S.next(0, cur)) return;
    f32x4 acc[2][2][4][2];
#pragma unroll
    for (int a = 0; a < 2; ++a)
#pragma unroll
        for (int b = 0; b < 2; ++b)
#pragma unroll
            for (int m = 0; m < 4; ++m)
#pragma unroll
                for (int n = 0; n < 2; ++n) acc[a][b][m][n] = (f32x4){0.f, 0.f, 0.f, 0.f};
    int scw_ = SCW, sca_ = SCA; asm volatile("" : "+v"(scw_), "+v"(sca_));
    bf16x8 At[4][2], B0[2][2], B1[2][2]; i32x8 At8[4], B08[2], B18[2];
    const char* cA = (const char*)g.A + (size_t)cur.pm * tstep; const char* cB = (const char*)g.Bt + (size_t)cur.pn * tstep;
    S.a_ready(cur);
    if constexpr (SP2) {
        PG8_STAGE(PG8_SB(0, 0), cB, voffB); PG8_STAGE(PG8_SB(0, 1), cB + hstep, voffB); PG8_STAGE(PG8_SA(0, 0), cA, voffA); PG8_STAGE(PG8_SA(0, 1), cA + hstep, voffA);
        if (wr == 1) PG8_BAR;
        PG8_WAIT_V(2); PG8_BAR;
        PG8_STAGE(PG8_SB(1, 0), cB + kstep, voffB); PG8_STAGE(PG8_SA(1, 0), cA + kstep, voffA); PG8_STAGE(PG8_SB(1, 1), cB + hstep + kstep, voffB);
        PG8_WAIT_V(6); PG8_BAR;
    } else {
        PG8_STAGE(PG8_SB(0, 0), cB, voffB); PG8_STAGE(PG8_SA(0, 0), cA, voffA); PG8_STAGE(PG8_SB(0, 1), cB + hstep, voffB); PG8_STAGE(PG8_SA(0, 1), cA + hstep, voffA);
        if (wr == 1) PG8_BAR;
        PG8_WAIT_V(4); PG8_BAR;
        PG8_STAGE(PG8_SB(1, 0), cB + kstep, voffB); PG8_STAGE(PG8_SA(1, 0), cA + kstep, voffA); PG8_STAGE(PG8_SB(1, 1), cB + hstep + kstep, voffB);
        PG8_WAIT_V(6); PG8_BAR;
    }
    for (;;) {
        const bool has_next = S.next(ui + 1, nxt);
        const char* nA = has_next ? (const char*)g.A + (size_t)nxt.pm * tstep : cA; const char* nB = has_next ? (const char*)g.Bt + (size_t)nxt.pn * tstep : cB;
        for (int t = 0; t < nt; t += 2) {
            const bool last = (t == nt - 2);
            const char* a1 = cA + (size_t)(t + 1) * kstep;
            const char* a2 = last ? nA : cA + (size_t)(t + 2) * kstep; const char* b2 = last ? nB : cB + (size_t)(t + 2) * kstep;
            const char* a3 = a2 + kstep; const char* b3 = b2 + kstep;
            if (last && has_next) S.a_ready(nxt);
            if constexpr (SP2) {
            PG8_LDB(B0, 0, 0); PG8_LDB(B1, 0, 1); PG8_SCHED; PG8_LDA(At, 0, 0); PG8_STAGE(PG8_SA(1, 1), a1 + hstep, voffA);
            PG8_WAIT_V(8); PG8_WAIT_L(0); PG8_BAR; PG8_MMA(0, 0, At, B0); PG8_MMA(0, 1, At, B1); PG8_BAR; PG8_SCHED;
            PG8_LDA(At, 0, 1); PG8_STAGE(PG8_SB(0, 0), b2, voffB); PG8_STAGE(PG8_SB(0, 1), b2 + hstep, voffB); PG8_STAGE(PG8_SA(0, 0), a2, voffA);
            PG8_WAIT_V(8); PG8_WAIT_L(0); PG8_BAR; PG8_MMA(1, 0, At, B0); PG8_MMA(1, 1, At, B1); PG8_BAR; PG8_SCHED;
            PG8_LDB(B0, 1, 0); PG8_LDB(B1, 1, 1); PG8_SCHED; PG8_LDA(At, 1, 0); PG8_STAGE(PG8_SA(0, 1), a2 + hstep, voffA);
            PG8_WAIT_V(8); PG8_WAIT_L(0); PG8_BAR; PG8_MMA(0, 0, At, B0); PG8_MMA(0, 1, At, B1); PG8_BAR; PG8_SCHED;
            PG8_LDA(At, 1, 1); PG8_STAGE(PG8_SB(1, 0), b3, voffB); PG8_STAGE(PG8_SB(1, 1), b3 + hstep, voffB); PG8_STAGE(PG8_SA(1, 0), a3, voffA);
            PG8_WAIT_V(8); PG8_WAIT_L(0); PG8_BAR; PG8_MMA(1, 0, At, B0); PG8_MMA(1, 1, At, B1); PG8_BAR; PG8_SCHED;
            } else {
            PG8_LDB(B0, 0, 0); PG8_SCHED; PG8_LDA(At, 0, 0); PG8_STAGE(PG8_SA(1, 1), a1 + hstep, voffA);
            PG8_WAIT_L(8); PG8_BAR; PG8_WAIT_L(0); PG8_MMA(0, 0, At, B0); PG8_BAR; PG8_SCHED;
            PG8_LDB(B1, 0, 1); PG8_STAGE(PG8_SB(0, 0), b2, voffB);
            PG8_BAR; PG8_WAIT_L(0); PG8_MMA(0, 1, At, B1); PG8_BAR;
            PG8_LDA(At, 0, 1); PG8_STAGE(PG8_SA(0, 0), a2, voffA);
            PG8_BAR; PG8_WAIT_L(0); PG8_MMA(1, 0, At, B0); PG8_BAR; PG8_SCHED;
            PG8_STAGE(PG8_SB(0, 1), b2 + hstep, voffB);
            PG8_WAIT_V(6); PG8_BAR; PG8_MMA(1, 1, At, B1); PG8_BAR;
            PG8_LDB(B0, 1, 0); PG8_SCHED; PG8_LDA(At, 1, 0); PG8_STAGE(PG8_SA(0, 1), a2 + hstep, voffA);
            PG8_WAIT_L(8); PG8_BAR; PG8_WAIT_L(0); PG8_MMA(0, 0, At, B0); PG8_BAR; PG8_SCHED;
            PG8_LDB(B1, 1, 1); PG8_STAGE(PG8_SB(1, 0), b3, voffB);
            PG8_BAR; PG8_WAIT_L(0); PG8_MMA(0, 1, At, B1); PG8_BAR;
            PG8_LDA(At, 1, 1); PG8_STAGE(PG8_SA(1, 0), a3, voffA);
            PG8_BAR; PG8_WAIT_L(0); PG8_MMA(1, 0, At, B0); PG8_BAR; PG8_SCHED;
            PG8_STAGE(PG8_SB(1, 1), b3 + hstep, voffB);
            PG8_WAIT_V(6); PG8_BAR; PG8_MMA(1, 1, At, B1); PG8_BAR;
            }
        }
        if constexpr (FP8) asm volatile("s_nop 15\n\ts_nop 15" ::: "memory");
        if constexpr (ALIGN_EPI) { if (wr == 0) PG8_BAR; }
        if constexpr (!Epi::AFTER_DRAIN) { E(acc, cur, wr, wc, fr, fq); S.done(cur); }
        if (!has_next) break;
#pragma unroll
        for (int a = 0; a < 2; ++a)
#pragma unroll
            for (int b = 0; b < 2; ++b)
#pragma unroll
                for (int m = 0; m < 4; ++m)
#pragma unroll
                    for (int n = 0; n < 2; ++n) acc[a][b][m][n] = (f32x4){0.f, 0.f, 0.f, 0.f};
        cur = nxt; cA = nA; cB = nB; ++ui;
        if constexpr (ALIGN_EPI) { if (wr == 1) PG8_BAR; }
    }
    PG8_WAIT_V(0);
    if constexpr (!ALIGN_EPI) { if (wr == 0) PG8_BAR; }
    PG8_BAR;
    if constexpr (Epi::AFTER_DRAIN) { E.fused(acc, cur, wr, wc, fr, fq, lds, wid, lane); S.done(cur); }
#undef PG8_SA
#undef PG8_SB
#undef PG8_STAGE
#undef PG8_LDA
#undef PG8_LDB
#undef PG8_MMA
#undef PG8_LD8
#undef PG8_WAIT_V
#undef PG8_WAIT_L
#undef PG8_BAR
#undef PG8_SCHED
}
}

#ifndef PROBE
#define PROBE 0
#endif
#define LAS __attribute__((address_space(3)))
typedef unsigned short bf16;
typedef unsigned short u16;
typedef _Float16 h2v __attribute__((ext_vector_type(2)));
typedef short s2v __attribute__((ext_vector_type(2)));
typedef unsigned v4u __attribute__((ext_vector_type(4)));
typedef unsigned v2u __attribute__((ext_vector_type(2)));
typedef float f32x4 __attribute__((ext_vector_type(4)));
typedef float f32x16 __attribute__((ext_vector_type(16)));
typedef short bf16x8 __attribute__((ext_vector_type(8)));

constexpr int NB = 4, SEQ = 8192, NMETA = 16, TT = 8208, DM = 1024, NL = 2;
constexpr int MAINR = 32768, RREAL = 32784, RPAD = 33024;
constexpr int ZC = 3072, LC = 2048, FF = 4096;
constexpr int C_Q = 0, C_CKV = 512, C_QI = 768, C_KI = 1024, C_WI = 1088, C_R = 1152, C_K = 1664, C_V = 2176, C_XW = 2688, C_XA = 2752, C_XG = 2816, C_XV = 2976;
constexpr int TPAD = 8320;
constexpr float NORM_EPS = 1e-6f, GN_EPS = 64e-5f;
constexpr int NT = 512, NWAVES = 8;
constexpr int LDS_BYTES = 155648;

constexpr size_t MiB = 1u << 20;
constexpr size_t WS_CTL = 0, CTL_BYTES = 65536;
constexpr size_t WS_ROPE = 1 * MiB;
constexpr size_t WS_HX = 2 * MiB;
constexpr size_t WS_WIN = 4 * MiB, WS_WO = 16 * MiB, WS_WUP = 20 * MiB, WS_WDN = 36 * MiB;
constexpr size_t WS_KATT = 52 * MiB, WS_VATT = 57 * MiB, WS_KI = 62 * MiB;
constexpr size_t WS_VF = 67 * MiB;
constexpr size_t WS_U = 100 * MiB;
constexpr size_t WS_Z = 165 * MiB;
constexpr size_t WS_L = WS_Z + (size_t)RPAD * ZC * 2;
constexpr size_t WS_HID = WS_Z;
constexpr size_t WS_TMP2 = WS_HID + (size_t)RPAD * FF * 2;
constexpr size_t WS_HMID = WS_HID + (size_t)RPAD * FF;
static_assert(WS_HMID + (size_t)MAINR * DM * 2 <= WS_TMP2 && WS_HMID >= WS_Z + (size_t)RPAD * DM * 2, "ws map");
constexpr size_t WS_ACT = WS_L + (size_t)RPAD * LC * 2;
constexpr int ACTC = 320, OPSB = 16384;
constexpr size_t WS_OPS = WS_L, WS_WLT = 3 * MiB, WS_WKV = 3 * MiB + 768 * 1024;
constexpr size_t WS_END = WS_ACT + (size_t)RPAD * ACTC * 2;
static_assert((size_t)16 * 513 * OPSB <= (size_t)RPAD * LC * 2, "ops fits");
static_assert(WS_END <= 512 * MiB, "ws total");
static_assert(WS_TMP2 + (size_t)RPAD * DM * 2 <= WS_ACT, "ws map");
static_assert(WS_U + (size_t)RPAD * DM * 2 <= WS_Z, "ws map");
static_assert(WS_VF + (size_t)RPAD * 512 * 2 <= WS_U, "ws map");

struct Args { const float* in[30]; float* out; unsigned char* ws; int ph_lo, ph_hi; };

enum { I_X = 0, I_META, I_NMPRE, I_NMPOST, I_NFPRE, I_NFPOST, I_WIN, I_MU, I_KVN, I_WUK, I_WUV, I_IDXG, I_IDXB, I_W0, I_W2, I_A0, I_A2, I_G2,
       I_KK, I_KA, I_RK, I_LNW, I_LNB, I_WINV, I_MUV, I_V0, I_V2, I_WO, I_WUP, I_WDN };

__device__ __forceinline__ float bf2f(bf16 b) { return __uint_as_float((unsigned)b << 16); }
typedef float f32x2h __attribute__((ext_vector_type(2)));
typedef __bf16 bf16x2h __attribute__((ext_vector_type(2)));
__device__ __forceinline__ unsigned pk2(float lo, float hi) { const bf16x2h v = __builtin_convertvector((f32x2h){lo, hi}, bf16x2h); return __builtin_bit_cast(unsigned, v); }
constexpr float S8_X = 16.f, S8_WU = 256.f, S8_H = 4.f, S8_WD = 512.f;
constexpr int E8_X = 0x7b7b7b7b, E8_WU = 0x77777777, E8_H = 0x7d7d7d7d, E8_WD = 0x76767676;
__device__ __forceinline__ float sat8(float x) { return __builtin_amdgcn_fmed3f(x, -448.f, 448.f); }
__device__ __forceinline__ unsigned pk4_fp8(float a, float b, float c, float d) { int p = __builtin_amdgcn_cvt_pk_fp8_f32(sat8(a), sat8(b), 0, false); p = __builtin_amdgcn_cvt_pk_fp8_f32(sat8(c), sat8(d), p, true); return (unsigned)p; }
__device__ __forceinline__ unsigned f2bf(float f) { return (unsigned)__builtin_bit_cast(unsigned short, (__bf16)f); }
template <int CTRL> __device__ __forceinline__ float dpp_f(float v) { return __int_as_float(__builtin_amdgcn_update_dpp(0, __float_as_int(v), CTRL, 0xf, 0xf, true)); }
__device__ __forceinline__ float row16_sum(float v) { v += dpp_f<0xB1>(v); v += dpp_f<0x4E>(v); v += dpp_f<0x141>(v); v += dpp_f<0x140>(v); return v; }
__device__ __forceinline__ float quad_sum(float v) { v += dpp_f<0xB1>(v); v += dpp_f<0x4E>(v); return v; }
template <int CTRL, int RM> __device__ __forceinline__ unsigned dpp_u(unsigned v) { return (unsigned)__builtin_amdgcn_update_dpp(0, (int)v, CTRL, RM, 0xf, false); }
__device__ __forceinline__ unsigned wave_scan_incl(unsigned x) {
    x += dpp_u<0x111, 0xf>(x); x += dpp_u<0x112, 0xf>(x); x += dpp_u<0x114, 0xf>(x); x += dpp_u<0x118, 0xf>(x);
    x += dpp_u<0x142, 0xa>(x); x += dpp_u<0x143, 0xc>(x); return x; }
__device__ __forceinline__ unsigned lane_bcast(unsigned v, int srclane) { return (unsigned)__builtin_amdgcn_readlane((int)v, srclane); }
typedef unsigned u2v __attribute__((ext_vector_type(2)));
__device__ __forceinline__ float xor16_sum(float v) { const u2v r = __builtin_amdgcn_permlane16_swap(__float_as_uint(v), __float_as_uint(v), false, false); return __uint_as_float(r.x) + __uint_as_float(r.y); }
__device__ __forceinline__ float xor32_sum(float v) { const u2v r = __builtin_amdgcn_permlane32_swap(__float_as_uint(v), __float_as_uint(v), false, false); return __uint_as_float(r.x) + __uint_as_float(r.y); }
__device__ __forceinline__ float xor16_max(float v) { const u2v r = __builtin_amdgcn_permlane16_swap(__float_as_uint(v), __float_as_uint(v), false, false); return fmaxf(__uint_as_float(r.x), __uint_as_float(r.y)); }
__device__ __forceinline__ float xor32_max(float v) { const u2v r = __builtin_amdgcn_permlane32_swap(__float_as_uint(v), __float_as_uint(v), false, false); return fmaxf(__uint_as_float(r.x), __uint_as_float(r.y)); }
__device__ __forceinline__ float wave_sum(float v) { v = row16_sum(v); v = xor16_sum(v); v = xor32_sum(v); return v; }
__device__ __forceinline__ float wave_max(float v) {
#pragma unroll
    for (int o = 1; o < 64; o <<= 1) v = fmaxf(v, __shfl_xor(v, o));
    return v;
}
__device__ __forceinline__ int row_of(int b, int p) { return p < NMETA ? MAINR + p : b * SEQ + (p - NMETA); }
__device__ __forceinline__ float relu_i(float x) { const int xi = __float_as_int(x); return __int_as_float(xi > 0 ? xi : 0); }
__device__ __forceinline__ float sigmoidf_(float x) { return __builtin_amdgcn_rcpf(1.f + __expf(-x)); }

__device__ __forceinline__ int lane_now() { int l; asm volatile("v_mbcnt_lo_u32_b32 %0, -1, 0\n\tv_mbcnt_hi_u32_b32 %0, -1, %0" : "=v"(l)); return l; }
__device__ __forceinline__ int launder2() { int n = 2; asm volatile("" : "+s"(n)); return n; }
struct Ctx {
    const float* const* in; float* out; unsigned char* ws;
    LAS unsigned char* lds; int tid, lane, wid, G, bid; int ppass;
    __device__ __forceinline__ const float* I(int i) const { return in[i]; }
    __device__ __forceinline__ bf16* Z() const { return (bf16*)(ws + WS_Z); }
    __device__ __forceinline__ bf16* ACT() const { return (bf16*)(ws + WS_ACT); }
    __device__ __forceinline__ bf16* WLT() const { return (bf16*)(ws + WS_WLT); }
    __device__ __forceinline__ bf16* U() const { return (bf16*)(ws + WS_U); }
    __device__ __forceinline__ bf16* VF() const { return (bf16*)(ws + WS_VF); }
    __device__ __forceinline__ bf16* KATT() const { return (bf16*)(ws + WS_KATT); }
    __device__ __forceinline__ bf16* VATT() const { return (bf16*)(ws + WS_VATT); }
    __device__ __forceinline__ bf16* KI() const { return (bf16*)(ws + WS_KI); }
    __device__ __forceinline__ float* HX() const { return (float*)(ws + WS_HX); }
    __device__ __forceinline__ float* COS() const { return (float*)(ws + WS_ROPE); }
    __device__ __forceinline__ float* SIN() const { return (float*)(ws + WS_ROPE) + TT * 8; }
    __device__ __forceinline__ unsigned* CTL() const { return (unsigned*)(ws + WS_CTL); }
};

template <class Src, bool FRAG = false>
__device__ __forceinline__ void transpose_item(const Src& src, bf16* WT, int K, int k0, int n0, LAS float* scr, int lane) {
#pragma unroll
    for (int i = 0; i < 8; ++i) { const int kk = 8 * i + (lane >> 3), nn = 4 * (lane & 7); const f32x4 v = src.v4(k0 + kk, n0 + nn);
        scr[kk * 33 + nn] = v.x; scr[kk * 33 + nn + 1] = v.y; scr[kk * 33 + nn + 2] = v.z; scr[kk * 33 + nn + 3] = v.w; }
    asm volatile("s_waitcnt lgkmcnt(0)" ::: "memory");
    const int c = lane & 7;
#pragma unroll
    for (int j = 0; j < 4; ++j) { const int n = (lane >> 3) + 8 * j; const LAS float* s = scr + (8 * c) * 33 + n;
        v4u o; o.x = pk2(s[0 * 33], s[1 * 33]); o.y = pk2(s[2 * 33], s[3 * 33]); o.z = pk2(s[4 * 33], s[5 * 33]); o.w = pk2(s[6 * 33], s[7 * 33]);
        if (FRAG) { const int ch = n0 + n, kq = (k0 >> 3) + c; *(v4u*)(WT + (size_t)((((ch >> 6) * 4 + (ch & 3)) * 10 + (kq >> 2)) * 64 + (kq & 3) * 16 + ((ch & 63) >> 2)) * 8) = o; }
        else *(v4u*)(WT + (size_t)(n0 + n) * K + k0 + 8 * c) = o; }
    asm volatile("s_waitcnt lgkmcnt(0)" ::: "memory");
}
template <class Src>
__device__ __forceinline__ void transpose_item8(const Src& src, unsigned char* WT, int K, int k0, int n0, LAS float* scr, int lane, float mul) {
#pragma unroll
    for (int i = 0; i < 8; ++i) { const int kk = 8 * i + (lane >> 3), nn = 4 * (lane & 7); const f32x4 v = src.v4(k0 + kk, n0 + nn);
        scr[kk * 33 + nn] = v.x; scr[kk * 33 + nn + 1] = v.y; scr[kk * 33 + nn + 2] = v.z; scr[kk * 33 + nn + 3] = v.w; }
    asm volatile("s_waitcnt lgkmcnt(0)" ::: "memory");
    const int c = lane & 7;
#pragma unroll
    for (int j = 0; j < 4; ++j) { const int n = (lane >> 3) + 8 * j; const LAS float* s = scr + (8 * c) * 33 + n;
        v2u o; o.x = pk4_fp8(s[0 * 33] * mul, s[1 * 33] * mul, s[2 * 33] * mul, s[3 * 33] * mul); o.y = pk4_fp8(s[4 * 33] * mul, s[5 * 33] * mul, s[6 * 33] * mul, s[7 * 33] * mul);
        *(v2u*)(WT + (size_t)(n0 + n) * K + k0 + 8 * c) = o; }
    asm volatile("s_waitcnt lgkmcnt(0)" ::: "memory");
}
struct SrcKV { const float* wk; const float* wv;
    __device__ __forceinline__ f32x4 v4(int k, int n) const { return n < 64 ? *(const f32x4*)(wk + (size_t)k * 64 + n) : *(const f32x4*)(wv + (size_t)k * 64 + n - 64); } };
struct SrcLora { const float* w2; const float* a2; const float* g2; const float* v2; int has_v;
    __device__ __forceinline__ f32x4 v4(int k, int n) const {
        if (k < 64) return *(const f32x4*)(w2 + (size_t)k * 512 + n);
        if (k < 128) return *(const f32x4*)(a2 + (size_t)(k - 64) * 512 + n);
        if (k < 288) return *(const f32x4*)(g2 + (size_t)(k - 128) * 512 + n);
        return has_v ? *(const f32x4*)(v2 + (size_t)(k - 288) * 512 + n) : (f32x4){0.f, 0.f, 0.f, 0.f}; } };
struct SrcPlain { const float* W; int ldw; __device__ __forceinline__ f32x4 v4(int k, int n) const { return *(const f32x4*)(W + (size_t)k * ldw + n); } };
struct SrcWin { const float* W; const float* Wv; int has_v;
    __device__ __forceinline__ f32x4 v4(int k, int n) const {
        if (n < 1092) return *(const f32x4*)(W + (size_t)k * 2916 + n);
        if (n >= C_R && n < C_XV) return *(const f32x4*)(W + (size_t)k * 2916 + 1092 + (n - C_R));
        if (n >= C_XV && n < C_XV + 32 && has_v) return *(const f32x4*)(Wv + (size_t)k * 32 + (n - C_XV));
        return (f32x4){0.f, 0.f, 0.f, 0.f}; } };

__device__ __forceinline__ void phase_prologue(const Ctx& C) {
    LAS float* scr = (LAS float*)(C.lds + C.wid * 16384);
    const int gw = C.bid * NWAVES + C.wid, NGW = C.G * NWAVES;
    constexpr int IT_WIN = 16 * 96, IT_WO = 16 * 32, IT_WUP = 16 * 128, IT_WDN = 64 * 32, IT_L = IT_WIN + IT_WO + IT_WUP + IT_WDN;
    for (int it = gw; it < 2 * IT_L; it += NGW) {
        const int l = it / IT_L; int r = it % IT_L;
        if (r < IT_WIN) { SrcWin s{C.I(I_WIN) + (size_t)l * 1024 * 2916, C.I(I_WINV), l == 1}; const int kb = r / 96, nb = r % 96;
            transpose_item(s, (bf16*)(C.ws + WS_WIN) + (size_t)l * ZC * 1024, 1024, 64 * kb, 32 * nb, scr, C.lane); continue; } r -= IT_WIN;
        if (r < IT_WO) { SrcPlain s{C.I(I_WO) + (size_t)l * 1024 * 1024, 1024}; const int kb = r / 32, nb = r % 32;
            transpose_item(s, (bf16*)(C.ws + WS_WO) + (size_t)l * 1024 * 1024, 1024, 64 * kb, 32 * nb, scr, C.lane); continue; } r -= IT_WO;
        if (r < IT_WUP) { SrcPlain s{C.I(I_WUP) + (size_t)l * 1024 * 4096, 4096}; const int kb = r / 128, nb = r % 128;
            transpose_item8(s, C.ws + WS_WUP + (size_t)l * 4096 * 1024, 1024, 64 * kb, 32 * nb, scr, C.lane, S8_WU); continue; } r -= IT_WUP;
        { SrcPlain s{C.I(I_WDN) + (size_t)l * 4096 * 1024, 1024}; const int kb = r / 32, nb = r % 32;
            transpose_item8(s, C.ws + WS_WDN + (size_t)l * 1024 * 4096, 4096, 64 * kb, 32 * nb, scr, C.lane, S8_WD); }
    }
    for (int it = gw; it < 2 * 16; it += NGW) { const int l = it / 16, r = it % 16, kb = r / 4, nb = r % 4;
        SrcKV s{C.I(I_WUK) + (size_t)l * 256 * 64, C.I(I_WUV) + (size_t)l * 256 * 64};
        transpose_item(s, (bf16*)(C.ws + WS_WKV) + (size_t)l * 128 * 256, 256, 64 * kb, 32 * nb, scr, C.lane); }
    for (int it = gw; it < 2 * 80; it += NGW) { const int l = it / 80, r = it % 80, kb = r / 16, nb = r % 16;
        SrcLora s{C.I(I_W2) + (size_t)l * 64 * 512, C.I(I_A2) + (size_t)l * 64 * 512, C.I(I_G2) + (size_t)l * 160 * 512, C.I(I_V2), l == 1};
        transpose_item<SrcLora, true>(s, C.WLT() + (size_t)l * 512 * ACTC, ACTC, 64 * kb, 32 * nb, scr, C.lane); }
    const int gt = C.bid * NT + C.tid, NGT = C.G * NT;
    for (int i = gt; i < TT * 8; i += NGT) {
        const int p = i >> 3, f = i & 7;
        const float invf = powf(500000.0f, -(float)(2 * f) / 16.0f);
        const float ang = (float)p * invf;
        const double ad = (double)ang; const double n = rint(ad * 0.15915494309189535); const float rr = (float)(ad - n * 6.283185307179586);
        C.COS()[i] = cosf(rr); C.SIN()[i] = sinf(rr);
    }
    for (int i = gt; i < 256 * DM; i += NGT) C.HX()[i] = (i < NMETA * DM) ? C.I(I_META)[i] : 0.f;
}

template <bool HIN16, bool HOUT16>
__device__ __forceinline__ void phase_norm(const Ctx& C, const void* hin_main, void* hout_main, const bf16* tmp, const float* g_post, const float* g_next, const float* hx_in = nullptr, const bool out8 = false) {
    const int gw = C.bid * NWAVES + C.wid, NGW = C.G * NWAVES; const int lane = C.lane;
    constexpr int NR = 2;
    for (int row0 = gw; row0 < RPAD; row0 += NR * NGW) {
        f32x4 h[NR][4]; v2u tw[NR][4];
#pragma unroll
        for (int u = 0; u < NR; ++u) { const int row = row0 + u * NGW; if (row >= RREAL) continue;
            const bool mainrow = row < MAINR;
            if (HIN16 && mainrow) {
#pragma unroll
                for (int j = 0; j < 4; ++j) { const v2u w = *(const v2u*)((const bf16*)hin_main + (size_t)row * DM + lane * 4 + 256 * j);
                    h[u][j] = (f32x4){__uint_as_float(w.x << 16), __uint_as_float(w.x & 0xffff0000u), __uint_as_float(w.y << 16), __uint_as_float(w.y & 0xffff0000u)}; }
            } else {
                const float* hp = mainrow ? (const float*)hin_main + (size_t)row * DM : (hx_in ? hx_in : (const float*)C.HX()) + (size_t)(row - MAINR) * DM;
#pragma unroll
                for (int j = 0; j < 4; ++j) h[u][j] = *(const f32x4*)(hp + lane * 4 + 256 * j);
            }
            if (tmp) {
#pragma unroll
                for (int j = 0; j < 4; ++j) tw[u][j] = *(const v2u*)(tmp + (size_t)row * DM + lane * 4 + 256 * j); }
        }
#pragma unroll
        for (int u = 0; u < NR; ++u) { const int row = row0 + u * NGW; if (row >= RPAD) continue;
            bf16* urow = C.U() + (size_t)row * DM;
            if (row >= RREAL) { if (g_next && !out8) {
#pragma unroll
                    for (int j = 0; j < 4; ++j) *(v2u*)(urow + lane * 4 + 256 * j) = (v2u){0u, 0u}; }
                continue; }
            const bool mainrow = row < MAINR;
            if (tmp) {
                f32x4 t[4]; float ss = 0.f;
#pragma unroll
                for (int j = 0; j < 4; ++j) { const v2u w = tw[u][j];
                    t[j] = (f32x4){__uint_as_float(w.x << 16), __uint_as_float(w.x & 0xffff0000u), __uint_as_float(w.y << 16), __uint_as_float(w.y & 0xffff0000u)};
                    ss += (t[j].x * t[j].x + t[j].y * t[j].y) + (t[j].z * t[j].z + t[j].w * t[j].w); }
                const float rstd = __builtin_amdgcn_rsqf(wave_sum(ss) * (1.f / DM) + NORM_EPS);
#pragma unroll
                for (int j = 0; j < 4; ++j) { const f32x4 g = *(const f32x4*)(g_post + lane * 4 + 256 * j); h[u][j] = h[u][j] + t[j] * rstd * g;
                    if (HOUT16 && mainrow) *(v2u*)((bf16*)hout_main + (size_t)row * DM + lane * 4 + 256 * j) = (v2u){pk2(h[u][j].x, h[u][j].y), pk2(h[u][j].z, h[u][j].w)};
                    else { float* ho = mainrow ? (float*)hout_main + (size_t)row * DM : C.HX() + (size_t)(row - MAINR) * DM; *(f32x4*)(ho + lane * 4 + 256 * j) = h[u][j]; } }
            }
            if (g_next) {
                float ss = 0.f;
#pragma unroll
                for (int j = 0; j < 4; ++j) ss += (h[u][j].x * h[u][j].x + h[u][j].y * h[u][j].y) + (h[u][j].z * h[u][j].z + h[u][j].w * h[u][j].w);
                const float rstd = __builtin_amdgcn_rsqf(wave_sum(ss) * (1.f / DM) + NORM_EPS);
#pragma unroll
                for (int j = 0; j < 4; ++j) { const f32x4 g = *(const f32x4*)(g_next + lane * 4 + 256 * j); const f32x4 y = h[u][j] * rstd * g;
                    if (out8) *(unsigned*)((unsigned char*)C.U() + (size_t)row * DM + lane * 4 + 256 * j) = pk4_fp8(y.x * S8_X, y.y * S8_X, y.z * S8_X, y.w * S8_X);
                    else *(v2u*)(urow + lane * 4 + 256 * j) = (v2u){pk2(y.x, y.y), pk2(y.z, y.w)}; }
            }
        }
    }
}

typedef short s16x4 __attribute__((ext_vector_type(4)));
constexpr int SLOT = 18432;
constexpr int O_W = 0, O_R = 2048, O_BK = 4096, O_ARK = 8192, O_TA = 9216, O_GAM = 9728, O_VT = 10240, O_TMP = 12288, O_B = 12288, O_K = 14336, O_AT = 16384;
constexpr int OPS_SH = 10240, OPS_VT = 10240, OPS_G = 12288, OPS_BG = 14336;
constexpr int NCHUNK = TT / 16;
__device__ __forceinline__ bf16x8 cat8(s16x4 a, s16x4 b) { return __builtin_shufflevector(a, b, 0, 1, 2, 3, 4, 5, 6, 7); }
__device__ __forceinline__ s16x4 pack4(f32x4 v) { v2u w = (v2u){pk2(v.x, v.y), pk2(v.z, v.w)}; return __builtin_bit_cast(s16x4, w); }
__device__ __forceinline__ s16x4 pack4f(float a, float b, float c, float d) { v2u w = (v2u){pk2(a, b), pk2(c, d)}; return __builtin_bit_cast(s16x4, w); }
__device__ __forceinline__ f32x4 mfma16(bf16x8 a, bf16x8 b, f32x4 c) { return __builtin_amdgcn_mfma_f32_16x16x32_bf16(a, b, c, 0, 0, 0); }
__device__ __forceinline__ void unpack4(v2u w, float (&o)[4]) { o[0] = __uint_as_float(w.x << 16); o[1] = __uint_as_float(w.x & 0xffff0000u); o[2] = __uint_as_float(w.y << 16); o[3] = __uint_as_float(w.y & 0xffff0000u); }


struct PostLd { unsigned short q1, q2, qi1, qi2, ki, a0, a1, a2, a3, a4; v2u ckv; float cs, sn; };
__device__ __forceinline__ void post_load(const Ctx& C, int l, int row, int lane, PostLd& o) {
    const int p = row < MAINR ? NMETA + (row & 8191) : row - MAINR;
    const bf16* z = C.Z() + (size_t)row * ZC;
    const int hh = lane >> 3, i = lane & 7;
    o.cs = C.COS()[p * 8 + i]; o.sn = C.SIN()[p * 8 + i];
    o.q1 = z[C_Q + hh * 64 + i]; o.q2 = z[C_Q + hh * 64 + 8 + i];
    o.qi1 = z[C_QI + (hh & 3) * 64 + i]; o.qi2 = z[C_QI + (hh & 3) * 64 + 8 + i];
    o.ki = z[C_KI + lane];
    o.ckv = *(const v2u*)(z + C_CKV + lane * 4);
    o.a0 = z[C_XW + lane]; o.a1 = z[C_XA + lane]; o.a2 = z[C_XG + lane]; o.a3 = z[C_XG + 64 + lane];
    o.a4 = lane < 32 ? z[C_XG + 128 + lane] : (l == 1 ? z[C_XV + lane - 32] : (unsigned short)0);
}
__device__ __forceinline__ float shiftf(unsigned short a_, unsigned short p_, float mu) { const float a = bf2f(a_), pr = bf2f(p_); return a + (pr - a) * mu; }
__device__ __forceinline__ void post_compute(const Ctx& C, int l, int row, int lane, const PostLd& d, const unsigned short (&pv)[5], const float (&mu)[5], const f32x4 kvg, const float ig, const float ib, LAS unsigned char* cl) {
    int b, p; if (row < MAINR) { b = row >> 13; p = NMETA + (row & 8191); } else { b = -1; p = row - MAINR; }
    bf16* z = C.Z() + (size_t)row * ZC;
    const int hh = lane >> 3, i = lane & 7; const float c = d.cs, s = d.sn;
    { const float t1 = bf2f(d.q1), t2 = bf2f(d.q2);
      z[C_Q + hh * 64 + i] = (bf16)f2bf(t1 * c - t2 * s); z[C_Q + hh * 64 + 8 + i] = (bf16)f2bf(t2 * c + t1 * s); }
    if (lane < 32) { const float t1 = bf2f(d.qi1), t2 = bf2f(d.qi2);
      z[C_QI + hh * 64 + i] = (bf16)f2bf(t1 * c - t2 * s); z[C_QI + hh * 64 + 8 + i] = (bf16)f2bf(t2 * c + t1 * s); }
    {
        const float x = bf2f(d.ki);
        const float mu_ = wave_sum(x) * (1.f / 64.f); const float dd = x - mu_; const float var = wave_sum(dd * dd) * (1.f / 64.f);
        float y = dd * __builtin_amdgcn_rsqf(var + NORM_EPS) * ig + ib;
        const float o = dpp_f<0x128>(y);
        if (lane < 8) y = y * c - o * s; else if (lane < 16) y = y * c + o * s;
        const bf16 yb = (bf16)f2bf(y);
        const size_t ko = ((size_t)((p >> 5) * 4 + (lane >> 4)) * 64 + ((lane >> 3) & 1) * 32 + (p & 31)) * 8 + (lane & 7);
        if (b >= 0) C.KI()[(size_t)b * TPAD * 64 + ko] = yb;
        else {
#pragma unroll
            for (int bb = 0; bb < NB; ++bb) C.KI()[(size_t)bb * TPAD * 64 + ko] = yb; }
    }
    {
        const v2u w = d.ckv;
        f32x4 x = (f32x4){__uint_as_float(w.x << 16), __uint_as_float(w.x & 0xffff0000u), __uint_as_float(w.y << 16), __uint_as_float(w.y & 0xffff0000u)};
        const float ms = wave_sum((x.x * x.x + x.y * x.y) + (x.z * x.z + x.w * x.w)) * (1.f / 256.f);
        const float rstd = __builtin_amdgcn_rsqf(ms + NORM_EPS);
        x = x * rstd * kvg;
        *(LAS v2u*)((LAS unsigned char*)cl + lane * 8) = (v2u){pk2(x.x, x.y), pk2(x.z, x.w)};
    }
    bf16* ar = C.ACT() + (size_t)(row >> 4) * (16 * ACTC) + ((lane >> 3) * 16 + (row & 15)) * 8 + (lane & 7);
    const float x0 = shiftf(d.a0, pv[0], mu[0]); ar[0] = (bf16)f2bf(2.f * sigmoidf_(2.f * x0) - 1.f);
    ar[1024] = (bf16)f2bf(shiftf(d.a1, pv[1], mu[1]));
    ar[2048] = (bf16)f2bf(sigmoidf_(shiftf(d.a2, pv[2], mu[2])));
    ar[3072] = (bf16)f2bf(sigmoidf_(shiftf(d.a3, pv[3], mu[3])));
    float x4;
    if (lane < 32) x4 = sigmoidf_(shiftf(d.a4, pv[4], mu[4])); else x4 = l == 1 ? shiftf(d.a4, pv[4], mu[4]) : 0.f;
    ar[4096] = (bf16)f2bf(x4);
}
constexpr int CLP = 528;
__device__ __forceinline__ void phase_post(const Ctx& C, int l, bool doA) {
    int lane_ = lane_now(); const int lane = lane_, g = lane >> 4, cc = lane & 15;
    const int gw = C.bid * NWAVES + C.wid, NGW = C.G * NWAVES;
    LAS unsigned char* cl = C.lds + C.wid * (16 * CLP);
    const float* mup = C.I(I_MU) + l * 1824;
    const float mu[5] = {mup[1536 + lane], mup[1600 + lane], mup[1664 + lane], mup[1728 + lane], lane < 32 ? mup[1792 + lane] : (l == 1 ? C.I(I_MUV)[lane - 32] : 0.f)};
    const f32x4 kvg = *(const f32x4*)(C.I(I_KVN) + l * 256 + lane * 4); const float ig = C.I(I_IDXG)[l * 64 + lane], ib = C.I(I_IDXB)[l * 64 + lane];
    const bf16* wkv = (const bf16*)(C.ws + WS_WKV) + (size_t)l * 128 * 256 + (size_t)cc * 256 + 8 * g;
#define POST_PREV(prow_, has_, pv_) do { const bf16* zp_ = C.Z() + (size_t)(prow_) * ZC; \
        pv_[0] = zp_[C_XW + lane]; pv_[1] = zp_[C_XA + lane]; pv_[2] = zp_[C_XG + lane]; pv_[3] = zp_[C_XG + 64 + lane]; pv_[4] = lane < 32 ? zp_[C_XG + 128 + lane] : (l == 1 ? zp_[C_XV + lane - 32] : (unsigned short)0); \
        if (!(has_)) { pv_[0] = 0; pv_[1] = 0; pv_[2] = 0; pv_[3] = 0; pv_[4] = 0; } } while (0)
#define POST_NEXT(pv_, d_) do { pv_[0] = d_.a0; pv_[1] = d_.a1; pv_[2] = d_.a2; pv_[3] = d_.a3; pv_[4] = d_.a4; } while (0)
#define POST_KV(row0_, cl_) do { const int kvrow0 = (row0_); \
        bf16x8 Af[8]; \
        _Pragma("unroll") for (int ks = 0; ks < 8; ++ks) Af[ks] = *(const LAS bf16x8*)((cl_) + cc * CLP + (32 * ks + 8 * g) * 2); \
        const bool ismeta = kvrow0 >= MAINR; const int bq = ismeta ? 0 : kvrow0 >> 13; const int pb = ismeta ? kvrow0 - MAINR : NMETA + (kvrow0 & 8191); \
        _Pragma("unroll 2") for (int nt = 0; nt < 8; ++nt) { \
            bf16x8 Bf[8]; \
            _Pragma("unroll") for (int ks = 0; ks < 8; ++ks) Bf[ks] = *(const bf16x8*)(wkv + (size_t)nt * 16 * 256 + 32 * ks); \
            f32x4 acc = (f32x4){0.f, 0.f, 0.f, 0.f}; \
            _Pragma("unroll") for (int ks = 0; ks < 8; ++ks) acc = mfma16(Af[ks], Bf[ks], acc); \
            bf16* dst = (nt < 4 ? C.KATT() : C.VATT()) + (nt & 3) * 16 + cc; \
            _Pragma("unroll") for (int r = 0; r < 4; ++r) { const int p = pb + 4 * g + r; float v = acc[r]; \
                if (nt == 0) { const float o = __shfl_xor(v, 8); const float cs = C.COS()[p * 8 + (cc & 7)], sn = C.SIN()[p * 8 + (cc & 7)]; v = cc < 8 ? v * cs - o * sn : v * cs + o * sn; } \
                const bf16 vb = (bf16)f2bf(v); \
                if (!ismeta) dst[((size_t)bq * TPAD + p) * 64] = vb; \
                else { _Pragma("unroll") for (int bb = 0; bb < NB; ++bb) dst[((size_t)bb * TPAD + p) * 64] = vb; } } } } while (0)
    for (int grp = gw; grp < MAINR / 16; grp += NGW) {
        const int row0 = grp * 16;
        unsigned short pv[5];
        { const int s0 = row0 & 8191; POST_PREV(s0 == 0 ? MAINR + 15 : row0 - 1, true, pv); }
        PostLd d0, d1; post_load(C, l, row0, lane, d0);
#pragma unroll 1
        for (int rr = 0; rr < 16; rr += 2) {
            post_load(C, l, row0 + rr + 1, lane, d1);
            post_compute(C, l, row0 + rr, lane, d0, pv, mu, kvg, ig, ib, cl + rr * CLP); POST_NEXT(pv, d0);
            if (rr + 2 < 16) post_load(C, l, row0 + rr + 2, lane, d0);
            post_compute(C, l, row0 + rr + 1, lane, d1, pv, mu, kvg, ig, ib, cl + (rr + 1) * CLP); POST_NEXT(pv, d1);
        }
        asm volatile("s_waitcnt lgkmcnt(0)" ::: "memory");
        POST_KV(row0, cl);
    }
    if (C.bid == C.G - 1) {
        LAS unsigned char* clm = C.lds + NWAVES * 16 * CLP;
        const int r0 = MAINR + 2 * C.wid;
        unsigned short pv[5]; POST_PREV(r0 == MAINR ? r0 : r0 - 1, r0 != MAINR, pv);
        PostLd d0, d1; post_load(C, l, r0, lane, d0); post_load(C, l, r0 + 1, lane, d1);
        post_compute(C, l, r0, lane, d0, pv, mu, kvg, ig, ib, clm + (2 * C.wid) * CLP); POST_NEXT(pv, d0);
        post_compute(C, l, r0 + 1, lane, d1, pv, mu, kvg, ig, ib, clm + (2 * C.wid + 1) * CLP);
        asm volatile("s_waitcnt lgkmcnt(0)" ::: "memory");
        __syncthreads();
        if (C.wid == 0) POST_KV(MAINR, clm);
    }
#undef POST_PREV
#undef POST_NEXT
#undef POST_KV
}

__device__ __forceinline__ void prep_copy(LAS unsigned char* sl, unsigned char* ops, int lane) {
#pragma unroll
    for (int i = 0; i < 12; ++i) *(v4u*)(ops + (i * 64 + lane) * 16) = *(const LAS v4u*)(sl + (i * 64 + lane) * 16);
    asm volatile("s_waitcnt lgkmcnt(0)" ::: "memory");
}
template <bool SHARED>
__device__ __forceinline__ unsigned char* prep_unit(const Ctx& C, int l, int bh, int bhl, int cidx, LAS unsigned char* sl, unsigned char* prev_ops) {
    int lane_ = lane_now(); const int lane = lane_, g = lane >> 4, c = lane & 15;
    const int b = bh >> 3, h = bh & 7;
    const int row0 = cidx == 0 ? MAINR : b * SEQ + 16 * (cidx - 1);
    const bf16x8 zero8 = (bf16x8){0, 0, 0, 0, 0, 0, 0, 0};
    const f32x4 z4 = (f32x4){0.f, 0.f, 0.f, 0.f};
    f32x4 aw[4], aa[4], ag[4], av[4];
    const int ch0 = h * 64 + 4 * c;
    const bf16* zb = C.Z() + C_R + ch0;
    v2u wr[4], wk[4], wv[4], wf[4], pwr, pwk, pwv;
    const bf16* act = C.ACT() + (size_t)(row0 >> 4) * (16 * ACTC) + lane * 8;
    const bf16* wl = C.WLT() + (size_t)l * 512 * ACTC + (size_t)(h * 4) * (10 * 512) + lane * 8;
    bf16x8 Af[10], BfA[10], BfB[10];
#define PREP_LDB(Bf, n) do { if (SHARED) { _Pragma("unroll") for (int ks = 0; ks < 10; ++ks) Bf[ks] = *(const LAS bf16x8*)(C.lds + (((n) * 10 + ks) * 64 + lane) * 16); } \
        else { _Pragma("unroll") for (int ks = 0; ks < 10; ++ks) Bf[ks] = *(const bf16x8*)(wl + ((n) * 10 + ks) * 512); } } while (0)
#define PREP_MM(Bf, n) do { aw[n] = mfma16(Af[1], Bf[1], mfma16(Af[0], Bf[0], z4)); aa[n] = mfma16(Af[3], Bf[3], mfma16(Af[2], Bf[2], z4)); \
        { f32x4 t = z4; _Pragma("unroll") for (int ks = 4; ks < 9; ++ks) t = mfma16(Af[ks], Bf[ks], t); ag[n] = t; } av[n] = mfma16(Af[9], Bf[9], z4); } while (0)
    if (SHARED) {
        __syncthreads();
#pragma unroll
        for (int i = 0; i < 5; ++i) { const int blk = C.wid + 8 * i;
            __builtin_amdgcn_global_load_lds((const unsigned*)(wl - lane * 8 + blk * 512 + lane * 8), (LAS unsigned*)(C.lds + blk * 1024), 16, 0, 0); }
    }
#pragma unroll
    for (int ks = 0; ks < 10; ++ks) Af[ks] = *(const bf16x8*)(act + 512 * ks);
    if (!SHARED) { PREP_LDB(BfA, 0); PREP_LDB(BfB, 1); }
#pragma unroll
    for (int r = 0; r < 4; ++r) { const size_t row = row0 + 4 * g + r;
        wr[r] = *(const v2u*)(zb + row * ZC); wk[r] = *(const v2u*)(zb + row * ZC + 512); wv[r] = *(const v2u*)(zb + row * ZC + 1024);
        wf[r] = l == 1 ? *(const v2u*)(C.VF() + row * 512 + ch0) : (v2u){0u, 0u}; }
    {
        bool hasprev = true; int prow;
        if (g > 0) prow = row0 + 4 * g - 1; else if (cidx == 0) { hasprev = false; prow = row0; } else prow = cidx == 1 ? MAINR + 15 : row0 - 1;
        pwr = *(const v2u*)(zb + (size_t)prow * ZC); pwk = *(const v2u*)(zb + (size_t)prow * ZC + 512); pwv = *(const v2u*)(zb + (size_t)prow * ZC + 1024);
        if (!hasprev) { pwr = (v2u){0u, 0u}; pwk = pwr; pwv = pwr; }
    }
    asm volatile("" ::: "memory");
    if (prev_ops) prep_copy(sl, prev_ops, lane);
    asm volatile("" ::: "memory");
    if (SHARED) { asm volatile("s_waitcnt vmcnt(0)" ::: "memory"); __syncthreads(); PREP_LDB(BfA, 0); PREP_LDB(BfB, 1); }
    PREP_MM(BfA, 0);
    asm volatile("" ::: "memory");
    PREP_LDB(BfA, 2);
    asm volatile("" ::: "memory");
    PREP_MM(BfB, 1);
    asm volatile("" ::: "memory");
    PREP_LDB(BfB, 3);
    const f32x4 w0v = *(const f32x4*)(C.I(I_W0) + l * 512 + ch0), a0v = *(const f32x4*)(C.I(I_A0) + l * 512 + ch0);
    const f32x4 v0v = l == 1 ? *(const f32x4*)(C.I(I_V0) + ch0) : z4;
    const f32x4 mur = *(const f32x4*)(C.I(I_MU) + l * 1824 + ch0), muk = *(const f32x4*)(C.I(I_MU) + l * 1824 + 512 + ch0), muv = *(const f32x4*)(C.I(I_MU) + l * 1824 + 1024 + ch0);
    const f32x4 kkc = *(const f32x4*)(C.I(I_KK) + l * 512 + ch0), kac = *(const f32x4*)(C.I(I_KA) + l * 512 + ch0), rkc = *(const f32x4*)(C.I(I_RK) + l * 512 + ch0);
    const f32x4 lnw = *(const f32x4*)(C.I(I_LNW) + l * 512 + ch0), lnb = *(const f32x4*)(C.I(I_LNB) + l * 512 + ch0);
    asm volatile("" ::: "memory");
    PREP_MM(BfA, 2);
    PREP_MM(BfB, 3);
    asm volatile("" ::: "memory");
    if (SHARED) { asm volatile("s_waitcnt lgkmcnt(0)" ::: "memory"); __syncthreads(); }
#undef PREP_LDB
#undef PREP_MM
    float At[4][4], Bt[4][4], Kt[4][4], Vv[4][4], gam[4];
    unsigned char* ops = C.ws + WS_OPS + ((size_t)bhl * NCHUNK + cidx) * OPSB;
    {
        float lw[4][4], cum[4][4];
#pragma unroll
        for (int r = 0; r < 4; ++r)
#pragma unroll
            for (int n = 0; n < 4; ++n) lw[r][n] = -0.6065306597126334f * sigmoidf_(w0v[n] + aw[n][r]);
#pragma unroll
        for (int n = 0; n < 4; ++n) { cum[0][n] = lw[0][n]; cum[1][n] = cum[0][n] + lw[1][n]; cum[2][n] = cum[1][n] + lw[2][n]; cum[3][n] = cum[2][n] + lw[3][n];
            const float tot = cum[3][n];
            const u2v r16 = __builtin_amdgcn_permlane16_swap(__float_as_uint(tot), __float_as_uint(tot), false, false);
            const float x16 = __uint_as_float((g & 1) ? r16.x : r16.y), pr2 = tot + x16;
            const u2v r32 = __builtin_amdgcn_permlane32_swap(__float_as_uint(pr2), __float_as_uint(pr2), false, false);
            const float off = ((g & 1) ? x16 : 0.f) + ((g & 2) ? __uint_as_float(r32.x) : 0.f);
#pragma unroll
            for (int r = 0; r < 4; ++r) cum[r][n] += off;
            gam[n] = 0.f; }
        float pr[4], pk[4], pv[4]; unpack4(pwr, pr); unpack4(pwk, pk); unpack4(pwv, pv);
        float ecp[4];
#pragma unroll
        for (int n = 0; n < 4; ++n) ecp[n] = __expf(cum[0][n] - lw[0][n]);
#pragma unroll
        for (int r = 0; r < 4; ++r) {
            float rr[4], kr[4], vr[4], vf[4]; unpack4(wr[r], rr); unpack4(wk[r], kr); unpack4(wv[r], vr); unpack4(wf[r], vf);
            float rs[4], ks[4], vs[4], kk[4], ss = 0.f;
#pragma unroll
            for (int n = 0; n < 4; ++n) { rs[n] = rr[n] + (pr[n] - rr[n]) * mur[n]; ks[n] = kr[n] + (pk[n] - kr[n]) * muk[n]; vs[n] = vr[n] + (pv[n] - vr[n]) * muv[n];
                pr[n] = rr[n]; pk[n] = kr[n]; pv[n] = vr[n]; kk[n] = ks[n] * kkc[n]; ss += kk[n] * kk[n]; }
            ss = row16_sum(ss);
            const float inv = __builtin_amdgcn_rcpf(fmaxf(__builtin_amdgcn_sqrtf(ss), 1e-12f));
            float k2[4], v2[4], Rt[4], Gp[4], BGp[4], rks = 0.f;
#pragma unroll
            for (int n = 0; n < 4; ++n) { const float a = sigmoidf_(a0v[n] + aa[n][r]); kk[n] *= inv; k2[n] = ks[n] * (1.f + (a - 1.f) * kac[n]);
                const float bb = kk[n] * a; v2[n] = l == 0 ? vs[n] : vs[n] + (vf[n] - vs[n]) * sigmoidf_(v0v[n] + av[n][r]);
                rks += rs[n] * k2[n] * rkc[n];
                const float ec = __expf(cum[r][n]), en = __builtin_amdgcn_rcpf(ec), ep = ecp[n]; ecp[n] = ec; if (r == 3) gam[n] = ec;
                At[r][n] = -kk[n] * ep; Bt[r][n] = bb * en; Kt[r][n] = k2[n] * en; Rt[n] = rs[n] * ec; Vv[r][n] = v2[n]; }
            rks = row16_sum(rks);
#pragma unroll
            for (int n = 0; n < 4; ++n) { const float gg = ag[n][r]; Gp[n] = lnw[n] * gg; BGp[n] = (lnb[n] + rks * v2[n]) * gg; }
            { const int t = 4 * g + r;
              *(LAS s16x4*)(sl + O_W + (t * 64 + 4 * c) * 2) = pack4f(At[r][0], At[r][1], At[r][2], At[r][3]);
              *(LAS s16x4*)(sl + O_B + (t * 64 + 4 * c) * 2) = pack4f(Bt[r][0], Bt[r][1], Bt[r][2], Bt[r][3]);
              *(LAS s16x4*)(sl + O_K + (t * 64 + 4 * c) * 2) = pack4f(Kt[r][0], Kt[r][1], Kt[r][2], Kt[r][3]);
              *(LAS s16x4*)(sl + O_R + (t * 64 + 4 * c) * 2) = pack4f(Rt[0], Rt[1], Rt[2], Rt[3]);
              *(s16x4*)(ops + OPS_G + (t * 64 + 4 * c) * 2) = pack4f(Gp[0], Gp[1], Gp[2], Gp[3]);
              *(s16x4*)(ops + OPS_BG + (t * 64 + 4 * c) * 2) = pack4f(BGp[0], BGp[1], BGp[2], BGp[3]); }
            if (l == 0) *(v2u*)(C.VF() + (size_t)(row0 + 4 * g + r) * 512 + ch0) = (v2u){pk2(vs[0], vs[1]), pk2(vs[2], vs[3])};
        }
    }
#pragma unroll
    for (int n = 0; n < 4; ++n) { const int j = 4 * c + n;
        *(LAS s16x4*)(sl + O_AT + (j * 16 + 4 * g) * 2) = pack4f(At[0][n], At[1][n], At[2][n], At[3][n]);
        *(LAS s16x4*)(sl + O_BK + (j * 32 + 4 * g) * 2) = pack4f(Bt[0][n], Bt[1][n], Bt[2][n], Bt[3][n]);
        *(LAS s16x4*)(sl + O_BK + (j * 32 + 16 + 4 * g) * 2) = pack4f(Kt[0][n], Kt[1][n], Kt[2][n], Kt[3][n]);
        *(LAS s16x4*)(sl + O_VT + (j * 16 + 4 * g) * 2) = pack4f(Vv[0][n], Vv[1][n], Vv[2][n], Vv[3][n]); }
    if (g == 3) *(LAS f32x4*)(sl + O_GAM + 4 * c * 4) = (f32x4){gam[0], gam[1], gam[2], gam[3]};
    asm volatile("s_waitcnt lgkmcnt(0)" ::: "memory");
    {
        f32x4 aab = z4, aak = z4, arb = z4, ark = z4;
#pragma unroll
        for (int ks = 0; ks < 2; ++ks) {
            const bf16x8 Aa = *(const LAS bf16x8*)(sl + O_W + (c * 64 + 32 * ks + 8 * g) * 2), Ar = *(const LAS bf16x8*)(sl + O_R + (c * 64 + 32 * ks + 8 * g) * 2);
            const bf16x8 Bb = *(const LAS bf16x8*)(sl + O_B + (c * 64 + 32 * ks + 8 * g) * 2), Bk = *(const LAS bf16x8*)(sl + O_K + (c * 64 + 32 * ks + 8 * g) * 2);
            aab = mfma16(Aa, Bb, aab); aak = mfma16(Aa, Bk, aak); arb = mfma16(Ar, Bb, arb); ark = mfma16(Ar, Bk, ark);
        }
        asm volatile("" ::: "memory");
        f32x4 mk;
#pragma unroll
        for (int r = 0; r < 4; ++r) { const int t = 4 * g + r; const bool lo = c < t, li = c <= t;
            *(LAS float*)(sl + O_B + (t * 16 + c) * 4) = lo ? aab[r] : 0.f;
            mk[r] = lo ? aak[r] : 0.f;
            *(LAS bf16*)(sl + O_ARK + (t * 32 + c) * 2) = (bf16)f2bf(li ? arb[r] : 0.f);
            *(LAS bf16*)(sl + O_ARK + (t * 32 + 16 + c) * 2) = (bf16)f2bf(li ? ark[r] : 0.f); }
        *(LAS s16x4*)(sl + O_K + (c * 16 + 4 * g) * 2) = pack4(mk);
    }
    asm volatile("s_waitcnt lgkmcnt(0)" ::: "memory");
    {
        float X[16];
#pragma unroll
        for (int t = 0; t < 16; ++t) { float acc = (t == c) ? 1.f : 0.f;
#pragma unroll
            for (int s4 = 0; s4 < (t + 3) / 4; ++s4) { const f32x4 a4 = *(const LAS f32x4*)(sl + O_B + (t * 16 + 4 * s4) * 4);
#pragma unroll
                for (int e = 0; e < 4; ++e) if (4 * s4 + e < t) acc += a4[e] * X[4 * s4 + e]; }
            X[t] = acc; }
#pragma unroll
        for (int t = 0; t < 16; ++t) *(LAS bf16*)(sl + O_K + 512 + (t * 16 + c) * 2) = (bf16)f2bf(X[t]);
    }
    asm volatile("s_waitcnt lgkmcnt(0)" ::: "memory");
    {
        const bf16x8 Top = g < 2 ? *(const LAS bf16x8*)(sl + O_K + 512 + (c * 16 + 8 * g) * 2) : zero8;
#pragma unroll
        for (int n = 0; n < 4; ++n) { const bf16x8 Bop = g < 2 ? *(const LAS bf16x8*)(sl + O_AT + ((16 * n + c) * 16 + 8 * g) * 2) : zero8;
            const f32x4 wacc = mfma16(Top, Bop, z4);
#pragma unroll
            for (int r = 0; r < 4; ++r) *(LAS bf16*)(sl + O_W + ((4 * g + r) * 64 + 16 * n + c) * 2) = (bf16)f2bf(wacc[r]); }
        const bf16x8 Bop = g < 2 ? *(const LAS bf16x8*)(sl + O_K + (c * 16 + 8 * g) * 2) : zero8;
        const f32x4 ta = mfma16(Top, Bop, z4);
#pragma unroll
        for (int r = 0; r < 4; ++r) *(LAS bf16*)(sl + O_TA + ((4 * g + r) * 16 + c) * 2) = (bf16)f2bf(ta[r]);
    }
    asm volatile("s_waitcnt lgkmcnt(0)" ::: "memory");
    return ops;
}

__device__ __forceinline__ void phase_prep(const Ctx& C, int l, int half) {
    const int gw = C.bid * NWAVES + C.wid, NGW = C.G * NWAVES;
    LAS unsigned char* sl = C.lds + C.wid * SLOT;
    unsigned char* pops = nullptr;
    for (int u = gw; u < 16 * 512; u += NGW) { const int bhl = u >> 9, cidx = u & 511; pops = prep_unit<false>(C, l, 16 * half + bhl, bhl, cidx, sl, pops); }
    if (pops) prep_copy(sl, pops, lane_now());
}

struct OpsSet { v4u d[10]; };
struct GbSet { v4u d[4]; };
struct VtSet { v2u v4[4]; };
constexpr int RING_SLOT = 11520, YB_OFF = 8 * RING_SLOT, YB_SLOT = 4096;
__device__ __forceinline__ int swz(int x) { return x + ((x >> 7) << 4); }

__device__ __forceinline__ void ld_ops(OpsSet& s, const unsigned char* ops, int c, int lane) {
    const unsigned char* p = ops + (size_t)(c < NCHUNK ? c : NCHUNK - 1) * OPSB + lane * 16;
#pragma unroll
    for (int i = 0; i < 10; ++i) s.d[i] = *(const v4u*)(p + i * 1024);
}
__device__ __forceinline__ void st_ops(const OpsSet& s, LAS unsigned char* ring, int c, int lane) {
    LAS unsigned char* p = ring + (c & 7) * RING_SLOT + lane * 16 + (lane >> 3) * 16;
#pragma unroll
    for (int i = 0; i < 10; ++i) *(LAS v4u*)(p + i * 1152) = s.d[i];
}
__device__ __forceinline__ void ld_gb(GbSet& s, const unsigned char* ops, int c, int lane) {
    const int t = lane >> 2, cg = lane & 3;
    const unsigned char* p = ops + (size_t)(c < NCHUNK ? c : NCHUNK - 1) * OPSB + (t * 64 + 16 * cg) * 2;
    s.d[0] = *(const v4u*)(p + OPS_G); s.d[1] = *(const v4u*)(p + OPS_G + 16); s.d[2] = *(const v4u*)(p + OPS_BG); s.d[3] = *(const v4u*)(p + OPS_BG + 16);
}
__device__ __forceinline__ void ld_vt(VtSet& s, const unsigned char* ops, int j, int wid, int lane) {
    const int g = lane >> 4, c = lane & 15;
#pragma unroll
    for (int u = 0; u < 4; ++u) { const int ch = 4 * j + u; const unsigned char* p = ops + (size_t)(ch < NCHUNK ? ch : NCHUNK - 1) * OPSB + OPS_VT + (16 * wid + c) * 32;
        s.v4[u] = *(const v2u*)(p + g * 8); }
}
__device__ __forceinline__ void out_stage(const Ctx& C, const GbSet& s, LAS unsigned char* ybuf, int b, int hh, int c, int lane) {
    const int t = lane >> 2, cg = lane & 3;
    const int row = (c == 0 ? MAINR : b * SEQ + 16 * (c - 1)) + t;
    const LAS float* yp = (const LAS float*)(ybuf + (c & 7) * YB_SLOT) + t * 64 + 16 * cg;
    f32x4 y[4];
#pragma unroll
    for (int i = 0; i < 4; ++i) y[i] = *(const LAS f32x4*)(yp + 4 * i);
    float s1 = 0.f;
#pragma unroll
    for (int i = 0; i < 4; ++i) s1 += (y[i].x + y[i].y) + (y[i].z + y[i].w);
    s1 = quad_sum(s1);
    const float mean = s1 * (1.f / 64.f); float s2 = 0.f;
#pragma unroll
    for (int i = 0; i < 4; ++i) { y[i] = y[i] - mean; s2 += (y[i].x * y[i].x + y[i].y * y[i].y) + (y[i].z * y[i].z + y[i].w * y[i].w); }
    s2 = quad_sum(s2);
    const float rstd = __builtin_amdgcn_rsqf(s2 * (1.f / 64.f) + GN_EPS);
    v4u o[2];
#pragma unroll
    for (int k = 0; k < 2; ++k) {
        const v4u gw = s.d[k], bw = s.d[2 + k]; unsigned ow[4];
#pragma unroll
        for (int e = 0; e < 4; ++e) { const f32x4 yy = y[2 * k + (e >> 1)]; const float ya = (e & 1) ? yy.z : yy.x, yb = (e & 1) ? yy.w : yy.y;
            const float g0 = __uint_as_float(gw[e] << 16), g1 = __uint_as_float(gw[e] & 0xffff0000u), b0 = __uint_as_float(bw[e] << 16), b1 = __uint_as_float(bw[e] & 0xffff0000u);
            ow[e] = pk2(ya * rstd * g0 + b0, yb * rstd * g1 + b1); }
        o[k] = (v4u){ow[0], ow[1], ow[2], ow[3]};
    }
    bf16* dst = C.U() + (size_t)row * DM + 512 + hh * 64 + 16 * cg;
    *(v4u*)dst = o[0]; *(v4u*)(dst + 8) = o[1];
}

struct ChEarly { bf16x8 Wp[2], Rp[2]; s16x4 TAop; };
struct ChLate { bf16x8 ARKp, BKp[4]; f32x4 gam[4]; };
__device__ __forceinline__ void chain_load_e(ChEarly& o, const LAS unsigned char* p1, const LAS unsigned char* p2, const int so) {
#pragma unroll
    for (int ks = 0; ks < 2; ++ks) {
        o.Wp[ks] = cat8(*(const LAS s16x4*)(p1 + so + 64 * ks), *(const LAS s16x4*)(p1 + so + 64 * ks + 32));
        o.Rp[ks] = cat8(*(const LAS s16x4*)(p1 + so + 2304 + 64 * ks), *(const LAS s16x4*)(p1 + so + 2304 + 64 * ks + 32)); }
    o.TAop = *(const LAS s16x4*)(p2 + so + 10368);
}
__device__ __forceinline__ void chain_load_l(ChLate& o, const LAS unsigned char* p3, const LAS unsigned char* p4, const int so) {
    o.ARKp = cat8(*(const LAS s16x4*)(p3 + so + 9216), *(const LAS s16x4*)(p3 + so + 9216 + 32));
#pragma unroll
    for (int q = 0; q < 4; ++q) { o.BKp[q] = cat8(*(const LAS s16x4*)(p3 + so + 4608 + 1152 * q), *(const LAS s16x4*)(p3 + so + 4608 + 1152 * q + 32));
        o.gam[q] = *(const LAS f32x4*)(p4 + so + 9728 + 76 * 16 + 64 * q + (q >= 2 ? 16 : 0)); }
}
__device__ __forceinline__ f32x4 chain_compute(const ChEarly& e, const ChLate& o, const v2u v4w, f32x4 (&ST)[4]) {
    const s16x4 V4 = __builtin_bit_cast(s16x4, v4w); const s16x4 zero4 = (s16x4){0, 0, 0, 0};
    const bf16x8 TAop = cat8(e.TAop, zero4), Vb = cat8(V4, zero4);
    const f32x4 z4 = (f32x4){0.f, 0.f, 0.f, 0.f};
    const bf16x8 Bk0 = cat8(pack4(ST[0]), pack4(ST[1])), Bk1 = cat8(pack4(ST[2]), pack4(ST[3]));
    f32x4 U = mfma16(e.Wp[0], Bk0, z4); U = mfma16(e.Wp[1], Bk1, U); U = mfma16(TAop, Vb, U);
    f32x4 Y = mfma16(e.Rp[0], Bk0, z4); Y = mfma16(e.Rp[1], Bk1, Y);
    const bf16x8 UV = cat8(pack4(U), V4);
    Y = mfma16(o.ARKp, UV, Y);
#pragma unroll
    for (int q = 0; q < 4; ++q) { ST[q] = mfma16(o.BKp[q], UV, ST[q]); ST[q] = ST[q] * o.gam[q]; }
    return Y;
}

#define WAIT_LAST() do { unsigned sp_ = 0; while (__hip_atomic_load(flagw, __ATOMIC_RELAXED, __HIP_MEMORY_SCOPE_AGENT) < 2u && ++sp_ < (1u << 20)) __builtin_amdgcn_s_sleep(8); \
    __builtin_amdgcn_fence(__ATOMIC_ACQUIRE, "agent"); asm volatile("s_waitcnt vmcnt(0)" ::: "memory"); } while (0)
#define WG_BAR() do { asm volatile("s_waitcnt lgkmcnt(0)" ::: "memory"); __builtin_amdgcn_s_barrier(); asm volatile("" ::: "memory"); } while (0)
#define YSTORE(ch, Yv) do { _Pragma("unroll") for (int r = 0; r < 4; ++r) *(LAS float*)(ybuf + ((ch) & 7) * YB_SLOT + ((4 * (lane >> 4) + r) * 64 + 16 * wid + (lane & 15)) * 4) = (Yv)[r]; } while (0)
#define CHAIN_IT(j, VTU, HB) do { \
    ChEarly ea, eb; ChLate la; f32x4 Yv; \
    chain_load_e(ea, p1 + HB, p2 + HB, 0); \
    chain_load_l(la, p3 + HB, p4 + HB, 0); chain_load_e(eb, p1 + HB, p2 + HB, RING_SLOT); \
    Yv = chain_compute(ea, la, VTU.v4[0], ST); YSTORE(4 * (j) + 0, Yv); \
    chain_load_l(la, p3 + HB, p4 + HB, RING_SLOT); chain_load_e(ea, p1 + HB, p2 + HB, 2 * RING_SLOT); \
    Yv = chain_compute(eb, la, VTU.v4[1], ST); YSTORE(4 * (j) + 1, Yv); \
    chain_load_l(la, p3 + HB, p4 + HB, 2 * RING_SLOT); chain_load_e(eb, p1 + HB, p2 + HB, 3 * RING_SLOT); \
    Yv = chain_compute(ea, la, VTU.v4[2], ST); YSTORE(4 * (j) + 2, Yv); \
    chain_load_l(la, p3 + HB, p4 + HB, 3 * RING_SLOT); \
    Yv = chain_compute(eb, la, VTU.v4[3], ST); YSTORE(4 * (j) + 3, Yv); \
    ld_vt(VTU, ops, (j) + 2, wid, lane); WG_BAR(); } while (0)
#define LOAD_IT(j, OSW, OSI, GBO, GBI) do { \
    const int co = 4 * ((j) - 1) + lw; if ((j) >= 1 && co < NCHUNK) out_stage(C, GBO, ybuf, b, hh, co, lane); \
    const int cn = 4 * ((j) + 1) + lw; if (cn < NCHUNK) st_ops(OSW, ring, cn, lane); \
    ld_ops(OSI, ops, 4 * ((j) + 3) + lw, lane); ld_gb(GBI, ops, cn, lane); WG_BAR(); } while (0)

__device__ __forceinline__ void chain_phase(const Ctx& C, int bh, int bhl, unsigned* flagw) {
    int lane_ = lane_now(); const int lane = lane_, wid = C.wid;
    const int b = bh >> 3, hh = bh & 7;
    LAS unsigned char* ring = C.lds; LAS unsigned char* ybuf = C.lds + YB_OFF;
    const unsigned char* ops = C.ws + WS_OPS + (size_t)bhl * NCHUNK * OPSB;
    constexpr int NIT = 132;
    if (wid < 4) {
        f32x4 ST[4];
#pragma unroll
        for (int q = 0; q < 4; ++q) ST[q] = (f32x4){0.f, 0.f, 0.f, 0.f};
        VtSet vt0, vt1;
        ld_vt(vt0, ops, 0, wid, lane); ld_vt(vt1, ops, 1, wid, lane);
        WG_BAR();
        __builtin_amdgcn_s_setprio(3);
        const int g_ = lane >> 4, c_ = lane & 15;
        const LAS unsigned char* p1 = ring + c_ * 144 + 8 * g_;
        const LAS unsigned char* p2 = ring + c_ * 32 + 8 * g_ + (c_ >> 2) * 16;
        const LAS unsigned char* p3 = ring + c_ * 64 + 8 * g_ + (c_ >> 1) * 16;
        const LAS unsigned char* p4 = ring + 16 * g_;
#pragma unroll 1
        for (int j = 0; j < NIT; j += 2) {
            if (j == 96) WAIT_LAST();
#ifndef NOCHAIN
            CHAIN_IT(j, vt0, 0); CHAIN_IT(j + 1, vt1, 4 * RING_SLOT);
#endif
        }
        __builtin_amdgcn_s_setprio(0);
    } else {
        const int lw = wid - 4;
        OpsSet os0, os1, os2; GbSet gb0, gb1, gb2;
        ld_ops(os0, ops, lw, lane); ld_ops(os1, ops, 4 + lw, lane); ld_ops(os2, ops, 8 + lw, lane); ld_gb(gb0, ops, lw, lane); st_ops(os0, ring, lw, lane);
        gb1 = gb0; gb2 = gb0;
        WG_BAR();
#pragma unroll 1
        for (int j = 0; j < NIT; j += 3) {
            if (j == 96) WAIT_LAST();
#ifndef NOLOADER
            LOAD_IT(j, os1, os0, gb2, gb1); LOAD_IT(j + 1, os2, os1, gb0, gb2); LOAD_IT(j + 2, os0, os2, gb1, gb0);
#endif
        }
    }
}

constexpr int SCW = 8224;
constexpr int LDS_HIST = 8 * SCW * 2;
constexpr int LDS_IDX = LDS_HIST + 8 * 256 * 4;
constexpr int LDS_MISC = LDS_IDX + 8 * 256 * 2;
static_assert(LDS_MISC + 64 <= LDS_BYTES && 8 * 18432 <= LDS_BYTES && 8 * 10240 + 8 * 4096 <= LDS_MISC, "lds map");

__device__ __forceinline__ unsigned mbcnt64(unsigned long long m) { return __builtin_amdgcn_mbcnt_hi((unsigned)(m >> 32), __builtin_amdgcn_mbcnt_lo((unsigned)m, 0u)); }

__device__ __forceinline__ void find_bin(LAS unsigned* hist, unsigned target, int lane, unsigned& bin, unsigned& above) {
    const v4u c = *(LAS v4u*)(hist + 4 * lane);
    const unsigned t = c.x + c.y + c.z + c.w;
    const unsigned inc = wave_scan_incl(t);
    const unsigned total = lane_bcast(inc, 63);
    const unsigned sufx = total - inc;
    const bool found = (sufx < target) && (target <= sufx + t);
    unsigned mybin = 0, myab = 0;
    if (found) { unsigned a = sufx;
        if (a + c.w >= target) { mybin = 4 * lane + 3; myab = a; } else { a += c.w;
        if (a + c.z >= target) { mybin = 4 * lane + 2; myab = a; } else { a += c.z;
        if (a + c.y >= target) { mybin = 4 * lane + 1; myab = a; } else { a += c.y; mybin = 4 * lane; myab = a; } } } }
    const unsigned long long m = __ballot(found);
    const int src = m ? (int)__builtin_ctzll(m) : 0;
    bin = lane_bcast(mybin, src); above = lane_bcast(myab, src);
}

__device__ __forceinline__ void attn_unit(const Ctx& C, int l, int b, int qt) {
    const int lane = lane_now(), wid = C.wid, tid = wid * 64 + lane;
    const int p0 = 8 * qt, nk = p0 + 8, ntile = (nk + 31) >> 5, nkp = ntile * 32;
    LAS u16* SC = (LAS u16*)C.lds; LAS unsigned* HIST = (LAS unsigned*)(C.lds + LDS_HIST); LAS u16* IDX = (LAS u16*)(C.lds + LDS_IDX);
    for (int i = tid; i < 8 * 256; i += NT) HIST[i] = 0u;
    __syncthreads();
    const bf16* Z = C.Z();
    {
        const int r = lane & 31, half = lane >> 5;
        const int rowq = row_of(b, p0 + (r >> 2));
        bf16x8 Af[4];
#pragma unroll
        for (int s = 0; s < 4; ++s) Af[s] = *(const bf16x8*)(Z + (size_t)rowq * ZC + C_QI + (r & 3) * 64 + 16 * s + 8 * half);
        float wi[4][4];
#pragma unroll
        for (int g = 0; g < 4; ++g) { const int rg = row_of(b, p0 + 2 * g + half);
#pragma unroll
            for (int hh = 0; hh < 4; ++hh) wi[g][hh] = bf2f(Z[(size_t)rg * ZC + C_WI + hh]) * 0.0625f; }
        const unsigned char* kib = (const unsigned char*)(C.KI() + (size_t)b * TPAD * 64); const unsigned klane = (unsigned)lane * 16u;
        const unsigned char* kib2 = (const unsigned char*)(C.KI() + (size_t)((b + 1) & 3) * TPAD * 64);
#define SC_LOAD2(P, ka_, kb_) do { const int ka__ = (ka_), kb__ = (kb_); _Pragma("unroll") for (int s = 0; s < 4; ++s) { P[0][s] = *(const bf16x8*)(kib + ((unsigned)ka__ * 4096u + 1024u * s + klane)); P[1][s] = *(const bf16x8*)(kib + ((unsigned)kb__ * 4096u + 1024u * s + klane)); } } while (0)
#define SC_LOAD(P, kt_) do { _Pragma("unroll") for (int s = 0; s < 4; ++s) { P[0][s] = *(const bf16x8*)(kib + ((unsigned)(kt_) * 4096u + 1024u * s + klane)); P[1][s] = *(const bf16x8*)(kib + ((unsigned)((kt_) + 8) * 4096u + 1024u * s + klane)); \
    if (PROBE == 6) { bf16x8 d0 = *(const bf16x8*)(kib2 + ((unsigned)(kt_) * 4096u + 1024u * s + klane)), d1 = *(const bf16x8*)(kib2 + ((unsigned)((kt_) + 8) * 4096u + 1024u * s + klane)); asm volatile("" :: "v"(d0), "v"(d1)); } } } while (0)
#define SC_MFMA(acc, Bq) do { _Pragma("unroll") for (int e = 0; e < 16; ++e) acc[e] = 0.f; \
            _Pragma("unroll") for (int s = 0; s < 4; ++s) acc = __builtin_amdgcn_mfma_f32_32x32x16_bf16(Af[s], Bq[s], acc, 0, 0, 0); } while (0)
#define SC_KEY2(a_, b_) ({ const h2v hh_ = __builtin_convertvector((f32x2h){(a_), (b_)}, h2v); const unsigned w_ = __builtin_bit_cast(unsigned, hh_); \
            const s2v m_ = __builtin_bit_cast(s2v, w_) >> 15; w_ ^ (__builtin_bit_cast(unsigned, m_) | 0x80008000u); })
#define SC_SCORES(acc) float scv[4]; \
            _Pragma("unroll") for (int g = 0; g < 4; ++g) { \
                const float r0 = relu_i(acc[4 * g + 0]), r1 = relu_i(acc[4 * g + 1]), r2 = relu_i(acc[4 * g + 2]), r3 = relu_i(acc[4 * g + 3]); \
                scv[g] = __builtin_fmaf(wi[g][3], r3, __builtin_fmaf(wi[g][2], r2, __builtin_fmaf(wi[g][1], r1, wi[g][0] * r0))); } \
            const unsigned w01 = SC_KEY2(scv[0], scv[1]), w23 = SC_KEY2(scv[2], scv[3]);
#define SC_EMIT_FULL() do { \
                SC[(0 + half) * SCW + key] = (u16)w01; SC[(2 + half) * SCW + key] = (u16)(w01 >> 16); SC[(4 + half) * SCW + key] = (u16)w23; SC[(6 + half) * SCW + key] = (u16)(w23 >> 16); \
                atomicAdd((unsigned*)(HIST + (0 + half) * 256 + ((w01 >> 8) & 0xffu)), 1u); atomicAdd((unsigned*)(HIST + (2 + half) * 256 + (w01 >> 24)), 1u); \
                atomicAdd((unsigned*)(HIST + (4 + half) * 256 + ((w23 >> 8) & 0xffu)), 1u); atomicAdd((unsigned*)(HIST + (6 + half) * 256 + (w23 >> 24)), 1u); } while (0)
#define SC_VALU_FAST(acc, kt_) do { const int key = (kt_) * 32 + r; SC_SCORES(acc) SC_EMIT_FULL(); } while (0)
#define SC_VALU(acc, kt_) do { const int kt__ = (kt_); if (kt__ < ntile) { const int key = kt__ * 32 + r; SC_SCORES(acc) \
            if (kt__ * 32 + 31 <= p0) SC_EMIT_FULL(); \
            else { \
                _Pragma("unroll") for (int g = 0; g < 4; ++g) { const unsigned wp = g < 2 ? w01 : w23; unsigned k16 = (g & 1) ? (wp >> 16) : (wp & 0xffffu); \
                    const int qq = 2 * g + half; const bool valid = key <= p0 + qq; \
                    if (!valid) k16 = 0u; \
                    SC[qq * SCW + key] = (u16)k16; \
                    if (valid) atomicAdd((unsigned*)(HIST + qq * 256 + (k16 >> 8)), 1u); } } } } while (0)
        bf16x8 P0[2][4], P1[2][4], P2[2][4];
        _Pragma("unroll 1") for (int rep7 = 0, n7 = (PROBE == 7 ? launder2() : 1); rep7 < n7; ++rep7) {
        LAS unsigned* HISTsave = HIST; if (rep7) HIST = (LAS unsigned*)(C.lds + 144384);
        const int nst = (ntile + 7) >> 3, nfull = (p0 + 1) >> 5, jfull = nfull > wid ? (nfull - wid + 7) >> 3 : 0;
#define TIDX(j) (wid + 8 * (j))
#define TSAFE(j) ((j) < nst ? TIDX(j) : wid)
        SC_LOAD2(P0, TSAFE(0), TSAFE(1)); SC_LOAD2(P1, TSAFE(2), TSAFE(3));
        int j = 0;
        for (; j + 6 <= jfull; j += 6) {
            f32x16 acc0, acc1;
            SC_LOAD2(P2, TSAFE(j + 4), TSAFE(j + 5));
            SC_MFMA(acc0, P0[0]); SC_MFMA(acc1, P0[1]); SC_VALU_FAST(acc0, TIDX(j)); SC_VALU_FAST(acc1, TIDX(j + 1));
            SC_LOAD2(P0, TSAFE(j + 6), TSAFE(j + 7));
            SC_MFMA(acc0, P1[0]); SC_MFMA(acc1, P1[1]); SC_VALU_FAST(acc0, TIDX(j + 2)); SC_VALU_FAST(acc1, TIDX(j + 3));
            SC_LOAD2(P1, TSAFE(j + 8), TSAFE(j + 9));
            SC_MFMA(acc0, P2[0]); SC_MFMA(acc1, P2[1]); SC_VALU_FAST(acc0, TIDX(j + 4)); SC_VALU_FAST(acc1, TIDX(j + 5));
        }
        for (; j < nst; j += 6) {
            f32x16 acc0, acc1;
            SC_LOAD2(P2, TSAFE(j + 4), TSAFE(j + 5));
            SC_MFMA(acc0, P0[0]); SC_MFMA(acc1, P0[1]); SC_VALU(acc0, TSAFE(j)); if (j + 1 < nst) SC_VALU(acc1, TIDX(j + 1));
            SC_LOAD2(P0, TSAFE(j + 6), TSAFE(j + 7));
            SC_MFMA(acc0, P1[0]); SC_MFMA(acc1, P1[1]); if (j + 2 < nst) SC_VALU(acc0, TIDX(j + 2)); if (j + 3 < nst) SC_VALU(acc1, TIDX(j + 3));
            SC_LOAD2(P1, TSAFE(j + 8), TSAFE(j + 9));
            SC_MFMA(acc0, P2[0]); SC_MFMA(acc1, P2[1]); if (j + 4 < nst) SC_VALU(acc0, TIDX(j + 4)); if (j + 5 < nst) SC_VALU(acc1, TIDX(j + 5));
        }
#undef TIDX
#undef TSAFE
        HIST = HISTsave; }
#undef SC_LOAD
#undef SC_LOAD2
#undef SC_MFMA
#undef SC_VALU
#undef SC_VALU_FAST
#undef SC_SCORES
#undef SC_EMIT_FULL
#undef SC_KEY2
    }
    __syncthreads();
    const int q = wid, p = p0 + q, nvalid = p + 1, nsel = nvalid < 256 ? nvalid : 256;
    LAS u16* sc = SC + q * SCW; LAS unsigned* hist = HIST + q * 256; LAS u16* idx = IDX + q * 256;
    if (nvalid <= 256) { for (int i = lane; i < nvalid; i += 64) idx[i] = (u16)i; }
    else {
        unsigned b1, ab1; find_bin(hist, 256u, lane, b1, ab1);
        _Pragma("unroll 1") for (int rep8 = 0, n8 = (PROBE == 8 ? launder2() : 1); rep8 < n8; ++rep8) {
        asm volatile("s_waitcnt lgkmcnt(0)" ::: "memory");
        { unsigned z_ = 0u; asm volatile("" : "+v"(z_)); *(LAS v4u*)(hist + 4 * lane) = (v4u){z_, z_, z_, z_}; }
        asm volatile("s_waitcnt lgkmcnt(0)" ::: "memory");
        const int niter = (nkp + 255) >> 8;
        {   v2u cur = 4 * lane < nkp ? *(LAS v2u*)(sc + 4 * lane) : (v2u){0u, 0u};
            for (int it = 0; it < niter; ++it) { const int in = (it + 1) * 256 + 4 * lane; const v2u nxt = in < nkp ? *(LAS v2u*)(sc + in) : (v2u){0u, 0u};
                const unsigned k0 = cur.x & 0xffffu, k1 = cur.x >> 16, k2 = cur.y & 0xffffu, k3 = cur.y >> 16;
                if ((k0 >> 8) == b1) atomicAdd((unsigned*)(hist + (k0 & 255u)), 1u);
                if ((k1 >> 8) == b1) atomicAdd((unsigned*)(hist + (k1 & 255u)), 1u);
                if ((k2 >> 8) == b1) atomicAdd((unsigned*)(hist + (k2 & 255u)), 1u);
                if ((k3 >> 8) == b1) atomicAdd((unsigned*)(hist + (k3 & 255u)), 1u);
                cur = nxt; } }
        asm volatile("s_waitcnt lgkmcnt(0)" ::: "memory");
        unsigned b2, ab2; find_bin(hist, 256u - ab1, lane, b2, ab2);
        const unsigned T16 = (b1 << 8) | b2; const unsigned need_eq = 256u - ab1 - ab2;
        unsigned eq_base = 0u;
        LAS unsigned* bmp = (LAS unsigned*)sc;
        unsigned c0 = lane < nkp ? sc[lane] : 0u, c1 = 64 + lane < nkp ? sc[64 + lane] : 0u, c2 = 128 + lane < nkp ? sc[128 + lane] : 0u, c3 = 192 + lane < nkp ? sc[192 + lane] : 0u;
        for (int it = 0; it < niter; ++it) { const int nb = (it + 1) * 256 + lane;
            const unsigned n0 = nb < nkp ? sc[nb] : 0u, n1 = nb + 64 < nkp ? sc[nb + 64] : 0u, n2 = nb + 128 < nkp ? sc[nb + 128] : 0u, n3 = nb + 192 < nkp ? sc[nb + 192] : 0u;
            const unsigned k[4] = {c0, c1, c2, c3};
            unsigned long long mt[4];
#pragma unroll
            for (int j = 0; j < 4; ++j) mt[j] = __ballot(k[j] > T16);
            if (__ballot(k[0] == T16 || k[1] == T16 || k[2] == T16 || k[3] == T16)) {
#pragma unroll
                for (int j = 0; j < 4; ++j) { const bool eq = k[j] == T16; const unsigned long long me = __ballot(eq);
                    mt[j] |= __ballot(eq && (eq_base + mbcnt64(me)) < need_eq); eq_base += (unsigned)__popcll(me); }
            }
            if (lane == 0) { *(LAS v4u*)(bmp + it * 8) = (v4u){(unsigned)mt[0], (unsigned)(mt[0] >> 32), (unsigned)mt[1], (unsigned)(mt[1] >> 32)};
                             *(LAS v4u*)(bmp + it * 8 + 4) = (v4u){(unsigned)mt[2], (unsigned)(mt[2] >> 32), (unsigned)mt[3], (unsigned)(mt[3] >> 32)}; }
            c0 = n0; c1 = n1; c2 = n2; c3 = n3; }
        asm volatile("s_waitcnt lgkmcnt(0)" ::: "memory");
        {
            const int ndw = niter * 8;
            v4u d4 = (v4u){0u, 0u, 0u, 0u};
            if (4 * lane < ndw) d4 = *(const LAS v4u*)(bmp + 4 * lane);
            const unsigned cnt = (unsigned)(__builtin_popcount(d4.x) + __builtin_popcount(d4.y) + __builtin_popcount(d4.z) + __builtin_popcount(d4.w));
            const unsigned inc = wave_scan_incl(cnt);
            unsigned pos = inc - cnt; const unsigned tot = lane_bcast(inc, 63);
            const unsigned dt = ndw > 256 ? bmp[256] : 0u;
#pragma unroll
            for (int w = 0; w < 4; ++w) { unsigned d = d4[w]; while (d) { const unsigned bit = (unsigned)__builtin_ctz(d); if (pos < 256u) idx[pos] = (u16)((4 * lane + w) * 32 + bit); ++pos; d &= d - 1u; } }
            if (lane == 0) { unsigned d = dt, ps = tot; while (d) { const unsigned bit = (unsigned)__builtin_ctz(d); if (ps < 256u) idx[ps] = (u16)(8192u + bit); ++ps; d &= d - 1u; } }
        }
        }
    }
    asm volatile("s_waitcnt lgkmcnt(0)" ::: "memory");
    if (p < NMETA && b != 0) return;
    const int row = row_of(b, p);
    if (nsel < 256) { for (int i = nsel + lane; i < 256; i += 64) idx[i] = (u16)0; asm volatile("s_waitcnt lgkmcnt(0)" ::: "memory"); }
    _Pragma("unroll 1") for (int rep9 = 0, n9 = (PROBE == 9 ? launder2() : 1); rep9 < n9; ++rep9)
    {
        const int g = lane >> 4, c = lane & 15;
        const bf16x8 zero8 = (bf16x8){0, 0, 0, 0, 0, 0, 0, 0};
        bf16x8 qB[2];
#pragma unroll
        for (int ks = 0; ks < 2; ++ks) qB[ks] = c < 8 ? *(const bf16x8*)(Z + (size_t)row * ZC + C_Q + c * 64 + 32 * ks + 8 * g) : zero8;
        const unsigned char* kbase = (const unsigned char*)(C.KATT() + (size_t)b * TPAD * 64);
        f32x4 S[16];
        {
            bf16x8 Kf0[8][2], Kf1[8][2];
#pragma unroll
            for (int t4 = 0; t4 < 8; ++t4) { const int slot = 16 * t4 + c; const int kix = (int)idx[slot];
                const unsigned ko = (unsigned)kix * 128u + 16u * (unsigned)g; Kf0[t4][0] = *(const bf16x8*)(kbase + ko); Kf0[t4][1] = *(const bf16x8*)(kbase + ko + 64u); }
#pragma unroll
            for (int t4 = 0; t4 < 8; ++t4) { const int slot = 16 * (8 + t4) + c; const int kix = (int)idx[slot];
                const unsigned ko = (unsigned)kix * 128u + 16u * (unsigned)g; Kf1[t4][0] = *(const bf16x8*)(kbase + ko); Kf1[t4][1] = *(const bf16x8*)(kbase + ko + 64u); }
#pragma unroll
            for (int t4 = 0; t4 < 8; ++t4) S[t4] = mfma16(Kf0[t4][0], qB[0], (f32x4){0.f, 0.f, 0.f, 0.f});
#pragma unroll
            for (int t4 = 0; t4 < 8; ++t4) S[t4] = mfma16(Kf0[t4][1], qB[1], S[t4]);
#pragma unroll
            for (int t4 = 0; t4 < 8; ++t4) S[8 + t4] = mfma16(Kf1[t4][0], qB[0], (f32x4){0.f, 0.f, 0.f, 0.f});
#pragma unroll
            for (int t4 = 0; t4 < 8; ++t4) S[8 + t4] = mfma16(Kf1[t4][1], qB[1], S[8 + t4]);
            asm volatile("" ::: "memory");
        }
        LAS unsigned char* VL = (LAS unsigned char*)sc;
        const unsigned char* vbase = (const unsigned char*)(C.VATT() + (size_t)b * TPAD * 64);
        const unsigned tr_base = (unsigned)(size_t)VL + (unsigned)(((4 * g + ((lane & 15) >> 2)) * 64 + 4 * (lane & 3)) * 2);
        v4u vv0[16], vv1[16];
#define V_GATHER(vv, hf, i0, i1) do { _Pragma("unroll") for (int i = (i0); i < (i1); ++i) { const int e = i * 64 + lane; const int sl = (hf) * 128 + (e >> 3); const int kix = (int)idx[sl]; \
            vv[i] = *(const v4u*)(vbase + ((unsigned)kix * 128u + (unsigned)(e & 7) * 16u)); } } while (0)
        V_GATHER(vv0, 0, 0, 16);
        asm volatile("" ::: "memory");
        if (nsel < 256) {
#pragma unroll
            for (int kt = 0; kt < 16; ++kt)
#pragma unroll
                for (int r = 0; r < 4; ++r) { const int slot = 16 * kt + 4 * g + r; if (slot >= nsel) S[kt][r] = -INFINITY; }
        }
        float mx = -INFINITY;
#pragma unroll
        for (int kt = 0; kt < 16; ++kt)
#pragma unroll
            for (int r = 0; r < 4; ++r) mx = fmaxf(mx, S[kt][r]);
        mx = xor16_max(mx); mx = xor32_max(mx);
        const float sl2 = 0.125f * 1.4426950408889634f, m2 = mx * sl2;
        float sum = 0.f;
#pragma unroll
        for (int kt = 0; kt < 16; ++kt)
#pragma unroll
            for (int r = 0; r < 4; ++r) { const float e = __builtin_amdgcn_exp2f(__builtin_fmaf(S[kt][r], sl2, -m2)); S[kt][r] = e; sum += e; }
        sum = xor16_sum(sum); sum = xor32_sum(sum);
        const float inv = __builtin_amdgcn_rcpf(sum);
        f32x4 O[4];
#pragma unroll
        for (int dt = 0; dt < 4; ++dt) O[dt] = (f32x4){0.f, 0.f, 0.f, 0.f};
        asm volatile("" ::: "memory");
        V_GATHER(vv1, 1, 0, 8);
        asm volatile("" ::: "memory");
#define PV_HALF(vv, hf) do { \
            _Pragma("unroll") for (int i = 0; i < 16; ++i) *(LAS v4u*)(VL + (i * 64 + lane) * 16) = vv[i]; \
            if ((hf) == 0) { asm volatile("" ::: "memory"); V_GATHER(vv1, 1, 8, 16); } \
            asm volatile("s_waitcnt lgkmcnt(0)" ::: "memory"); \
            _Pragma("unroll") for (int kk = 0; kk < 4; ++kk) { \
                const bf16x8 Bp = cat8(pack4(S[(hf) * 8 + 2 * kk]), pack4(S[(hf) * 8 + 2 * kk + 1])); \
                s16x4 lo0, hi0, lo1, hi1, lo2, hi2, lo3, hi3; \
                asm volatile("ds_read_b64_tr_b16 %0, %8 offset:%c9\n\tds_read_b64_tr_b16 %1, %8 offset:%c10\n\tds_read_b64_tr_b16 %2, %8 offset:%c11\n\tds_read_b64_tr_b16 %3, %8 offset:%c12\n\t" \
                             "ds_read_b64_tr_b16 %4, %8 offset:%c13\n\tds_read_b64_tr_b16 %5, %8 offset:%c14\n\tds_read_b64_tr_b16 %6, %8 offset:%c15\n\tds_read_b64_tr_b16 %7, %8 offset:%c16\n\ts_waitcnt lgkmcnt(0)" \
                             : "=&v"(lo0), "=&v"(hi0), "=&v"(lo1), "=&v"(hi1), "=&v"(lo2), "=&v"(hi2), "=&v"(lo3), "=&v"(hi3) \
                             : "v"(tr_base), "i"(kk * 4096), "i"(kk * 4096 + 2048), "i"(kk * 4096 + 32), "i"(kk * 4096 + 32 + 2048), "i"(kk * 4096 + 64), "i"(kk * 4096 + 64 + 2048), "i"(kk * 4096 + 96), "i"(kk * 4096 + 96 + 2048) : "memory"); \
                O[0] = mfma16(cat8(lo0, hi0), Bp, O[0]); O[1] = mfma16(cat8(lo1, hi1), Bp, O[1]); O[2] = mfma16(cat8(lo2, hi2), Bp, O[2]); O[3] = mfma16(cat8(lo3, hi3), Bp, O[3]); } \
            asm volatile("" ::: "memory"); } while (0)
        PV_HALF(vv0, 0);
        PV_HALF(vv1, 1);
#undef V_GATHER
#undef PV_HALF
        if (c < 8) {
#pragma unroll
            for (int dt = 0; dt < 4; ++dt) { const f32x4 o = O[dt] * inv; *(v2u*)(C.U() + (size_t)row * DM + c * 64 + 16 * dt + 4 * g) = (v2u){pk2(o.x, o.y), pk2(o.z, o.w)}; }
        }
    }
}

constexpr int NUNITS = 1026 * NB;
__device__ __forceinline__ void phase_seq(const Ctx& C, int l, int half) {
    unsigned* ctr = C.CTL() + 64 + 64 * l;
    unsigned* done = C.CTL() + 64 * 8 + 64 * (2 * l + half);
    unsigned* flagw = C.CTL() + 64 * (40 + 2 * l + half);
    if (C.bid == 16 || C.bid == 17) {
        const int bhl = (C.bid - 16) * 8 + C.wid;
        { unsigned char* po = prep_unit<false>(C, l, 16 * half + bhl, bhl, 512, C.lds + C.wid * SLOT, nullptr); prep_copy(C.lds + C.wid * SLOT, po, lane_now()); }
        asm volatile("s_waitcnt vmcnt(0)" ::: "memory"); __syncthreads();
        if (C.wid == 0 && lane_now() == 0) { __builtin_amdgcn_fence(__ATOMIC_RELEASE, "agent"); asm volatile("s_waitcnt vmcnt(0)" ::: "memory"); __hip_atomic_fetch_add(flagw, 1u, __ATOMIC_RELAXED, __HIP_MEMORY_SCOPE_AGENT); }
        __syncthreads();
    }
    if (C.bid < 16) { _Pragma("unroll 1") for (int rep4 = 0, n4 = (PROBE == 4 ? launder2() : 1); rep4 < n4; ++rep4) { chain_phase(C, 16 * half + C.bid, C.bid, flagw); __syncthreads(); }
        if (C.wid == 0 && lane_now() == 0) __hip_atomic_fetch_add(done, 1u, __ATOMIC_RELAXED, __HIP_MEMORY_SCOPE_AGENT); }
    LAS unsigned* shu = (LAS unsigned*)(C.lds + LDS_MISC);
    _Pragma("unroll 1") for (int rep5 = 0, n5 = ((PROBE == 5 && half == 1) ? launder2() : 1); rep5 < n5; ++rep5) {
    int bpref = (int)(((unsigned)__builtin_amdgcn_s_getreg((3 << 11) | 20) & 7u) >> 1);
    unsigned* cb = C.CTL() + 64 * (16 + 8 * l + 4 * rep5);
    auto fetch = [&](int& bp) -> unsigned {
        if (half == 0 && __hip_atomic_load(done, __ATOMIC_RELAXED, __HIP_MEMORY_SCOPE_AGENT) >= 16u) return 0xffffffffu;
        for (int t = 0; t < 4; ++t) { const unsigned u = atomicAdd(cb + bp, 1u); if (u < 1026u) return u | ((unsigned)bp << 16); bp = (bp + 1) & 3; }
        return 0xffffffffu; };
    unsigned nxt = 0xffffffffu;
    if (C.wid == 0 && lane_now() == 0) shu[0] = fetch(bpref);
    __syncthreads();
    for (;;) {
        const unsigned u = shu[0];
        __syncthreads();
        if (u == 0xffffffffu) break;
        if (C.wid == 0 && lane_now() == 0) nxt = fetch(bpref);
        const int qt = 1025 - (int)(u & 0xffffu), b = (int)(u >> 16);
        if (!(qt < 2 && b != 0)) attn_unit(C, l, b, qt);
        __syncthreads();
        if (C.wid == 0 && lane_now() == 0) shu[0] = nxt;
        __syncthreads();
    }
    }
}

template <int ACT>
__device__ __forceinline__ void meta_gemm(const Ctx& C, const bf16* A, const bf16* Bt, int K, int N, bf16* O, int ldc) {
    int lane_ = lane_now(); const int lane = lane_, g = lane >> 4, c = lane & 15, wid = C.wid;
    LAS float* red = (LAS float*)C.lds;
    const int kw = K / NWAVES;
    for (int unit = C.bid; unit < N / 16; unit += C.G) {
        const bf16* ap = A + (size_t)(MAINR + c) * K + wid * kw + 8 * g; const bf16* bp = Bt + (size_t)(unit * 16 + c) * K + wid * kw + 8 * g;
        f32x4 acc = (f32x4){0.f, 0.f, 0.f, 0.f};
        for (int k0 = 0; k0 < kw; k0 += 128) {
            bf16x8 af[4], bfr[4];
#pragma unroll
            for (int s = 0; s < 4; ++s) { af[s] = *(const bf16x8*)(ap + k0 + 32 * s); bfr[s] = *(const bf16x8*)(bp + k0 + 32 * s); }
#pragma unroll
            for (int s = 0; s < 4; ++s) acc = mfma16(af[s], bfr[s], acc);
        }
        *(LAS f32x4*)(red + (wid * 64 + lane) * 4) = acc;
        __syncthreads();
        if (wid == 0) {
            f32x4 t = acc;
#pragma unroll
            for (int w = 1; w < NWAVES; ++w) t = t + *(const LAS f32x4*)(red + (w * 64 + lane) * 4);
#pragma unroll
            for (int r = 0; r < 4; ++r) { float v = t[r]; if (ACT == 2) { v = fmaxf(v, 0.f); v = v * v; }
                O[(size_t)(MAINR + 4 * g + r) * ldc + unit * 16 + c] = (bf16)f2bf(v); }
        }
        __syncthreads();
    }
}

template <int ACT, bool OUT8>
__device__ __forceinline__ void meta_gemm8(const Ctx& C, const unsigned char* A, const unsigned char* Bt, int K, int N, void* Ov, int ldc, float omul, float hmul) {
    int lane_ = lane_now(); const int lane = lane_, g = lane >> 4, c = lane & 15, wid = C.wid;
    LAS float* red = (LAS float*)C.lds;
    const int kw = K / NWAVES;
    for (int unit = C.bid; unit < N / 16; unit += C.G) {
        const unsigned char* ap = A + (size_t)(MAINR + c) * K + wid * kw + 8 * g; const unsigned char* bp = Bt + (size_t)(unit * 16 + c) * K + wid * kw + 8 * g;
        f32x4 acc = (f32x4){0.f, 0.f, 0.f, 0.f};
        for (int k0 = 0; k0 < kw; k0 += 128) {
            long af[4], bfr[4];
#pragma unroll
            for (int s = 0; s < 4; ++s) { af[s] = *(const long*)(ap + k0 + 32 * s); bfr[s] = *(const long*)(bp + k0 + 32 * s); }
#pragma unroll
            for (int s = 0; s < 4; ++s) acc = __builtin_amdgcn_mfma_f32_16x16x32_fp8_fp8(af[s], bfr[s], acc, 0, 0, 0);
        }
        *(LAS f32x4*)(red + (wid * 64 + lane) * 4) = acc;
        __syncthreads();
        if (wid == 0) {
            f32x4 t = acc;
#pragma unroll
            for (int w = 1; w < NWAVES; ++w) t = t + *(const LAS f32x4*)(red + (w * 64 + lane) * 4);
#pragma unroll
            for (int r = 0; r < 4; ++r) { float v = t[r] * omul; if (ACT == 2) { v = fmaxf(v, 0.f); v = v * v; }
                if (OUT8) ((unsigned char*)Ov)[(size_t)(MAINR + 4 * g + r) * ldc + unit * 16 + c] = (unsigned char)(pk4_fp8(v * hmul, 0.f, 0.f, 0.f) & 0xffu);
                else ((bf16*)Ov)[(size_t)(MAINR + 4 * g + r) * ldc + unit * 16 + c] = (bf16)f2bf(v); }
        }
        __syncthreads();
    }
}

#define XLAS __attribute__((address_space(3)))
#define XB_TMO      128
#define XB_XCNT(j)  (256  + 64 * (j))
#define XB_XSUB(j)  (1280 + 64 * (j))
#define XB_XGEN(j)  (2304 + 64 * (j))
#define XB_TOP      3328
#define XB_TOPGEN   3392
#define XCD_BAR_WORDS 3456
#define XB_SPIN_CAP (1u << 18)

__device__ __forceinline__ unsigned xb_ld(unsigned* p)              { return __hip_atomic_load(p, __ATOMIC_RELAXED, __HIP_MEMORY_SCOPE_AGENT); }
__device__ __forceinline__ unsigned xb_add(unsigned* p, unsigned v) { return __hip_atomic_fetch_add(p, v, __ATOMIC_RELAXED, __HIP_MEMORY_SCOPE_AGENT); }
__device__ __forceinline__ unsigned xb_xcc_id() { return (unsigned)__builtin_amdgcn_s_getreg((3 << 11) | 20) & 0xFu; }
#define XB_SPIN(cond, bar) do { unsigned _sp = 0; while (cond) { __builtin_amdgcn_s_sleep(1); \
    if ((++_sp & 255u) == 0u) { if (xb_ld(&(bar)[XB_TMO])) break; if (_sp > XB_SPIN_CAP) { atomicAdd(&(bar)[XB_TMO], 1u); break; } } } } while (0)

struct XcdBarrier {
    unsigned* bar; unsigned x;
    int w; bool first;
    volatile XLAS unsigned* st;
};

__device__ __forceinline__ XcdBarrier xcd_barrier_post(unsigned* bar, volatile XLAS unsigned* st, int wid0) {
    XcdBarrier b; b.bar = bar; b.x = xb_xcc_id(); b.st = st; b.w = wid0; b.first = wid0 == 0 && lane_now() == 0;
    if (b.first) (void)xb_add(&bar[XB_XCNT(b.x)], 1u);
    return b;
}
__device__ __forceinline__ void xcd_barrier_complete(unsigned* bar, unsigned x, unsigned& nloc, unsigned& nx) {
    const unsigned G = gridDim.x * gridDim.y * gridDim.z;
    unsigned sum, cnt, mine, sp = 0u;
    for (;;) {
        sum = 0u; cnt = 0u; mine = 0u;
#pragma unroll
        for (unsigned j = 0; j < 16; ++j) { const unsigned c = xb_ld(&bar[XB_XCNT(j)]); sum += c; cnt += (c > 0u) ? 1u : 0u; mine = (j == x) ? c : mine; }
        if (sum == G) break;
        __builtin_amdgcn_s_sleep(1);
        if ((++sp & 255u) == 0u) { if (xb_ld(&bar[XB_TMO])) break; if (sp > XB_SPIN_CAP) { atomicAdd(&bar[XB_TMO], 1u); break; } }
    }
    nloc = mine > 0u ? mine : 1u; nx = cnt > 0u ? cnt : 1u;
}

__device__ __forceinline__ void xcd_barrier(const XcdBarrier& b) {
    asm volatile("s_waitcnt vmcnt(0)" ::: "memory");
    __syncthreads();
    if (b.w == 0 && lane_now() == 0) {
        unsigned* bar = b.bar;
        __builtin_amdgcn_s_waitcnt(0);
        unsigned nloc = b.st[0], nx = b.st[1];
        if (nloc == 0u) { xcd_barrier_complete(bar, b.x, nloc, nx); b.st[0] = nloc; b.st[1] = nx; }
        const unsigned old = xb_add(&bar[XB_XSUB(b.x)], 1u);
        const unsigned gen = old / nloc;
        if (old + 1u == (gen + 1u) * nloc) {
            __builtin_amdgcn_fence(__ATOMIC_RELEASE, "agent");
            asm volatile("s_waitcnt vmcnt(0)" ::: "memory");
            const unsigned og = xb_add(&bar[XB_TOP], 1u);
            const unsigned tg = og / nx;
            if (og + 1u == (tg + 1u) * nx) xb_add(&bar[XB_TOPGEN], 1u);
            else XB_SPIN(xb_ld(&bar[XB_TOPGEN]) == tg, bar);
            __builtin_amdgcn_fence(__ATOMIC_ACQUIRE, "agent");
            xb_add(&bar[XB_XGEN(b.x)], 1u);
            asm volatile("s_waitcnt vmcnt(0)" ::: "memory");
        } else {
            XB_SPIN(xb_ld(&bar[XB_XGEN(b.x)]) == gen, bar);
            __builtin_amdgcn_fence(__ATOMIC_ACQUIRE, "agent");
            asm volatile("s_waitcnt vmcnt(0)" ::: "memory");
        }
    }
    __syncthreads();
}

__global__ void __launch_bounds__(NT, 2) fwd_kernel(Args args) {
    extern __shared__ __attribute__((aligned(16))) unsigned char lds_raw[];
    Ctx C; C.ppass = 0; C.in = args.in; C.out = args.out; C.ws = args.ws; C.lds = (LAS unsigned char*)lds_raw;
    int wid0 = __builtin_amdgcn_readfirstlane(threadIdx.x >> 6); asm volatile("" : "+s"(wid0));
    C.wid = wid0; C.lane = lane_now(); C.tid = wid0 * 64 + C.lane; C.G = gridDim.x; C.bid = blockIdx.x;
    const int lo = args.ph_lo, hi = args.ph_hi;
    int ph = 0;
    volatile XLAS unsigned* bst = (volatile XLAS unsigned*)(C.lds + LDS_BYTES - 64);
    if (C.tid < 2) bst[C.tid] = 0u;
    __syncthreads();
    const XcdBarrier bar = xcd_barrier_post(C.CTL() + 4096, bst, wid0);
#define REPLOOP _Pragma("unroll 1") for (int rep = 0, nrep_ = launder2(); rep < nrep_; ++rep)
#define NOREP for (int rep = 0; rep < 1; ++rep)
#if PROBE == 1 || PROBE == 11 || PROBE == 12
#define REP1 REPLOOP
#else
#define REP1 NOREP
#endif
#if PROBE == 2
#define REP2 REPLOOP
#else
#define REP2 NOREP
#endif
#if PROBE == 3
#define REP3 REPLOOP
#else
#define REP3 NOREP
#endif
#ifndef PHSEL
#define PHSEL 0xffff
#endif
#define PHASE_BEGIN if (ph >= lo && ph < hi) { { const int l_ = lane_now(); C.lane = l_; C.wid = wid0; C.tid = wid0 * 64 + l_; }
#define PHASE_END(last) if (ph + 1 < hi && !(last)) xcd_barrier(bar); } ++ph;

    PHASE_BEGIN if (PHSEL & (1 << 0)) { phase_prologue(C); phase_norm<false, false>(C, C.I(I_X), nullptr, nullptr, nullptr, C.I(I_NMPRE), C.I(I_META)); } PHASE_END(false)
    for (int l = 0; l < NL; ++l) {
        PHASE_BEGIN if (PHSEL & (1 << 2)) { REP3 { pg8::Gemm g{C.U(), (const bf16*)(C.ws + WS_WIN) + (size_t)l * ZC * 1024, MAINR, ZC, 1024}; pg8::StaticOrder S; S.init(MAINR, ZC, C.G, C.bid);
            pg8::EpiBf16<0> E{C.Z(), ZC}; pg8::gemm_phase<pg8::EpiBf16<0>, pg8::StaticOrder, true, true>(C.lds, g, S, E, C.tid); __syncthreads(); } meta_gemm<0>(C, C.U(), (const bf16*)(C.ws + WS_WIN) + (size_t)l * ZC * 1024, 1024, ZC, C.Z(), ZC); } PHASE_END(false)
        PHASE_BEGIN if (PHSEL & (1 << 3)) { REP2 phase_post(C, l, rep == 0); } PHASE_END(false)
        PHASE_BEGIN if (PHSEL & (1 << 4)) { REP1 { C.ppass = rep; phase_prep(C, l, 0); C.ppass = 0; } } PHASE_END(false)
        PHASE_BEGIN if (PHSEL & (1 << 10)) phase_seq(C, l, 0); PHASE_END(false)
        PHASE_BEGIN if (PHSEL & (1 << 4)) { REP1 { C.ppass = rep; phase_prep(C, l, 1); C.ppass = 0; } } PHASE_END(false)
        PHASE_BEGIN if (PHSEL & (1 << 10)) phase_seq(C, l, 1); PHASE_END(false)
        PHASE_BEGIN if (PHSEL & (1 << 5)) { REP3 { pg8::Gemm g{C.U(), (const bf16*)(C.ws + WS_WO) + (size_t)l * 1024 * 1024, MAINR, DM, 1024}; pg8::StaticOrder S; S.init(MAINR, DM, C.G, C.bid);
            pg8::EpiBf16<0> E{C.Z(), DM}; pg8::gemm_phase<pg8::EpiBf16<0>, pg8::StaticOrder, true, true>(C.lds, g, S, E, C.tid); __syncthreads(); } meta_gemm<0>(C, C.U(), (const bf16*)(C.ws + WS_WO) + (size_t)l * 1024 * 1024, 1024, DM, C.Z(), DM); } PHASE_END(false)
        PHASE_BEGIN if (PHSEL & (1 << 6)) { void* hmid = (l + 1 == NL) ? (void*)(C.ws + WS_HMID) : (void*)C.out;
            if (l == 0) phase_norm<false, true>(C, C.I(I_X), hmid, C.Z(), C.I(I_NMPOST) + l * DM, C.I(I_NFPRE) + l * DM, nullptr, true);
            else phase_norm<true, true>(C, C.out, hmid, C.Z(), C.I(I_NMPOST) + l * DM, C.I(I_NFPRE) + l * DM, nullptr, true); } PHASE_END(false)
        PHASE_BEGIN if (PHSEL & (1 << 7)) { REP3 { pg8::Gemm g{(const bf16*)C.U(), (const bf16*)(C.ws + WS_WUP + (size_t)l * FF * 1024), MAINR, FF, 512}; pg8::StaticOrder S; S.init(MAINR, FF, C.G, C.bid);
            pg8::EpiFp8<2> E{C.ws + WS_HID, FF, S8_H}; pg8::gemm_phase<pg8::EpiFp8<2>, pg8::StaticOrder, true, true, true, E8_WU, E8_X>(C.lds, g, S, E, C.tid); __syncthreads(); }
            meta_gemm8<2, true>(C, (const unsigned char*)C.U(), C.ws + WS_WUP + (size_t)l * FF * 1024, 1024, FF, C.ws + WS_HID, FF, 1.f / (S8_X * S8_WU), S8_H); } PHASE_END(false)
        PHASE_BEGIN if (PHSEL & (1 << 8)) { REP3 { pg8::Gemm g{(const bf16*)(C.ws + WS_HID), (const bf16*)(C.ws + WS_WDN + (size_t)l * DM * FF), MAINR, DM, FF / 2}; pg8::StaticOrder S; S.init(MAINR, DM, C.G, C.bid);
            pg8::EpiBf16<0> E{(bf16*)(C.ws + WS_TMP2), DM}; pg8::gemm_phase<pg8::EpiBf16<0>, pg8::StaticOrder, true, true, true, E8_WD, E8_H>(C.lds, g, S, E, C.tid); __syncthreads(); }
            meta_gemm8<0, false>(C, C.ws + WS_HID, C.ws + WS_WDN + (size_t)l * DM * FF, FF, DM, C.ws + WS_TMP2, DM, 1.f / (S8_H * S8_WD), 1.f); } PHASE_END(false)
        PHASE_BEGIN if (PHSEL & (1 << 9)) { if (l + 1 < NL) phase_norm<true, true>(C, C.out, C.out, (const bf16*)(C.ws + WS_TMP2), C.I(I_NFPOST) + l * DM, C.I(I_NMPRE) + (l + 1) * DM);
            else phase_norm<true, false>(C, C.ws + WS_HMID, C.out, (const bf16*)(C.ws + WS_TMP2), C.I(I_NFPOST) + l * DM, nullptr); } PHASE_END(l + 1 == NL)
    }
}

extern "C" void kernel_launch(void* const* d_in, const int* in_sizes, int n_in, void* d_out, int out_size, void* d_ws, size_t ws_size, hipStream_t stream) {
    static int grid = 0;
    if (grid == 0) {
        if (n_in != 30 || out_size != NB * SEQ * DM || ws_size < WS_END) { fprintf(stderr, "kernel_launch: unexpected shapes (n_in %d out %d ws %zu need %zu)\n", n_in, out_size, ws_size, (size_t)WS_END); grid = -1; return; }
        int dev = 0, cus = 0, per_cu = 0;
        (void)hipGetDevice(&dev); (void)hipDeviceGetAttribute(&cus, hipDeviceAttributeMultiprocessorCount, dev);
        (void)hipFuncSetAttribute((const void*)fwd_kernel, hipFuncAttributeMaxDynamicSharedMemorySize, LDS_BYTES);
        (void)hipOccupancyMaxActiveBlocksPerMultiprocessor(&per_cu, (const void*)fwd_kernel, NT, LDS_BYTES);
        (void)hipGetLastError();
        grid = cus;
        fprintf(stderr, "kernel_launch: cus %d per_cu %d ws %zu\n", cus, per_cu, ws_size);
    }
    if (grid < 0) return;
    (void)hipMemsetAsync((char*)d_ws + WS_CTL, 0, CTL_BYTES, stream);
    Args a{};
    for (int i = 0; i < 30; ++i) a.in[i] = (const float*)d_in[i];
    a.out = (float*)d_out; a.ws = (unsigned char*)d_ws;
    a.ph_lo = 0; a.ph_hi = 1000;
    void* kargs[] = {&a};
    hipError_t e = hipLaunchCooperativeKernel((const void*)fwd_kernel, dim3(grid), dim3(NT), kargs, LDS_BYTES, stream);
    if (e != hipSuccess) fprintf(stderr, "kernel_launch: cooperative launch failed: %s\n", hipGetErrorString(e));
}
```

```cpp
#include <hip/hip_runtime.h>
#include <hip/hip_cooperative_groups.h>
#include <cstdio>
#include <cstdint>
namespace cg = cooperative_groups;
namespace pg8 {
#define PG8_LAS __attribute__((address_space(3)))
typedef unsigned short bf16_t;
typedef short bf16x8 __attribute__((ext_vector_type(8)));
typedef float f32x4 __attribute__((ext_vector_type(4)));
typedef unsigned u32x4 __attribute__((ext_vector_type(4)));
typedef int i32x8 __attribute__((ext_vector_type(8)));
typedef int i32x4 __attribute__((ext_vector_type(4)));
constexpr int BM = 256, BK = 64, HALF = 128, HTB = HALF * BK * 2  , STAGE_BYTES = 8 * HTB, NXCD = 8, WGM = 8;

__host__ __device__ __forceinline__ int lds_byte(int r, int c) { const int st = (r >> 4) * 2 + (c >> 5), rr = r & 15, cc = c & 31, ob = rr * 64 + cc * 2; return st * 1024 + (ob ^ (((ob >> 9) & 1) << 5)); }
__host__ __device__ __forceinline__ void stage_rc(int b, int& R, int& C) { const int st = b / 1024, sb = b % 1024, swz = sb ^ (((sb >> 9) & 1) << 5); R = (st >> 1) * 16 + swz / 64; C = (st & 1) * 32 + (swz % 64) / 2; }
__host__ __device__ __forceinline__ int perm32(int rho) { const int n = rho >> 4, i = rho & 15; return 8 * (i >> 2) + 4 * n + (i & 3); }

struct Unit { int pm, pn; };
struct Gemm { const bf16_t* A; const bf16_t* Bt; int M, N, K; };

struct StaticOrder {
    int nM, nN, nwg, G, c;
    __host__ __device__ void init(int M, int N, int G_, int c_) { nM = M / BM; nN = N / BM; nwg = nM * nN; G = G_; c = c_; }
    __host__ __device__ bool next(int i, Unit& u) const {
        const long L = (long)i * G + c; if (L >= nwg) return false;
        int wgid = (int)L; { const int q = nwg / NXCD, r = nwg % NXCD, xcd = wgid % NXCD, off = wgid / NXCD; wgid = (xcd < r ? xcd * (q + 1) : r * (q + 1) + (xcd - r) * q) + off; }
        const int nig = WGM * nN, gid = wgid / nig, fm = gid * WGM, gsz = (nM - fm) < WGM ? (nM - fm) : WGM;
        u.pm = fm + ((wgid % nig) % gsz); u.pn = (wgid % nig) / gsz; return true;
    }
    __device__ __forceinline__ void a_ready(const Unit&) const {}
    __device__ __forceinline__ void done(const Unit&) const {}
};

__device__ __forceinline__ unsigned cvt_pk_bf16(float lo, float hi) { unsigned r; asm volatile("v_cvt_pk_bf16_f32 %0, %1, %2" : "=v"(r) : "v"(lo), "v"(hi)); return r; }
typedef float f32x2 __attribute__((ext_vector_type(2)));
template <int ACT> struct EpiBf16 {
    static constexpr bool PERM = true, AFTER_DRAIN = false;
    bf16_t* O; int ldc;
    __device__ __forceinline__ void operator()(const f32x4 (&acc)[2][2][4][2], const Unit& u, int wr, int wc, int fr, int fq) const {
        const int row0 = u.pm * BM + wr * 64 + fr; const int col0 = u.pn * BM + wc * 32 + 8 * fq;
#pragma unroll
        for (int ai = 0; ai < 2; ++ai)
#pragma unroll
            for (int m = 0; m < 4; ++m) { bf16_t* rowp = O + (size_t)(row0 + ai * HALF + m * 16) * ldc + col0;
#pragma unroll
                for (int bj = 0; bj < 2; ++bj) { f32x4 v0 = acc[ai][bj][m][0], v1 = acc[ai][bj][m][1];
                    if (ACT == 2) {
#pragma unroll
                        for (int e = 0; e < 4; ++e) { float a = fmaxf(v0[e], 0.f), b = fmaxf(v1[e], 0.f); v0[e] = a * a; v1[e] = b * b; } }
                    u32x4 w; w.x = cvt_pk_bf16(v0[0], v0[1]); w.y = cvt_pk_bf16(v0[2], v0[3]); w.z = cvt_pk_bf16(v1[0], v1[1]); w.w = cvt_pk_bf16(v1[2], v1[3]);
                    *(u32x4*)(rowp + bj * HALF) = w; } }
    }
};
typedef unsigned u32x2 __attribute__((ext_vector_type(2)));
template <int ACT> struct EpiFp8 {
    static constexpr bool PERM = true, AFTER_DRAIN = false;
    unsigned char* O; int ldc; float mul;
    __device__ __forceinline__ void operator()(const f32x4 (&acc)[2][2][4][2], const Unit& u, int wr, int wc, int fr, int fq) const {
        const int row0 = u.pm * BM + wr * 64 + fr; const int col0 = u.pn * BM + wc * 32 + 8 * fq;
#pragma unroll
        for (int ai = 0; ai < 2; ++ai)
#pragma unroll
            for (int m = 0; m < 4; ++m) { unsigned char* rowp = O + (size_t)(row0 + ai * HALF + m * 16) * ldc + col0;
#pragma unroll
                for (int bj = 0; bj < 2; ++bj) { f32x4 v0 = acc[ai][bj][m][0], v1 = acc[ai][bj][m][1];
#pragma unroll
                    for (int e = 0; e < 4; ++e) {
                        if (ACT == 2) { float a = fmaxf(v0[e], 0.f), b = fmaxf(v1[e], 0.f); v0[e] = fminf(a * a * mul, 448.f); v1[e] = fminf(b * b * mul, 448.f); }
                        else { v0[e] = __builtin_amdgcn_fmed3f(v0[e] * mul, -448.f, 448.f); v1[e] = __builtin_amdgcn_fmed3f(v1[e] * mul, -448.f, 448.f); } }
                    int lo = __builtin_amdgcn_cvt_pk_fp8_f32(v0[0], v0[1], 0, false); lo = __builtin_amdgcn_cvt_pk_fp8_f32(v0[2], v0[3], lo, true);
                    int hi = __builtin_amdgcn_cvt_pk_fp8_f32(v1[0], v1[1], 0, false); hi = __builtin_amdgcn_cvt_pk_fp8_f32(v1[2], v1[3], hi, true);
                    *(u32x2*)(rowp + bj * HALF) = (u32x2){(unsigned)lo, (unsigned)hi}; } }
    }
};
template <class Epi, class Sched, bool ALIGN_EPI = false, bool SP2 = false, bool FP8 = false, int SCW = 0x7f7f7f7f, int SCA = 0x7f7f7f7f>
__device__ __forceinline__ void gemm_phase(PG8_LAS unsigned char* lds, const Gemm g, const Sched& S, const Epi& E, const int tid_in) {
    int tid_l_ = tid_in; asm volatile("" : "+v"(tid_l_));
    const int tid = tid_l_, wid = __builtin_amdgcn_readfirstlane(tid >> 6), lane = tid & 63, wr = wid >> 2, wc = wid & 3, fr = lane & 15, fq = lane >> 4;
    const int K = g.K, nt = K / BK;
    unsigned voffA[2], voffB[2];
#pragma unroll
    for (int i = 0; i < 2; ++i) { int R, C; stage_rc(tid * 16 + i * 8192, R, C); const int Rb = Epi::PERM ? ((R & ~31) + perm32(R & 31)) : R;
        voffA[i] = (unsigned)(R * K + C) * 2u; voffB[i] = (unsigned)(Rb * K + C) * 2u; }
    const size_t kstep = (size_t)(BK * 2);
    const size_t hstep = (size_t)HALF * K * 2;
    const size_t tstep = 2 * hstep;
    const unsigned ldsw = (unsigned)wid * 1024u;
    const int aoff = lds_byte(wr * 64 + fr, fq * 8), boff = lds_byte(wc * 32 + fr, fq * 8);
#define PG8_SA(b, h) (((b) * 2 + (h)) * HTB)
#define PG8_SB(b, h) ((4 + (b) * 2 + (h)) * HTB)
#define PG8_STAGE(bufoff, gbase, voff) do { _Pragma("unroll") for (int _i = 0; _i < 2; ++_i) \
        __builtin_amdgcn_global_load_lds((const unsigned*)((const char*)(gbase) + (voff)[_i]), (PG8_LAS unsigned*)(lds + (bufoff) + ldsw + _i * 8192), 16, 0, 0); } while (0)
#define PG8_LD8(off) __builtin_shufflevector(*(const PG8_LAS i32x4*)(lds + (off)), *(const PG8_LAS i32x4*)(lds + (off) + 1024), 0, 1, 2, 3, 4, 5, 6, 7)
#define PG8_LDA(dst, b, h) do { if constexpr (FP8) { _Pragma("unroll") for (int m = 0; m < 4; ++m) dst##8[m] = PG8_LD8(PG8_SA(b, h) + aoff + m * 2048); } else { \
        _Pragma("unroll") for (int m = 0; m < 4; ++m) _Pragma("unroll") for (int k = 0; k < 2; ++k) dst[m][k] = *(const PG8_LAS bf16x8*)(lds + PG8_SA(b, h) + aoff + m * 2048 + k * 1024); } } while (0)
#define PG8_LDB(dst, b, h) do { if constexpr (FP8) { _Pragma("unroll") for (int n = 0; n < 2; ++n) dst##8[n] = PG8_LD8(PG8_SB(b, h) + boff + n * 2048); } else { \
        _Pragma("unroll") for (int n = 0; n < 2; ++n) _Pragma("unroll") for (int k = 0; k < 2; ++k) dst[n][k] = *(const PG8_LAS bf16x8*)(lds + PG8_SB(b, h) + boff + n * 2048 + k * 1024); } } while (0)
#define PG8_MMA(ai, bj, At, Bt) do { __builtin_amdgcn_s_setprio(1); if constexpr (FP8) { _Pragma("unroll") for (int m = 0; m < 4; ++m) _Pragma("unroll") for (int n = 0; n < 2; ++n) \
        asm volatile("v_mfma_scale_f32_16x16x128_f8f6f4 %0, %1, %2, %0, %3, %4 op_sel_hi:[0,0,0]" : "+v"(acc[ai][bj][m][n]) : "v"(Bt##8[n]), "v"(At##8[m]), "v"(scw_), "v"(sca_)); } else { \
        _Pragma("unroll") for (int m = 0; m < 4; ++m) _Pragma("unroll") for (int n = 0; n < 2; ++n) _Pragma("unroll") for (int k = 0; k < 2; ++k) \
        acc[ai][bj][m][n] = __builtin_amdgcn_mfma_f32_16x16x32_bf16(Bt[n][k], At[m][k], acc[ai][bj][m][n], 0, 0, 0); } __builtin_amdgcn_s_setprio(0); } while (0)
#define PG8_WAIT_V(n) asm volatile("s_waitcnt vmcnt(" #n ")" ::: "memory")
#define PG8_WAIT_L(n) asm volatile("s_waitcnt lgkmcnt(" #n ")" ::: "memory")
#define PG8_BAR __builtin_amdgcn_s_barrier()
#define PG8_SCHED __builtin_amdgcn_sched_barrier(0)
    Unit cur, nxt; int ui = 0;
    if (!S.next(0, cur)) return;
    f32x4 acc[2][2][4][2];
#pragma unroll
    for (int a = 0; a < 2; ++a)
#pragma unroll
        for (int b = 0; b < 2; ++b)
#pragma unroll
            for (int m = 0; m < 4; ++m)
#pragma unroll
                for (int n = 0; n < 2; ++n) acc[a][b][m][n] = (f32x4){0.f, 0.f, 0.f, 0.f};
    int scw_ = SCW, sca_ = SCA; asm volatile("" : "+v"(scw_), "+v"(sca_));
    bf16x8 At[4][2], B0[2][2], B1[2][2]; i32x8 At8[4], B08[2], B18[2];
    const char* cA = (const char*)g.A + (size_t)cur.pm * tstep; const char* cB = (const char*)g.Bt + (size_t)cur.pn * tstep;
    S.a_ready(cur);
    if constexpr (SP2) {
        PG8_STAGE(PG8_SB(0, 0), cB, voffB); PG8_STAGE(PG8_SB(0, 1), cB + hstep, voffB); PG8_STAGE(PG8_SA(0, 0), cA, voffA); PG8_STAGE(PG8_SA(0, 1), cA + hstep, voffA);
        if (wr == 1) PG8_BAR;
        PG8_WAIT_V(2); PG8_BAR;
        PG8_STAGE(PG8_SB(1, 0), cB + kstep, voffB); PG8_STAGE(PG8_SA(1, 0), cA + kstep, voffA); PG8_STAGE(PG8_SB(1, 1), cB + hstep + kstep, voffB);
        PG8_WAIT_V(6); PG8_BAR;
    } else {
        PG8_STAGE(PG8_SB(0, 0), cB, voffB); PG8_STAGE(PG8_SA(0, 0), cA, voffA); PG8_STAGE(PG8_SB(0, 1), cB + hstep, voffB); PG8_STAGE(PG8_SA(0, 1), cA + hstep, voffA);
        if (wr == 1) PG8_BAR;
        PG8_WAIT_V(4); PG8_BAR;
        PG8_STAGE(PG8_SB(1, 0), cB + kstep, voffB); PG8_STAGE(PG8_SA(1, 0), cA + kstep, voffA); PG8_STAGE(PG8_SB(1, 1), cB + hstep + kstep, voffB);
        PG8_WAIT_V(6); PG8_BAR;
    }
    for (;;) {
        const bool has_next = S.next(ui + 1, nxt);
        const char* nA = has_next ? (const char*)g.A + (size_t)nxt.pm * tstep : cA; const char* nB = has_next ? (const char*)g.Bt + (size_t)nxt.pn * tstep : cB;
        for (int t = 0; t < nt; t += 2) {
            const bool last = (t == nt - 2);
            const char* a1 = cA + (size_t)(t + 1) * kstep;
            const char* a2 = last ? nA : cA + (size_t)(t + 2) * kstep; const char* b2 = last ? nB : cB + (size_t)(t + 2) * kstep;
            const char* a3 = a2 + kstep; const char* b3 = b2 + kstep;
            if (last && has_next) S.a_ready(nxt);
            if constexpr (SP2) {
            PG8_LDB(B0, 0, 0); PG8_LDB(B1, 0, 1); PG8_SCHED; PG8_LDA(At, 0, 0); PG8_STAGE(PG8_SA(1, 1), a1 + hstep, voffA);
            PG8_WAIT_V(8); PG8_WAIT_L(0); PG8_BAR; PG8_MMA(0, 0, At, B0); PG8_MMA(0, 1, At, B1); PG8_BAR; PG8_SCHED;
            PG8_LDA(At, 0, 1); PG8_STAGE(PG8_SB(0, 0), b2, voffB); PG8_STAGE(PG8_SB(0, 1), b2 + hstep, voffB); PG8_STAGE(PG8_SA(0, 0), a2, voffA);
            PG8_WAIT_V(8); PG8_WAIT_L(0); PG8_BAR; PG8_MMA(1, 0, At, B0); PG8_MMA(1, 1, At, B1); PG8_BAR; PG8_SCHED;
            PG8_LDB(B0, 1, 0); PG8_LDB(B1, 1, 1); PG8_SCHED; PG8_LDA(At, 1, 0); PG8_STAGE(PG8_SA(0, 1), a2 + hstep, voffA);
            PG8_WAIT_V(8); PG8_WAIT_L(0); PG8_BAR; PG8_MMA(0, 0, At, B0); PG8_MMA(0, 1, At, B1); PG8_BAR; PG8_SCHED;
            PG8_LDA(At, 1, 1); PG8_STAGE(PG8_SB(1, 0), b3, voffB); PG8_STAGE(PG8_SB(1, 1), b3 + hstep, voffB); PG8_STAGE(PG8_SA(1, 0), a3, voffA);
            PG8_WAIT_V(8); PG8_WAIT_L(0); PG8_BAR; PG8_MMA(1, 0, At, B0); PG8_MMA(1, 1, At, B1); PG8_BAR; PG8_SCHED;
            } else {
            PG8_LDB(B0, 0, 0); PG8_SCHED; PG8_LDA(At, 0, 0); PG8_STAGE(PG8_SA(1, 1), a1 + hstep, voffA);
            PG8_WAIT_L(8); PG8_BAR; PG8_WAIT_L(0); PG8_MMA(0, 0, At, B0); PG8_BAR; PG8_SCHED;
            PG8_LDB(B1, 0, 1); PG8_STAGE(PG8_SB(0, 0), b2, voffB);
            PG8_BAR; PG8_WAIT_L(0); PG8_MMA(0, 1, At, B1); PG8_BAR;
            PG8_LDA(At, 0, 1); PG8_STAGE(PG8_SA(0, 0), a2, voffA);
            PG8_BAR; PG8_WAIT_L(0); PG8_MMA(1, 0, At, B0); PG8_BAR; PG8_SCHED;
            PG8_STAGE(PG8_SB(0, 1), b2 + hstep, voffB);
            PG8_WAIT_V(6); PG8_BAR; PG8_MMA(1, 1, At, B1); PG8_BAR;
            PG8_LDB(B0, 1, 0); PG8_SCHED; PG8_LDA(At, 1, 0); PG8_STAGE(PG8_SA(0, 1), a2 + hstep, voffA);
            PG8_WAIT_L(8); PG8_BAR; PG8_WAIT_L(0); PG8_MMA(0, 0, At, B0); PG8_BAR; PG8_SCHED;
            PG8_LDB(B1, 1, 1); PG8_STAGE(PG8_SB(1, 0), b3, voffB);
            PG8_BAR; PG8_WAIT_L(0); PG8_MMA(0, 1, At, B1); PG8_BAR;
            PG8_LDA(At, 1, 1); PG8_STAGE(PG8_SA(1, 0), a3, voffA);
            PG8_BAR; PG8_WAIT_L(0); PG8_MMA(1, 0, At, B0); PG8_BAR; PG8_SCHED;
            PG8_STAGE(PG8_SB(1, 1), b3 + hstep, voffB);
            PG8_WAIT_V(6); PG8_BAR; PG8_MMA(1, 1, At, B1); PG8_BAR;
            }
        }
        if constexpr (FP8) asm volatile("s_nop 15\n\ts_nop 15" ::: "memory");
        if constexpr (ALIGN_EPI) { if (wr == 0) PG8_BAR; }
        if constexpr (!Epi::AFTER_DRAIN) { E(acc, cur, wr, wc, fr, fq); S.done(cur); }
        if (!has_next) break;
#pragma unroll
        for (int a = 0; a < 2; ++a)
#pragma unroll
            for (int b = 0; b < 2; ++b)
#pragma unroll
                for (int m = 0; m < 4; ++m)
#pragma unroll
                    for (int n = 0; n < 2; ++n) acc[a][b][m][n] = (f32x4){0.f, 0.f, 0.f, 0.f};
        cur = nxt; cA = nA; cB = nB; ++ui;
        if constexpr (ALIGN_EPI) { if (wr == 1) PG8_BAR; }
    }
    PG8_WAIT_V(0);
    if constexpr (!ALIGN_EPI) { if (wr == 0) PG8_BAR; }
    PG8_BAR;
    if constexpr (Epi::AFTER_DRAIN) { E.fused(acc, cur, wr, wc, fr, fq, lds, wid, lane); S.done(cur); }
#undef PG8_SA
#undef PG8_SB
#undef PG8_STAGE
#undef PG8_LDA
#undef PG8_LDB
#undef PG8_MMA
#undef PG8_LD8
#undef PG8_WAIT_V
#undef PG8_WAIT_L
#undef PG8_BAR
#undef PG8_SCHED
}
}

#ifndef PROBE
#define PROBE 0
#endif
#define LAS __attribute__((address_space(3)))
typedef unsigned short bf16;
typedef unsigned short u16;
typedef _Float16 h2v __attribute__((ext_vector_type(2)));
typedef short s2v __attribute__((ext_vector_type(2)));
typedef unsigned v4u __attribute__((ext_vector_type(4)));
typedef unsigned v2u __attribute__((ext_vector_type(2)));
typedef float f32x4 __attribute__((ext_vector_type(4)));
typedef float f32x16 __attribute__((ext_vector_type(16)));
typedef short bf16x8 __attribute__((ext_vector_type(8)));

constexpr int NB = 4, SEQ = 8192, NMETA = 16, TT = 8208, DM = 1024, NL = 2;
constexpr int MAINR = 32768, RREAL = 32784, RPAD = 33024;
constexpr int ZC = 3072, LC = 2048, FF = 4096;
constexpr int C_Q = 0, C_CKV = 512, C_QI = 768, C_KI = 1024, C_WI = 1088, C_R = 1152, C_K = 1664, C_V = 2176, C_XW = 2688, C_XA = 2752, C_XG = 2816, C_XV = 2976;
constexpr int TPAD = 8320;
constexpr float NORM_EPS = 1e-6f, GN_EPS = 64e-5f;
constexpr int NT = 512, NWAVES = 8;
constexpr int LDS_BYTES = 155648;

constexpr size_t MiB = 1u << 20;
constexpr size_t WS_CTL = 0, CTL_BYTES = 65536;
constexpr size_t WS_ROPE = 1 * MiB;
constexpr size_t WS_HX = 2 * MiB;
constexpr size_t WS_WIN = 4 * MiB, WS_WO = 16 * MiB, WS_WUP = 20 * MiB, WS_WDN = 36 * MiB;
constexpr size_t WS_KATT = 52 * MiB, WS_VATT = 57 * MiB, WS_KI = 62 * MiB;
constexpr size_t WS_VF = 67 * MiB;
constexpr size_t WS_U = 100 * MiB;
constexpr size_t WS_Z = 165 * MiB;
constexpr size_t WS_L = WS_Z + (size_t)RPAD * ZC * 2;
constexpr size_t WS_HID = WS_Z;
constexpr size_t WS_TMP2 = WS_HID + (size_t)RPAD * FF * 2;
constexpr size_t WS_HMID = WS_HID + (size_t)RPAD * FF;
static_assert(WS_HMID + (size_t)MAINR * DM * 2 <= WS_TMP2 && WS_HMID >= WS_Z + (size_t)RPAD * DM * 2, "ws map");
constexpr size_t WS_ACT = WS_L + (size_t)RPAD * LC * 2;
constexpr int ACTC = 320, OPSB = 16384;
constexpr size_t WS_OPS = WS_L, WS_WLT = 3 * MiB, WS_WKV = 3 * MiB + 768 * 1024;
constexpr size_t WS_END = WS_ACT + (size_t)RPAD * ACTC * 2;
static_assert((size_t)16 * 513 * OPSB <= (size_t)RPAD * LC * 2, "ops fits");
static_assert(WS_END <= 512 * MiB, "ws total");
static_assert(WS_TMP2 + (size_t)RPAD * DM * 2 <= WS_ACT, "ws map");
static_assert(WS_U + (size_t)RPAD * DM * 2 <= WS_Z, "ws map");
static_assert(WS_VF + (size_t)RPAD * 512 * 2 <= WS_U, "ws map");

struct Args { const float* in[30]; float* out; unsigned char* ws; int ph_lo, ph_hi; };

enum { I_X = 0, I_META, I_NMPRE, I_NMPOST, I_NFPRE, I_NFPOST, I_WIN, I_MU, I_KVN, I_WUK, I_WUV, I_IDXG, I_IDXB, I_W0, I_W2, I_A0, I_A2, I_G2,
       I_KK, I_KA, I_RK, I_LNW, I_LNB, I_WINV, I_MUV, I_V0, I_V2, I_WO, I_WUP, I_WDN };

__device__ __forceinline__ float bf2f(bf16 b) { return __uint_as_float((unsigned)b << 16); }
typedef float f32x2h __attribute__((ext_vector_type(2)));
typedef __bf16 bf16x2h __attribute__((ext_vector_type(2)));
__device__ __forceinline__ unsigned pk2(float lo, float hi) { const bf16x2h v = __builtin_convertvector((f32x2h){lo, hi}, bf16x2h); return __builtin_bit_cast(unsigned, v); }
constexpr float S8_X = 16.f, S8_WU = 256.f, S8_H = 4.f, S8_WD = 512.f;
constexpr int E8_X = 0x7b7b7b7b, E8_WU = 0x77777777, E8_H = 0x7d7d7d7d, E8_WD = 0x76767676;
__device__ __forceinline__ float sat8(float x) { return __builtin_amdgcn_fmed3f(x, -448.f, 448.f); }
__device__ __forceinline__ unsigned pk4_fp8(float a, float b, float c, float d) { int p = __builtin_amdgcn_cvt_pk_fp8_f32(sat8(a), sat8(b), 0, false); p = __builtin_amdgcn_cvt_pk_fp8_f32(sat8(c), sat8(d), p, true); return (unsigned)p; }
__device__ __forceinline__ unsigned f2bf(float f) { return (unsigned)__builtin_bit_cast(unsigned short, (__bf16)f); }
template <int CTRL> __device__ __forceinline__ float dpp_f(float v) { return __int_as_float(__builtin_amdgcn_update_dpp(0, __float_as_int(v), CTRL, 0xf, 0xf, true)); }
__device__ __forceinline__ float row16_sum(float v) { v += dpp_f<0xB1>(v); v += dpp_f<0x4E>(v); v += dpp_f<0x141>(v); v += dpp_f<0x140>(v); return v; }
__device__ __forceinline__ float quad_sum(float v) { v += dpp_f<0xB1>(v); v += dpp_f<0x4E>(v); return v; }
template <int CTRL, int RM> __device__ __forceinline__ unsigned dpp_u(unsigned v) { return (unsigned)__builtin_amdgcn_update_dpp(0, (int)v, CTRL, RM, 0xf, false); }
__device__ __forceinline__ unsigned wave_scan_incl(unsigned x) {
    x += dpp_u<0x111, 0xf>(x); x += dpp_u<0x112, 0xf>(x); x += dpp_u<0x114, 0xf>(x); x += dpp_u<0x118, 0xf>(x);
    x += dpp_u<0x142, 0xa>(x); x += dpp_u<0x143, 0xc>(x); return x; }
__device__ __forceinline__ unsigned lane_bcast(unsigned v, int srclane) { return (unsigned)__builtin_amdgcn_readlane((int)v, srclane); }
typedef unsigned u2v __attribute__((ext_vector_type(2)));
__device__ __forceinline__ float xor16_sum(float v) { const u2v r = __builtin_amdgcn_permlane16_swap(__float_as_uint(v), __float_as_uint(v), false, false); return __uint_as_float(r.x) + __uint_as_float(r.y); }
__device__ __forceinline__ float xor32_sum(float v) { const u2v r = __builtin_amdgcn_permlane32_swap(__float_as_uint(v), __float_as_uint(v), false, false); return __uint_as_float(r.x) + __uint_as_float(r.y); }
__device__ __forceinline__ float xor16_max(float v) { const u2v r = __builtin_amdgcn_permlane16_swap(__float_as_uint(v), __float_as_uint(v), false, false); return fmaxf(__uint_as_float(r.x), __uint_as_float(r.y)); }
__device__ __forceinline__ float xor32_max(float v) { const u2v r = __builtin_amdgcn_permlane32_swap(__float_as_uint(v), __float_as_uint(v), false, false); return fmaxf(__uint_as_float(r.x), __uint_as_float(r.y)); }
__device__ __forceinline__ float wave_sum(float v) { v = row16_sum(v); v = xor16_sum(v); v = xor32_sum(v); return v; }
__device__ __forceinline__ float wave_max(float v) {
#pragma unroll
    for (int o = 1; o < 64; o <<= 1) v = fmaxf(v, __shfl_xor(v, o));
    return v;
}
__device__ __forceinline__ int row_of(int b, int p) { return p < NMETA ? MAINR + p : b * SEQ + (p - NMETA); }
__device__ __forceinline__ float relu_i(float x) { const int xi = __float_as_int(x); return __int_as_float(xi > 0 ? xi : 0); }
__device__ __forceinline__ float sigmoidf_(float x) { return __builtin_amdgcn_rcpf(1.f + __expf(-x)); }

__device__ __forceinline__ int lane_now() { int l; asm volatile("v_mbcnt_lo_u32_b32 %0, -1, 0\n\tv_mbcnt_hi_u32_b32 %0, -1, %0" : "=v"(l)); return l; }
__device__ __forceinline__ int launder2() { int n = 2; asm volatile("" : "+s"(n)); return n; }
struct Ctx {
    const float* const* in; float* out; unsigned char* ws;
    LAS unsigned char* lds; int tid, lane, wid, G, bid; int ppass;
    __device__ __forceinline__ const float* I(int i) const { return in[i]; }
    __device__ __forceinline__ bf16* Z() const { return (bf16*)(ws + WS_Z); }
    __device__ __forceinline__ bf16* ACT() const { return (bf16*)(ws + WS_ACT); }
    __device__ __forceinline__ bf16* WLT() const { return (bf16*)(ws + WS_WLT); }
    __device__ __forceinline__ bf16* U() const { return (bf16*)(ws + WS_U); }
    __device__ __forceinline__ bf16* VF() const { return (bf16*)(ws + WS_VF); }
    __device__ __forceinline__ bf16* KATT() const { return (bf16*)(ws + WS_KATT); }
    __device__ __forceinline__ bf16* VATT() const { return (bf16*)(ws + WS_VATT); }
    __device__ __forceinline__ bf16* KI() const { return (bf16*)(ws + WS_KI); }
    __device__ __forceinline__ float* HX() const { return (float*)(ws + WS_HX); }
    __device__ __forceinline__ float* COS() const { return (float*)(ws + WS_ROPE); }
    __device__ __forceinline__ float* SIN() const { return (float*)(ws + WS_ROPE) + TT * 8; }
    __device__ __forceinline__ unsigned* CTL() const { return (unsigned*)(ws + WS_CTL); }
};

template <class Src, bool FRAG = false>
__device__ __forceinline__ void transpose_item(const Src& src, bf16* WT, int K, int k0, int n0, LAS float* scr, int lane) {
#pragma unroll
    for (int i = 0; i < 8; ++i) { const int kk = 8 * i + (lane >> 3), nn = 4 * (lane & 7); const f32x4 v = src.v4(k0 + kk, n0 + nn);
        scr[kk * 33 + nn] = v.x; scr[kk * 33 + nn + 1] = v.y; scr[kk * 33 + nn + 2] = v.z; scr[kk * 33 + nn + 3] = v.w; }
    asm volatile("s_waitcnt lgkmcnt(0)" ::: "memory");
    const int c = lane & 7;
#pragma unroll
    for (int j = 0; j < 4; ++j) { const int n = (lane >> 3) + 8 * j; const LAS float* s = scr + (8 * c) * 33 + n;
        v4u o; o.x = pk2(s[0 * 33], s[1 * 33]); o.y = pk2(s[2 * 33], s[3 * 33]); o.z = pk2(s[4 * 33], s[5 * 33]); o.w = pk2(s[6 * 33], s[7 * 33]);
        if (FRAG) { const int ch = n0 + n, kq = (k0 >> 3) + c; *(v4u*)(WT + (size_t)((((ch >> 6) * 4 + (ch & 3)) * 10 + (kq >> 2)) * 64 + (kq & 3) * 16 + ((ch & 63) >> 2)) * 8) = o; }
        else *(v4u*)(WT + (size_t)(n0 + n) * K + k0 + 8 * c) = o; }
    asm volatile("s_waitcnt lgkmcnt(0)" ::: "memory");
}
template <class Src>
__device__ __forceinline__ void transpose_item8(const Src& src, unsigned char* WT, int K, int k0, int n0, LAS float* scr, int lane, float mul) {
#pragma unroll
    for (int i = 0; i < 8; ++i) { const int kk = 8 * i + (lane >> 3), nn = 4 * (lane & 7); const f32x4 v = src.v4(k0 + kk, n0 + nn);
        scr[kk * 33 + nn] = v.x; scr[kk * 33 + nn + 1] = v.y; scr[kk * 33 + nn + 2] = v.z; scr[kk * 33 + nn + 3] = v.w; }
    asm volatile("s_waitcnt lgkmcnt(0)" ::: "memory");
    const int c = lane & 7;
#pragma unroll
    for (int j = 0; j < 4; ++j) { const int n = (lane >> 3) + 8 * j; const LAS float* s = scr + (8 * c) * 33 + n;
        v2u o; o.x = pk4_fp8(s[0 * 33] * mul, s[1 * 33] * mul, s[2 * 33] * mul, s[3 * 33] * mul); o.y = pk4_fp8(s[4 * 33] * mul, s[5 * 33] * mul, s[6 * 33] * mul, s[7 * 33] * mul);
        *(v2u*)(WT + (size_t)(n0 + n) * K + k0 + 8 * c) = o; }
    asm volatile("s_waitcnt lgkmcnt(0)" ::: "memory");
}
struct SrcKV { const float* wk; const float* wv;
    __device__ __forceinline__ f32x4 v4(int k, int n) const { return n < 64 ? *(const f32x4*)(wk + (size_t)k * 64 + n) : *(const f32x4*)(wv + (size_t)k * 64 + n - 64); } };
struct SrcLora { const float* w2; const float* a2; const float* g2; const float* v2; int has_v;
    __device__ __forceinline__ f32x4 v4(int k, int n) const {
        if (k < 64) return *(const f32x4*)(w2 + (size_t)k * 512 + n);
        if (k < 128) return *(const f32x4*)(a2 + (size_t)(k - 64) * 512 + n);
        if (k < 288) return *(const f32x4*)(g2 + (size_t)(k - 128) * 512 + n);
        return has_v ? *(const f32x4*)(v2 + (size_t)(k - 288) * 512 + n) : (f32x4){0.f, 0.f, 0.f, 0.f}; } };
struct SrcPlain { const float* W; int ldw; __device__ __forceinline__ f32x4 v4(int k, int n) const { return *(const f32x4*)(W + (size_t)k * ldw + n); } };
struct SrcWin { const float* W; const float* Wv; int has_v;
    __device__ __forceinline__ f32x4 v4(int k, int n) const {
        if (n < 1092) return *(const f32x4*)(W + (size_t)k * 2916 + n);
        if (n >= C_R && n < C_XV) return *(const f32x4*)(W + (size_t)k * 2916 + 1092 + (n - C_R));
        if (n >= C_XV && n < C_XV + 32 && has_v) return *(const f32x4*)(Wv + (size_t)k * 32 + (n - C_XV));
        return (f32x4){0.f, 0.f, 0.f, 0.f}; } };

__device__ __forceinline__ void phase_prologue(const Ctx& C) {
    LAS float* scr = (LAS float*)(C.lds + C.wid * 16384);
    const int gw = C.bid * NWAVES + C.wid, NGW = C.G * NWAVES;
    constexpr int IT_WIN = 16 * 96, IT_WO = 16 * 32, IT_WUP = 16 * 128, IT_WDN = 64 * 32, IT_L = IT_WIN + IT_WO + IT_WUP + IT_WDN;
    for (int it = gw; it < 2 * IT_L; it += NGW) {
        const int l = it / IT_L; int r = it % IT_L;
        if (r < IT_WIN) { SrcWin s{C.I(I_WIN) + (size_t)l * 1024 * 2916, C.I(I_WINV), l == 1}; const int kb = r / 96, nb = r % 96;
            transpose_item(s, (bf16*)(C.ws + WS_WIN) + (size_t)l * ZC * 1024, 1024, 64 * kb, 32 * nb, scr, C.lane); continue; } r -= IT_WIN;
        if (r < IT_WO) { SrcPlain s{C.I(I_WO) + (size_t)l * 1024 * 1024, 1024}; const int kb = r / 32, nb = r % 32;
            transpose_item(s, (bf16*)(C.ws + WS_WO) + (size_t)l * 1024 * 1024, 1024, 64 * kb, 32 * nb, scr, C.lane); continue; } r -= IT_WO;
        if (r < IT_WUP) { SrcPlain s{C.I(I_WUP) + (size_t)l * 1024 * 4096, 4096}; const int kb = r / 128, nb = r % 128;
            transpose_item8(s, C.ws + WS_WUP + (size_t)l * 4096 * 1024, 1024, 64 * kb, 32 * nb, scr, C.lane, S8_WU); continue; } r -= IT_WUP;
        { SrcPlain s{C.I(I_WDN) + (size_t)l * 4096 * 1024, 1024}; const int kb = r / 32, nb = r % 32;
            transpose_item8(s, C.ws + WS_WDN + (size_t)l * 1024 * 4096, 4096, 64 * kb, 32 * nb, scr, C.lane, S8_WD); }
    }
    for (int it = gw; it < 2 * 16; it += NGW) { const int l = it / 16, r = it % 16, kb = r / 4, nb = r % 4;
        SrcKV s{C.I(I_WUK) + (size_t)l * 256 * 64, C.I(I_WUV) + (size_t)l * 256 * 64};
        transpose_item(s, (bf16*)(C.ws + WS_WKV) + (size_t)l * 128 * 256, 256, 64 * kb, 32 * nb, scr, C.lane); }
    for (int it = gw; it < 2 * 80; it += NGW) { const int l = it / 80, r = it % 80, kb = r / 16, nb = r % 16;
        SrcLora s{C.I(I_W2) + (size_t)l * 64 * 512, C.I(I_A2) + (size_t)l * 64 * 512, C.I(I_G2) + (size_t)l * 160 * 512, C.I(I_V2), l == 1};
        transpose_item<SrcLora, true>(s, C.WLT() + (size_t)l * 512 * ACTC, ACTC, 64 * kb, 32 * nb, scr, C.lane); }
    const int gt = C.bid * NT + C.tid, NGT = C.G * NT;
    for (int i = gt; i < TT * 8; i += NGT) {
        const int p = i >> 3, f = i & 7;
        const float invf = powf(500000.0f, -(float)(2 * f) / 16.0f);
        const float ang = (float)p * invf;
        const double ad = (double)ang; const double n = rint(ad * 0.15915494309189535); const float rr = (float)(ad - n * 6.283185307179586);
        C.COS()[i] = cosf(rr); C.SIN()[i] = sinf(rr);
    }
    for (int i = gt; i < 256 * DM; i += NGT) C.HX()[i] = (i < NMETA * DM) ? C.I(I_META)[i] : 0.f;
}

struct NormIn { f32x4 hf[4]; v2u hw[4]; v2u tw[4]; };
template <bool HIN16>
__device__ __forceinline__ void norm_load(const Ctx& C, const void* hin_main, const float* hx_in, const bf16* tmp, int row, int lane, NormIn& o) {
    if (row >= RREAL) return;
    const bool mainrow = row < MAINR;
    if (HIN16 && mainrow) {
#pragma unroll
        for (int j = 0; j < 4; ++j) o.hw[j] = *(const v2u*)((const bf16*)hin_main + (size_t)row * DM + lane * 4 + 256 * j);
    } else {
        const float* hp = mainrow ? (const float*)hin_main + (size_t)row * DM : (hx_in ? hx_in : (const float*)C.HX()) + (size_t)(row - MAINR) * DM;
#pragma unroll
        for (int j = 0; j < 4; ++j) o.hf[j] = *(const f32x4*)(hp + lane * 4 + 256 * j);
    }
    if (tmp) {
#pragma unroll
        for (int j = 0; j < 4; ++j) o.tw[j] = *(const v2u*)(tmp + (size_t)row * DM + lane * 4 + 256 * j); }
}
template <bool HIN16, bool HOUT16>
__device__ __forceinline__ void norm_row(const Ctx& C, void* hout_main, const bf16* tmp, const float* g_post, const float* g_next, const bool out8, int row, int lane, const NormIn& in) {
    if (row >= RPAD) return;
    bf16* urow = C.U() + (size_t)row * DM;
    if (row >= RREAL) { if (g_next && !out8) {
#pragma unroll
            for (int j = 0; j < 4; ++j) *(v2u*)(urow + lane * 4 + 256 * j) = (v2u){0u, 0u}; }
        return; }
    const bool mainrow = row < MAINR;
    f32x4 h[4];
    if (HIN16 && mainrow) {
#pragma unroll
        for (int j = 0; j < 4; ++j) { const v2u w = in.hw[j]; h[j] = (f32x4){__uint_as_float(w.x << 16), __uint_as_float(w.x & 0xffff0000u), __uint_as_float(w.y << 16), __uint_as_float(w.y & 0xffff0000u)}; }
    } else {
#pragma unroll
        for (int j = 0; j < 4; ++j) h[j] = in.hf[j];
    }
    if (tmp) {
        f32x4 t[4]; float ss = 0.f;
#pragma unroll
        for (int j = 0; j < 4; ++j) { const v2u w = in.tw[j];
            t[j] = (f32x4){__uint_as_float(w.x << 16), __uint_as_float(w.x & 0xffff0000u), __uint_as_float(w.y << 16), __uint_as_float(w.y & 0xffff0000u)};
            ss += (t[j].x * t[j].x + t[j].y * t[j].y) + (t[j].z * t[j].z + t[j].w * t[j].w); }
        const float rstd = __builtin_amdgcn_rsqf(wave_sum(ss) * (1.f / DM) + NORM_EPS);
#pragma unroll
        for (int j = 0; j < 4; ++j) { const f32x4 g = *(const f32x4*)(g_post + lane * 4 + 256 * j); h[j] = h[j] + t[j] * rstd * g;
            if (HOUT16 && mainrow) *(v2u*)((bf16*)hout_main + (size_t)row * DM + lane * 4 + 256 * j) = (v2u){pk2(h[j].x, h[j].y), pk2(h[j].z, h[j].w)};
            else { float* ho = mainrow ? (float*)hout_main + (size_t)row * DM : C.HX() + (size_t)(row - MAINR) * DM; *(f32x4*)(ho + lane * 4 + 256 * j) = h[j]; } }
    }
    if (g_next) {
        float ss = 0.f;
#pragma unroll
        for (int j = 0; j < 4; ++j) ss += (h[j].x * h[j].x + h[j].y * h[j].y) + (h[j].z * h[j].z + h[j].w * h[j].w);
        const float rstd = __builtin_amdgcn_rsqf(wave_sum(ss) * (1.f / DM) + NORM_EPS);
#pragma unroll
        for (int j = 0; j < 4; ++j) { const f32x4 g = *(const f32x4*)(g_next + lane * 4 + 256 * j); const f32x4 y = h[j] * rstd * g;
            if (out8) *(unsigned*)((unsigned char*)C.U() + (size_t)row * DM + lane * 4 + 256 * j) = pk4_fp8(y.x * S8_X, y.y * S8_X, y.z * S8_X, y.w * S8_X);
            else *(v2u*)(urow + lane * 4 + 256 * j) = (v2u){pk2(y.x, y.y), pk2(y.z, y.w)}; }
    }
}
template <bool HIN16, bool HOUT16>
__device__ __forceinline__ void phase_norm(const Ctx& C, const void* hin_main, void* hout_main, const bf16* tmp, const float* g_post, const float* g_next, const float* hx_in = nullptr, const bool out8 = false) {
    const int gw = C.bid * NWAVES + C.wid, NGW = C.G * NWAVES; const int lane = C.lane;
    NormIn a0, a1, b0, b1;
    norm_load<HIN16>(C, hin_main, hx_in, tmp, gw, lane, a0); norm_load<HIN16>(C, hin_main, hx_in, tmp, gw + NGW, lane, a1);
#pragma unroll 1
    for (int row0 = gw; row0 < RPAD; row0 += 4 * NGW) {
        norm_load<HIN16>(C, hin_main, hx_in, tmp, row0 + 2 * NGW, lane, b0); norm_load<HIN16>(C, hin_main, hx_in, tmp, row0 + 3 * NGW, lane, b1);
        norm_row<HIN16, HOUT16>(C, hout_main, tmp, g_post, g_next, out8, row0, lane, a0); norm_row<HIN16, HOUT16>(C, hout_main, tmp, g_post, g_next, out8, row0 + NGW, lane, a1);
        norm_load<HIN16>(C, hin_main, hx_in, tmp, row0 + 4 * NGW, lane, a0); norm_load<HIN16>(C, hin_main, hx_in, tmp, row0 + 5 * NGW, lane, a1);
        norm_row<HIN16, HOUT16>(C, hout_main, tmp, g_post, g_next, out8, row0 + 2 * NGW, lane, b0); norm_row<HIN16, HOUT16>(C, hout_main, tmp, g_post, g_next, out8, row0 + 3 * NGW, lane, b1);
    }
}

typedef short s16x4 __attribute__((ext_vector_type(4)));
constexpr int SLOT = 18432;
constexpr int O_W = 0, O_R = 2048, O_BK = 4096, O_ARK = 8192, O_TA = 9216, O_GAM = 9728, O_VT = 10240, O_TMP = 12288, O_B = 12288, O_K = 14336, O_AT = 16384;
constexpr int OPS_SH = 10240, OPS_VT = 10240, OPS_G = 12288, OPS_BG = 14336;
constexpr int NCHUNK = TT / 16;
__device__ __forceinline__ bf16x8 cat8(s16x4 a, s16x4 b) { return __builtin_shufflevector(a, b, 0, 1, 2, 3, 4, 5, 6, 7); }
__device__ __forceinline__ s16x4 pack4(f32x4 v) { v2u w = (v2u){pk2(v.x, v.y), pk2(v.z, v.w)}; return __builtin_bit_cast(s16x4, w); }
__device__ __forceinline__ s16x4 pack4f(float a, float b, float c, float d) { v2u w = (v2u){pk2(a, b), pk2(c, d)}; return __builtin_bit_cast(s16x4, w); }
__device__ __forceinline__ f32x4 mfma16(bf16x8 a, bf16x8 b, f32x4 c) { return __builtin_amdgcn_mfma_f32_16x16x32_bf16(a, b, c, 0, 0, 0); }
__device__ __forceinline__ void unpack4(v2u w, float (&o)[4]) { o[0] = __uint_as_float(w.x << 16); o[1] = __uint_as_float(w.x & 0xffff0000u); o[2] = __uint_as_float(w.y << 16); o[3] = __uint_as_float(w.y & 0xffff0000u); }


struct PostLd { unsigned short q1, q2, qi1, qi2, ki, a0, a1, a2, a3, a4; v2u ckv; float cs, sn; };
__device__ __forceinline__ void post_load(const Ctx& C, int l, int row, int lane, PostLd& o) {
    const int p = row < MAINR ? NMETA + (row & 8191) : row - MAINR;
    const bf16* z = C.Z() + (size_t)row * ZC;
    const int hh = lane >> 3, i = lane & 7;
    o.cs = C.COS()[p * 8 + i]; o.sn = C.SIN()[p * 8 + i];
    o.q1 = z[C_Q + hh * 64 + i]; o.q2 = z[C_Q + hh * 64 + 8 + i];
    o.qi1 = z[C_QI + (hh & 3) * 64 + i]; o.qi2 = z[C_QI + (hh & 3) * 64 + 8 + i];
    o.ki = z[C_KI + lane];
    o.ckv = *(const v2u*)(z + C_CKV + lane * 4);
    o.a0 = z[C_XW + lane]; o.a1 = z[C_XA + lane]; o.a2 = z[C_XG + lane]; o.a3 = z[C_XG + 64 + lane];
    o.a4 = lane < 32 ? z[C_XG + 128 + lane] : (l == 1 ? z[C_XV + lane - 32] : (unsigned short)0);
}
__device__ __forceinline__ float shiftf(unsigned short a_, unsigned short p_, float mu) { const float a = bf2f(a_), pr = bf2f(p_); return a + (pr - a) * mu; }
__device__ __forceinline__ void post_compute(const Ctx& C, int l, int row, int lane, const PostLd& d, const unsigned short (&pv)[5], const float (&mu)[5], const f32x4 kvg, const float ig, const float ib, LAS unsigned char* cl) {
    int b, p; if (row < MAINR) { b = row >> 13; p = NMETA + (row & 8191); } else { b = -1; p = row - MAINR; }
    bf16* z = C.Z() + (size_t)row * ZC;
    const int hh = lane >> 3, i = lane & 7; const float c = d.cs, s = d.sn;
    { const float t1 = bf2f(d.q1), t2 = bf2f(d.q2);
      z[C_Q + hh * 64 + i] = (bf16)f2bf(t1 * c - t2 * s); z[C_Q + hh * 64 + 8 + i] = (bf16)f2bf(t2 * c + t1 * s); }
    if (lane < 32) { const float t1 = bf2f(d.qi1), t2 = bf2f(d.qi2);
      z[C_QI + hh * 64 + i] = (bf16)f2bf(t1 * c - t2 * s); z[C_QI + hh * 64 + 8 + i] = (bf16)f2bf(t2 * c + t1 * s); }
    {
        const float x = bf2f(d.ki);
        const float mu_ = wave_sum(x) * (1.f / 64.f); const float dd = x - mu_; const float var = wave_sum(dd * dd) * (1.f / 64.f);
        float y = dd * __builtin_amdgcn_rsqf(var + NORM_EPS) * ig + ib;
        const float o = dpp_f<0x128>(y);
        if (lane < 8) y = y * c - o * s; else if (lane < 16) y = y * c + o * s;
        const bf16 yb = (bf16)f2bf(y);
        const size_t ko = ((size_t)((p >> 5) * 4 + (lane >> 4)) * 64 + ((lane >> 3) & 1) * 32 + (p & 31)) * 8 + (lane & 7);
        if (b >= 0) C.KI()[(size_t)b * TPAD * 64 + ko] = yb;
        else {
#pragma unroll
            for (int bb = 0; bb < NB; ++bb) C.KI()[(size_t)bb * TPAD * 64 + ko] = yb; }
    }
    {
        const v2u w = d.ckv;
        f32x4 x = (f32x4){__uint_as_float(w.x << 16), __uint_as_float(w.x & 0xffff0000u), __uint_as_float(w.y << 16), __uint_as_float(w.y & 0xffff0000u)};
        const float ms = wave_sum((x.x * x.x + x.y * x.y) + (x.z * x.z + x.w * x.w)) * (1.f / 256.f);
        const float rstd = __builtin_amdgcn_rsqf(ms + NORM_EPS);
        x = x * rstd * kvg;
        *(LAS v2u*)((LAS unsigned char*)cl + lane * 8) = (v2u){pk2(x.x, x.y), pk2(x.z, x.w)};
    }
    bf16* ar = C.ACT() + (size_t)(row >> 4) * (16 * ACTC) + ((lane >> 3) * 16 + (row & 15)) * 8 + (lane & 7);
    const float x0 = shiftf(d.a0, pv[0], mu[0]); ar[0] = (bf16)f2bf(2.f * sigmoidf_(2.f * x0) - 1.f);
    ar[1024] = (bf16)f2bf(shiftf(d.a1, pv[1], mu[1]));
    ar[2048] = (bf16)f2bf(sigmoidf_(shiftf(d.a2, pv[2], mu[2])));
    ar[3072] = (bf16)f2bf(sigmoidf_(shiftf(d.a3, pv[3], mu[3])));
    float x4;
    if (lane < 32) x4 = sigmoidf_(shiftf(d.a4, pv[4], mu[4])); else x4 = l == 1 ? shiftf(d.a4, pv[4], mu[4]) : 0.f;
    ar[4096] = (bf16)f2bf(x4);
}
constexpr int CLP = 528;
__device__ __forceinline__ void phase_post(const Ctx& C, int l, bool doA) {
    int lane_ = lane_now(); const int lane = lane_, g = lane >> 4, cc = lane & 15;
    const int gw = C.bid * NWAVES + C.wid, NGW = C.G * NWAVES;
    LAS unsigned char* cl = C.lds + C.wid * (16 * CLP);
    const float* mup = C.I(I_MU) + l * 1824;
    const float mu[5] = {mup[1536 + lane], mup[1600 + lane], mup[1664 + lane], mup[1728 + lane], lane < 32 ? mup[1792 + lane] : (l == 1 ? C.I(I_MUV)[lane - 32] : 0.f)};
    const f32x4 kvg = *(const f32x4*)(C.I(I_KVN) + l * 256 + lane * 4); const float ig = C.I(I_IDXG)[l * 64 + lane], ib = C.I(I_IDXB)[l * 64 + lane];
    const bf16* wkv = (const bf16*)(C.ws + WS_WKV) + (size_t)l * 128 * 256 + (size_t)cc * 256 + 8 * g;
#define POST_PREV(prow_, has_, pv_) do { const bf16* zp_ = C.Z() + (size_t)(prow_) * ZC; \
        pv_[0] = zp_[C_XW + lane]; pv_[1] = zp_[C_XA + lane]; pv_[2] = zp_[C_XG + lane]; pv_[3] = zp_[C_XG + 64 + lane]; pv_[4] = lane < 32 ? zp_[C_XG + 128 + lane] : (l == 1 ? zp_[C_XV + lane - 32] : (unsigned short)0); \
        if (!(has_)) { pv_[0] = 0; pv_[1] = 0; pv_[2] = 0; pv_[3] = 0; pv_[4] = 0; } } while (0)
#define POST_NEXT(pv_, d_) do { pv_[0] = d_.a0; pv_[1] = d_.a1; pv_[2] = d_.a2; pv_[3] = d_.a3; pv_[4] = d_.a4; } while (0)
#define POST_KV(row0_, cl_) do { const int kvrow0 = (row0_); \
        bf16x8 Af[8]; \
        _Pragma("unroll") for (int ks = 0; ks < 8; ++ks) Af[ks] = *(const LAS bf16x8*)((cl_) + cc * CLP + (32 * ks + 8 * g) * 2); \
        const bool ismeta = kvrow0 >= MAINR; const int bq = ismeta ? 0 : kvrow0 >> 13; const int pb = ismeta ? kvrow0 - MAINR : NMETA + (kvrow0 & 8191); \
        _Pragma("unroll 2") for (int nt = 0; nt < 8; ++nt) { \
            bf16x8 Bf[8]; \
            _Pragma("unroll") for (int ks = 0; ks < 8; ++ks) Bf[ks] = *(const bf16x8*)(wkv + (size_t)nt * 16 * 256 + 32 * ks); \
            f32x4 acc = (f32x4){0.f, 0.f, 0.f, 0.f}; \
            _Pragma("unroll") for (int ks = 0; ks < 8; ++ks) acc = mfma16(Af[ks], Bf[ks], acc); \
            bf16* dst = (nt < 4 ? C.KATT() : C.VATT()) + (nt & 3) * 16 + cc; \
            _Pragma("unroll") for (int r = 0; r < 4; ++r) { const int p = pb + 4 * g + r; float v = acc[r]; \
                if (nt == 0) { const float o = __shfl_xor(v, 8); const float cs = C.COS()[p * 8 + (cc & 7)], sn = C.SIN()[p * 8 + (cc & 7)]; v = cc < 8 ? v * cs - o * sn : v * cs + o * sn; } \
                const bf16 vb = (bf16)f2bf(v); \
                if (!ismeta) dst[((size_t)bq * TPAD + p) * 64] = vb; \
                else { _Pragma("unroll") for (int bb = 0; bb < NB; ++bb) dst[((size_t)bb * TPAD + p) * 64] = vb; } } } } while (0)
    for (int grp = gw; grp < MAINR / 16; grp += NGW) {
        const int row0 = grp * 16;
        unsigned short pv[5];
        { const int s0 = row0 & 8191; POST_PREV(s0 == 0 ? MAINR + 15 : row0 - 1, true, pv); }
        PostLd d0, d1; post_load(C, l, row0, lane, d0);
#pragma unroll 1
        for (int rr = 0; rr < 16; rr += 2) {
            post_load(C, l, row0 + rr + 1, lane, d1);
            post_compute(C, l, row0 + rr, lane, d0, pv, mu, kvg, ig, ib, cl + rr * CLP); POST_NEXT(pv, d0);
            if (rr + 2 < 16) post_load(C, l, row0 + rr + 2, lane, d0);
            post_compute(C, l, row0 + rr + 1, lane, d1, pv, mu, kvg, ig, ib, cl + (rr + 1) * CLP); POST_NEXT(pv, d1);
        }
        asm volatile("s_waitcnt lgkmcnt(0)" ::: "memory");
        POST_KV(row0, cl);
    }
    if (C.bid == C.G - 1) {
        LAS unsigned char* clm = C.lds + NWAVES * 16 * CLP;
        const int r0 = MAINR + 2 * C.wid;
        unsigned short pv[5]; POST_PREV(r0 == MAINR ? r0 : r0 - 1, r0 != MAINR, pv);
        PostLd d0, d1; post_load(C, l, r0, lane, d0); post_load(C, l, r0 + 1, lane, d1);
        post_compute(C, l, r0, lane, d0, pv, mu, kvg, ig, ib, clm + (2 * C.wid) * CLP); POST_NEXT(pv, d0);
        post_compute(C, l, r0 + 1, lane, d1, pv, mu, kvg, ig, ib, clm + (2 * C.wid + 1) * CLP);
        asm volatile("s_waitcnt lgkmcnt(0)" ::: "memory");
        __syncthreads();
        if (C.wid == 0) POST_KV(MAINR, clm);
    }
#undef POST_PREV
#undef POST_NEXT
#undef POST_KV
}

__device__ __forceinline__ void prep_copy(LAS unsigned char* sl, unsigned char* ops, int lane) {
#pragma unroll
    for (int i = 0; i < 12; ++i) *(v4u*)(ops + (i * 64 + lane) * 16) = *(const LAS v4u*)(sl + (i * 64 + lane) * 16);
    asm volatile("s_waitcnt lgkmcnt(0)" ::: "memory");
}
template <bool SHARED>
__device__ __forceinline__ unsigned char* prep_unit(const Ctx& C, int l, int bh, int bhl, int cidx, LAS unsigned char* sl, unsigned char* prev_ops) {
    int lane_ = lane_now(); const int lane = lane_, g = lane >> 4, c = lane & 15;
    const int b = bh >> 3, h = bh & 7;
    const int row0 = cidx == 0 ? MAINR : b * SEQ + 16 * (cidx - 1);
    const bf16x8 zero8 = (bf16x8){0, 0, 0, 0, 0, 0, 0, 0};
    const f32x4 z4 = (f32x4){0.f, 0.f, 0.f, 0.f};
    f32x4 aw[4], aa[4], ag[4], av[4];
    const int ch0 = h * 64 + 4 * c;
    const bf16* zb = C.Z() + C_R + ch0;
    v2u wr[4], wk[4], wv[4], wf[4], pwr, pwk, pwv;
    const bf16* act = C.ACT() + (size_t)(row0 >> 4) * (16 * ACTC) + lane * 8;
    const bf16* wl = C.WLT() + (size_t)l * 512 * ACTC + (size_t)(h * 4) * (10 * 512) + lane * 8;
    bf16x8 Af[10], BfA[10], BfB[10];
#define PREP_LDB(Bf, n) do { if (SHARED) { _Pragma("unroll") for (int ks = 0; ks < 10; ++ks) Bf[ks] = *(const LAS bf16x8*)(C.lds + (((n) * 10 + ks) * 64 + lane) * 16); } \
        else { _Pragma("unroll") for (int ks = 0; ks < 10; ++ks) Bf[ks] = *(const bf16x8*)(wl + ((n) * 10 + ks) * 512); } } while (0)
#define PREP_MM(Bf, n) do { aw[n] = mfma16(Af[1], Bf[1], mfma16(Af[0], Bf[0], z4)); aa[n] = mfma16(Af[3], Bf[3], mfma16(Af[2], Bf[2], z4)); \
        { f32x4 t = z4; _Pragma("unroll") for (int ks = 4; ks < 9; ++ks) t = mfma16(Af[ks], Bf[ks], t); ag[n] = t; } av[n] = mfma16(Af[9], Bf[9], z4); } while (0)
    if (SHARED) {
        __syncthreads();
#pragma unroll
        for (int i = 0; i < 5; ++i) { const int blk = C.wid + 8 * i;
            __builtin_amdgcn_global_load_lds((const unsigned*)(wl - lane * 8 + blk * 512 + lane * 8), (LAS unsigned*)(C.lds + blk * 1024), 16, 0, 0); }
    }
#pragma unroll
    for (int ks = 0; ks < 10; ++ks) Af[ks] = *(const bf16x8*)(act + 512 * ks);
    if (!SHARED) { PREP_LDB(BfA, 0); PREP_LDB(BfB, 1); }
#pragma unroll
    for (int r = 0; r < 4; ++r) { const size_t row = row0 + 4 * g + r;
        wr[r] = *(const v2u*)(zb + row * ZC); wk[r] = *(const v2u*)(zb + row * ZC + 512); wv[r] = *(const v2u*)(zb + row * ZC + 1024);
        wf[r] = l == 1 ? *(const v2u*)(C.VF() + row * 512 + ch0) : (v2u){0u, 0u}; }
    {
        bool hasprev = true; int prow;
        if (g > 0) prow = row0 + 4 * g - 1; else if (cidx == 0) { hasprev = false; prow = row0; } else prow = cidx == 1 ? MAINR + 15 : row0 - 1;
        pwr = *(const v2u*)(zb + (size_t)prow * ZC); pwk = *(const v2u*)(zb + (size_t)prow * ZC + 512); pwv = *(const v2u*)(zb + (size_t)prow * ZC + 1024);
        if (!hasprev) { pwr = (v2u){0u, 0u}; pwk = pwr; pwv = pwr; }
    }
    asm volatile("" ::: "memory");
    if (prev_ops) prep_copy(sl, prev_ops, lane);
    asm volatile("" ::: "memory");
    if (SHARED) { asm volatile("s_waitcnt vmcnt(0)" ::: "memory"); __syncthreads(); PREP_LDB(BfA, 0); PREP_LDB(BfB, 1); }
    PREP_MM(BfA, 0);
    asm volatile("" ::: "memory");
    PREP_LDB(BfA, 2);
    asm volatile("" ::: "memory");
    PREP_MM(BfB, 1);
    asm volatile("" ::: "memory");
    PREP_LDB(BfB, 3);
    const f32x4 w0v = *(const f32x4*)(C.I(I_W0) + l * 512 + ch0), a0v = *(const f32x4*)(C.I(I_A0) + l * 512 + ch0);
    const f32x4 v0v = l == 1 ? *(const f32x4*)(C.I(I_V0) + ch0) : z4;
    const f32x4 mur = *(const f32x4*)(C.I(I_MU) + l * 1824 + ch0), muk = *(const f32x4*)(C.I(I_MU) + l * 1824 + 512 + ch0), muv = *(const f32x4*)(C.I(I_MU) + l * 1824 + 1024 + ch0);
    const f32x4 kkc = *(const f32x4*)(C.I(I_KK) + l * 512 + ch0), kac = *(const f32x4*)(C.I(I_KA) + l * 512 + ch0), rkc = *(const f32x4*)(C.I(I_RK) + l * 512 + ch0);
    const f32x4 lnw = *(const f32x4*)(C.I(I_LNW) + l * 512 + ch0), lnb = *(const f32x4*)(C.I(I_LNB) + l * 512 + ch0);
    asm volatile("" ::: "memory");
    PREP_MM(BfA, 2);
    PREP_MM(BfB, 3);
    asm volatile("" ::: "memory");
    if (SHARED) { asm volatile("s_waitcnt lgkmcnt(0)" ::: "memory"); __syncthreads(); }
#undef PREP_LDB
#undef PREP_MM
    float At[4][4], Bt[4][4], Kt[4][4], Vv[4][4], gam[4];
    unsigned char* ops = C.ws + WS_OPS + ((size_t)bhl * NCHUNK + cidx) * OPSB;
    {
        float lw[4][4], cum[4][4];
#pragma unroll
        for (int r = 0; r < 4; ++r)
#pragma unroll
            for (int n = 0; n < 4; ++n) lw[r][n] = -0.6065306597126334f * sigmoidf_(w0v[n] + aw[n][r]);
#pragma unroll
        for (int n = 0; n < 4; ++n) { cum[0][n] = lw[0][n]; cum[1][n] = cum[0][n] + lw[1][n]; cum[2][n] = cum[1][n] + lw[2][n]; cum[3][n] = cum[2][n] + lw[3][n];
            const float tot = cum[3][n];
            const u2v r16 = __builtin_amdgcn_permlane16_swap(__float_as_uint(tot), __float_as_uint(tot), false, false);
            const float x16 = __uint_as_float((g & 1) ? r16.x : r16.y), pr2 = tot + x16;
            const u2v r32 = __builtin_amdgcn_permlane32_swap(__float_as_uint(pr2), __float_as_uint(pr2), false, false);
            const float off = ((g & 1) ? x16 : 0.f) + ((g & 2) ? __uint_as_float(r32.x) : 0.f);
#pragma unroll
            for (int r = 0; r < 4; ++r) cum[r][n] += off;
            gam[n] = 0.f; }
        float pr[4], pk[4], pv[4]; unpack4(pwr, pr); unpack4(pwk, pk); unpack4(pwv, pv);
        float ecp[4];
#pragma unroll
        for (int n = 0; n < 4; ++n) ecp[n] = __expf(cum[0][n] - lw[0][n]);
#pragma unroll
        for (int r = 0; r < 4; ++r) {
            float rr[4], kr[4], vr[4], vf[4]; unpack4(wr[r], rr); unpack4(wk[r], kr); unpack4(wv[r], vr); unpack4(wf[r], vf);
            float rs[4], ks[4], vs[4], kk[4], ss = 0.f;
#pragma unroll
            for (int n = 0; n < 4; ++n) { rs[n] = rr[n] + (pr[n] - rr[n]) * mur[n]; ks[n] = kr[n] + (pk[n] - kr[n]) * muk[n]; vs[n] = vr[n] + (pv[n] - vr[n]) * muv[n];
                pr[n] = rr[n]; pk[n] = kr[n]; pv[n] = vr[n]; kk[n] = ks[n] * kkc[n]; ss += kk[n] * kk[n]; }
            ss = row16_sum(ss);
            const float inv = __builtin_amdgcn_rcpf(fmaxf(__builtin_amdgcn_sqrtf(ss), 1e-12f));
            float k2[4], v2[4], Rt[4], Gp[4], BGp[4], rks = 0.f;
#pragma unroll
            for (int n = 0; n < 4; ++n) { const float a = sigmoidf_(a0v[n] + aa[n][r]); kk[n] *= inv; k2[n] = ks[n] * (1.f + (a - 1.f) * kac[n]);
                const float bb = kk[n] * a; v2[n] = l == 0 ? vs[n] : vs[n] + (vf[n] - vs[n]) * sigmoidf_(v0v[n] + av[n][r]);
                rks += rs[n] * k2[n] * rkc[n];
                const float ec = __expf(cum[r][n]), en = __builtin_amdgcn_rcpf(ec), ep = ecp[n]; ecp[n] = ec; if (r == 3) gam[n] = ec;
                At[r][n] = -kk[n] * ep; Bt[r][n] = bb * en; Kt[r][n] = k2[n] * en; Rt[n] = rs[n] * ec; Vv[r][n] = v2[n]; }
            rks = row16_sum(rks);
#pragma unroll
            for (int n = 0; n < 4; ++n) { const float gg = ag[n][r]; Gp[n] = lnw[n] * gg; BGp[n] = (lnb[n] + rks * v2[n]) * gg; }
            { const int t = 4 * g + r;
              *(LAS s16x4*)(sl + O_W + (t * 64 + 4 * c) * 2) = pack4f(At[r][0], At[r][1], At[r][2], At[r][3]);
              *(LAS s16x4*)(sl + O_B + (t * 64 + 4 * c) * 2) = pack4f(Bt[r][0], Bt[r][1], Bt[r][2], Bt[r][3]);
              *(LAS s16x4*)(sl + O_K + (t * 64 + 4 * c) * 2) = pack4f(Kt[r][0], Kt[r][1], Kt[r][2], Kt[r][3]);
              *(LAS s16x4*)(sl + O_R + (t * 64 + 4 * c) * 2) = pack4f(Rt[0], Rt[1], Rt[2], Rt[3]);
              *(s16x4*)(ops + OPS_G + (t * 64 + 4 * c) * 2) = pack4f(Gp[0], Gp[1], Gp[2], Gp[3]);
              *(s16x4*)(ops + OPS_BG + (t * 64 + 4 * c) * 2) = pack4f(BGp[0], BGp[1], BGp[2], BGp[3]); }
            if (l == 0) *(v2u*)(C.VF() + (size_t)(row0 + 4 * g + r) * 512 + ch0) = (v2u){pk2(vs[0], vs[1]), pk2(vs[2], vs[3])};
        }
    }
#pragma unroll
    for (int n = 0; n < 4; ++n) { const int j = 4 * c + n;
        *(LAS s16x4*)(sl + O_AT + (j * 16 + 4 * g) * 2) = pack4f(At[0][n], At[1][n], At[2][n], At[3][n]);
        *(LAS s16x4*)(sl + O_BK + (j * 32 + 4 * g) * 2) = pack4f(Bt[0][n], Bt[1][n], Bt[2][n], Bt[3][n]);
        *(LAS s16x4*)(sl + O_BK + (j * 32 + 16 + 4 * g) * 2) = pack4f(Kt[0][n], Kt[1][n], Kt[2][n], Kt[3][n]);
        *(LAS s16x4*)(sl + O_VT + (j * 16 + 4 * g) * 2) = pack4f(Vv[0][n], Vv[1][n], Vv[2][n], Vv[3][n]); }
    if (g == 3) *(LAS f32x4*)(sl + O_GAM + 4 * c * 4) = (f32x4){gam[0], gam[1], gam[2], gam[3]};
    asm volatile("s_waitcnt lgkmcnt(0)" ::: "memory");
    {
        f32x4 aab = z4, aak = z4, arb = z4, ark = z4;
#pragma unroll
        for (int ks = 0; ks < 2; ++ks) {
            const bf16x8 Aa = *(const LAS bf16x8*)(sl + O_W + (c * 64 + 32 * ks + 8 * g) * 2), Ar = *(const LAS bf16x8*)(sl + O_R + (c * 64 + 32 * ks + 8 * g) * 2);
            const bf16x8 Bb = *(const LAS bf16x8*)(sl + O_B + (c * 64 + 32 * ks + 8 * g) * 2), Bk = *(const LAS bf16x8*)(sl + O_K + (c * 64 + 32 * ks + 8 * g) * 2);
            aab = mfma16(Aa, Bb, aab); aak = mfma16(Aa, Bk, aak); arb = mfma16(Ar, Bb, arb); ark = mfma16(Ar, Bk, ark);
        }
        asm volatile("" ::: "memory");
        f32x4 mk;
#pragma unroll
        for (int r = 0; r < 4; ++r) { const int t = 4 * g + r; const bool lo = c < t, li = c <= t;
            *(LAS float*)(sl + O_B + (t * 16 + c) * 4) = lo ? aab[r] : 0.f;
            mk[r] = lo ? aak[r] : 0.f;
            *(LAS bf16*)(sl + O_ARK + (t * 32 + c) * 2) = (bf16)f2bf(li ? arb[r] : 0.f);
            *(LAS bf16*)(sl + O_ARK + (t * 32 + 16 + c) * 2) = (bf16)f2bf(li ? ark[r] : 0.f); }
        *(LAS s16x4*)(sl + O_K + (c * 16 + 4 * g) * 2) = pack4(mk);
    }
    asm volatile("s_waitcnt lgkmcnt(0)" ::: "memory");
    {
        float X[16];
#pragma unroll
        for (int t = 0; t < 16; ++t) { float acc = (t == c) ? 1.f : 0.f;
#pragma unroll
            for (int s4 = 0; s4 < (t + 3) / 4; ++s4) { const f32x4 a4 = *(const LAS f32x4*)(sl + O_B + (t * 16 + 4 * s4) * 4);
#pragma unroll
                for (int e = 0; e < 4; ++e) if (4 * s4 + e < t) acc += a4[e] * X[4 * s4 + e]; }
            X[t] = acc; }
#pragma unroll
        for (int t = 0; t < 16; ++t) *(LAS bf16*)(sl + O_K + 512 + (t * 16 + c) * 2) = (bf16)f2bf(X[t]);
    }
    asm volatile("s_waitcnt lgkmcnt(0)" ::: "memory");
    {
        const bf16x8 Top = g < 2 ? *(const LAS bf16x8*)(sl + O_K + 512 + (c * 16 + 8 * g) * 2) : zero8;
#pragma unroll
        for (int n = 0; n < 4; ++n) { const bf16x8 Bop = g < 2 ? *(const LAS bf16x8*)(sl + O_AT + ((16 * n + c) * 16 + 8 * g) * 2) : zero8;
            const f32x4 wacc = mfma16(Top, Bop, z4);
#pragma unroll
            for (int r = 0; r < 4; ++r) *(LAS bf16*)(sl + O_W + ((4 * g + r) * 64 + 16 * n + c) * 2) = (bf16)f2bf(wacc[r]); }
        const bf16x8 Bop = g < 2 ? *(const LAS bf16x8*)(sl + O_K + (c * 16 + 8 * g) * 2) : zero8;
        const f32x4 ta = mfma16(Top, Bop, z4);
#pragma unroll
        for (int r = 0; r < 4; ++r) *(LAS bf16*)(sl + O_TA + ((4 * g + r) * 16 + c) * 2) = (bf16)f2bf(ta[r]);
    }
    asm volatile("s_waitcnt lgkmcnt(0)" ::: "memory");
    return ops;
}

__device__ __forceinline__ void phase_prep(const Ctx& C, int l, int half) {
    const int gw = C.bid * NWAVES + C.wid, NGW = C.G * NWAVES;
    LAS unsigned char* sl = C.lds + C.wid * SLOT;
    unsigned char* pops = nullptr;
    for (int u = gw; u < 16 * 512; u += NGW) { const int bhl = u >> 9, cidx = u & 511; pops = prep_unit<false>(C, l, 16 * half + bhl, bhl, cidx, sl, pops); }
    if (pops) prep_copy(sl, pops, lane_now());
}

struct OpsSet { v4u d[10]; };
struct GbSet { v4u d[4]; };
struct VtSet { v2u v4[4]; };
constexpr int RING_SLOT = 11520, YB_OFF = 8 * RING_SLOT, YB_SLOT = 4096;
__device__ __forceinline__ int swz(int x) { return x + ((x >> 7) << 4); }

__device__ __forceinline__ void ld_ops(OpsSet& s, const unsigned char* ops, int c, int lane) {
    const unsigned char* p = ops + (size_t)(c < NCHUNK ? c : NCHUNK - 1) * OPSB + lane * 16;
#pragma unroll
    for (int i = 0; i < 10; ++i) s.d[i] = *(const v4u*)(p + i * 1024);
}
__device__ __forceinline__ void st_ops(const OpsSet& s, LAS unsigned char* ring, int c, int lane) {
    LAS unsigned char* p = ring + (c & 7) * RING_SLOT + lane * 16 + (lane >> 3) * 16;
#pragma unroll
    for (int i = 0; i < 10; ++i) *(LAS v4u*)(p + i * 1152) = s.d[i];
}
__device__ __forceinline__ void ld_gb(GbSet& s, const unsigned char* ops, int c, int lane) {
    const int t = lane >> 2, cg = lane & 3;
    const unsigned char* p = ops + (size_t)(c < NCHUNK ? c : NCHUNK - 1) * OPSB + (t * 64 + 16 * cg) * 2;
    s.d[0] = *(const v4u*)(p + OPS_G); s.d[1] = *(const v4u*)(p + OPS_G + 16); s.d[2] = *(const v4u*)(p + OPS_BG); s.d[3] = *(const v4u*)(p + OPS_BG + 16);
}
__device__ __forceinline__ void ld_vt(VtSet& s, const unsigned char* ops, int j, int wid, int lane) {
    const int g = lane >> 4, c = lane & 15;
#pragma unroll
    for (int u = 0; u < 4; ++u) { const int ch = 4 * j + u; const unsigned char* p = ops + (size_t)(ch < NCHUNK ? ch : NCHUNK - 1) * OPSB + OPS_VT + (16 * wid + c) * 32;
        s.v4[u] = *(const v2u*)(p + g * 8); }
}
__device__ __forceinline__ void out_stage(const Ctx& C, const GbSet& s, LAS unsigned char* ybuf, int b, int hh, int c, int lane) {
    const int t = lane >> 2, cg = lane & 3;
    const int row = (c == 0 ? MAINR : b * SEQ + 16 * (c - 1)) + t;
    const LAS float* yp = (const LAS float*)(ybuf + (c & 7) * YB_SLOT) + t * 64 + 16 * cg;
    f32x4 y[4];
#pragma unroll
    for (int i = 0; i < 4; ++i) y[i] = *(const LAS f32x4*)(yp + 4 * i);
    float s1 = 0.f;
#pragma unroll
    for (int i = 0; i < 4; ++i) s1 += (y[i].x + y[i].y) + (y[i].z + y[i].w);
    s1 = quad_sum(s1);
    const float mean = s1 * (1.f / 64.f); float s2 = 0.f;
#pragma unroll
    for (int i = 0; i < 4; ++i) { y[i] = y[i] - mean; s2 += (y[i].x * y[i].x + y[i].y * y[i].y) + (y[i].z * y[i].z + y[i].w * y[i].w); }
    s2 = quad_sum(s2);
    const float rstd = __builtin_amdgcn_rsqf(s2 * (1.f / 64.f) + GN_EPS);
    v4u o[2];
#pragma unroll
    for (int k = 0; k < 2; ++k) {
        const v4u gw = s.d[k], bw = s.d[2 + k]; unsigned ow[4];
#pragma unroll
        for (int e = 0; e < 4; ++e) { const f32x4 yy = y[2 * k + (e >> 1)]; const float ya = (e & 1) ? yy.z : yy.x, yb = (e & 1) ? yy.w : yy.y;
            const float g0 = __uint_as_float(gw[e] << 16), g1 = __uint_as_float(gw[e] & 0xffff0000u), b0 = __uint_as_float(bw[e] << 16), b1 = __uint_as_float(bw[e] & 0xffff0000u);
            ow[e] = pk2(ya * rstd * g0 + b0, yb * rstd * g1 + b1); }
        o[k] = (v4u){ow[0], ow[1], ow[2], ow[3]};
    }
    bf16* dst = C.U() + (size_t)row * DM + 512 + hh * 64 + 16 * cg;
    *(v4u*)dst = o[0]; *(v4u*)(dst + 8) = o[1];
}

struct ChEarly { bf16x8 Wp[2], Rp[2]; s16x4 TAop; };
struct ChLate { bf16x8 ARKp, BKp[4]; f32x4 gam[4]; };
__device__ __forceinline__ void chain_load_e(ChEarly& o, const LAS unsigned char* p1, const LAS unsigned char* p2, const int so) {
#pragma unroll
    for (int ks = 0; ks < 2; ++ks) {
        o.Wp[ks] = cat8(*(const LAS s16x4*)(p1 + so + 64 * ks), *(const LAS s16x4*)(p1 + so + 64 * ks + 32));
        o.Rp[ks] = cat8(*(const LAS s16x4*)(p1 + so + 2304 + 64 * ks), *(const LAS s16x4*)(p1 + so + 2304 + 64 * ks + 32)); }
    o.TAop = *(const LAS s16x4*)(p2 + so + 10368);
}
__device__ __forceinline__ void chain_load_l(ChLate& o, const LAS unsigned char* p3, const LAS unsigned char* p4, const int so) {
    o.ARKp = cat8(*(const LAS s16x4*)(p3 + so + 9216), *(const LAS s16x4*)(p3 + so + 9216 + 32));
#pragma unroll
    for (int q = 0; q < 4; ++q) { o.BKp[q] = cat8(*(const LAS s16x4*)(p3 + so + 4608 + 1152 * q), *(const LAS s16x4*)(p3 + so + 4608 + 1152 * q + 32));
        o.gam[q] = *(const LAS f32x4*)(p4 + so + 9728 + 76 * 16 + 64 * q + (q >= 2 ? 16 : 0)); }
}
__device__ __forceinline__ f32x4 chain_compute(const ChEarly& e, const ChLate& o, const v2u v4w, f32x4 (&ST)[4]) {
    const s16x4 V4 = __builtin_bit_cast(s16x4, v4w); const s16x4 zero4 = (s16x4){0, 0, 0, 0};
    const bf16x8 TAop = cat8(e.TAop, zero4), Vb = cat8(V4, zero4);
    const f32x4 z4 = (f32x4){0.f, 0.f, 0.f, 0.f};
    const bf16x8 Bk0 = cat8(pack4(ST[0]), pack4(ST[1])), Bk1 = cat8(pack4(ST[2]), pack4(ST[3]));
    f32x4 U = mfma16(e.Wp[0], Bk0, z4); U = mfma16(e.Wp[1], Bk1, U); U = mfma16(TAop, Vb, U);
    f32x4 Y = mfma16(e.Rp[0], Bk0, z4); Y = mfma16(e.Rp[1], Bk1, Y);
    const bf16x8 UV = cat8(pack4(U), V4);
    Y = mfma16(o.ARKp, UV, Y);
#pragma unroll
    for (int q = 0; q < 4; ++q) { ST[q] = mfma16(o.BKp[q], UV, ST[q]); ST[q] = ST[q] * o.gam[q]; }
    return Y;
}

#define WAIT_LAST() do { unsigned sp_ = 0; while (__hip_atomic_load(flagw, __ATOMIC_RELAXED, __HIP_MEMORY_SCOPE_AGENT) < 2u && ++sp_ < (1u << 20)) __builtin_amdgcn_s_sleep(8); \
    __builtin_amdgcn_fence(__ATOMIC_ACQUIRE, "agent"); asm volatile("s_waitcnt vmcnt(0)" ::: "memory"); } while (0)
#define WG_BAR() do { asm volatile("s_waitcnt lgkmcnt(0)" ::: "memory"); __builtin_amdgcn_s_barrier(); asm volatile("" ::: "memory"); } while (0)
#define YSTORE(ch, Yv) do { _Pragma("unroll") for (int r = 0; r < 4; ++r) *(LAS float*)(ybuf + ((ch) & 7) * YB_SLOT + ((4 * (lane >> 4) + r) * 64 + 16 * wid + (lane & 15)) * 4) = (Yv)[r]; } while (0)
#define CHAIN_IT(j, VTU, HB) do { \
    ChEarly ea, eb; ChLate la; f32x4 Yv; \
    chain_load_e(ea, p1 + HB, p2 + HB, 0); \
    chain_load_l(la, p3 + HB, p4 + HB, 0); chain_load_e(eb, p1 + HB, p2 + HB, RING_SLOT); \
    Yv = chain_compute(ea, la, VTU.v4[0], ST); YSTORE(4 * (j) + 0, Yv); \
    chain_load_l(la, p3 + HB, p4 + HB, RING_SLOT); chain_load_e(ea, p1 + HB, p2 + HB, 2 * RING_SLOT); \
    Yv = chain_compute(eb, la, VTU.v4[1], ST); YSTORE(4 * (j) + 1, Yv); \
    chain_load_l(la, p3 + HB, p4 + HB, 2 * RING_SLOT); chain_load_e(eb, p1 + HB, p2 + HB, 3 * RING_SLOT); \
    Yv = chain_compute(ea, la, VTU.v4[2], ST); YSTORE(4 * (j) + 2, Yv); \
    chain_load_l(la, p3 + HB, p4 + HB, 3 * RING_SLOT); \
    Yv = chain_compute(eb, la, VTU.v4[3], ST); YSTORE(4 * (j) + 3, Yv); \
    ld_vt(VTU, ops, (j) + 2, wid, lane); WG_BAR(); } while (0)
#define LOAD_IT(j, OSW, OSI, GBO, GBI) do { \
    const int co = 4 * ((j) - 1) + lw; if ((j) >= 1 && co < NCHUNK) out_stage(C, GBO, ybuf, b, hh, co, lane); \
    const int cn = 4 * ((j) + 1) + lw; if (cn < NCHUNK) st_ops(OSW, ring, cn, lane); \
    ld_ops(OSI, ops, 4 * ((j) + 3) + lw, lane); ld_gb(GBI, ops, cn, lane); WG_BAR(); } while (0)

__device__ __forceinline__ void chain_phase(const Ctx& C, int bh, int bhl, unsigned* flagw) {
    int lane_ = lane_now(); const int lane = lane_, wid = C.wid;
    const int b = bh >> 3, hh = bh & 7;
    LAS unsigned char* ring = C.lds; LAS unsigned char* ybuf = C.lds + YB_OFF;
    const unsigned char* ops = C.ws + WS_OPS + (size_t)bhl * NCHUNK * OPSB;
    constexpr int NIT = 132;
    if (wid < 4) {
        f32x4 ST[4];
#pragma unroll
        for (int q = 0; q < 4; ++q) ST[q] = (f32x4){0.f, 0.f, 0.f, 0.f};
        VtSet vt0, vt1;
        ld_vt(vt0, ops, 0, wid, lane); ld_vt(vt1, ops, 1, wid, lane);
        WG_BAR();
        __builtin_amdgcn_s_setprio(3);
        const int g_ = lane >> 4, c_ = lane & 15;
        const LAS unsigned char* p1 = ring + c_ * 144 + 8 * g_;
        const LAS unsigned char* p2 = ring + c_ * 32 + 8 * g_ + (c_ >> 2) * 16;
        const LAS unsigned char* p3 = ring + c_ * 64 + 8 * g_ + (c_ >> 1) * 16;
        const LAS unsigned char* p4 = ring + 16 * g_;
#pragma unroll 1
        for (int j = 0; j < NIT; j += 2) {
            if (j == 96) WAIT_LAST();
#ifndef NOCHAIN
            CHAIN_IT(j, vt0, 0); CHAIN_IT(j + 1, vt1, 4 * RING_SLOT);
#endif
        }
        __builtin_amdgcn_s_setprio(0);
    } else {
        const int lw = wid - 4;
        OpsSet os0, os1, os2; GbSet gb0, gb1, gb2;
        ld_ops(os0, ops, lw, lane); ld_ops(os1, ops, 4 + lw, lane); ld_ops(os2, ops, 8 + lw, lane); ld_gb(gb0, ops, lw, lane); st_ops(os0, ring, lw, lane);
        gb1 = gb0; gb2 = gb0;
        WG_BAR();
#pragma unroll 1
        for (int j = 0; j < NIT; j += 3) {
            if (j == 96) WAIT_LAST();
#ifndef NOLOADER
            LOAD_IT(j, os1, os0, gb2, gb1); LOAD_IT(j + 1, os2, os1, gb0, gb2); LOAD_IT(j + 2, os0, os2, gb1, gb0);
#endif
        }
    }
}

constexpr int SCW = 8224;
constexpr int LDS_HIST = 8 * SCW * 2;
constexpr int LDS_IDX = LDS_HIST + 8 * 256 * 4;
constexpr int LDS_MISC = LDS_IDX + 8 * 256 * 2;
static_assert(LDS_MISC + 64 <= LDS_BYTES && 8 * 18432 <= LDS_BYTES && 8 * 10240 + 8 * 4096 <= LDS_MISC, "lds map");

__device__ __forceinline__ unsigned mbcnt64(unsigned long long m) { return __builtin_amdgcn_mbcnt_hi((unsigned)(m >> 32), __builtin_amdgcn_mbcnt_lo((unsigned)m, 0u)); }

__device__ __forceinline__ void find_bin(LAS unsigned* hist, unsigned target, int lane, unsigned& bin, unsigned& above) {
    const v4u c = *(LAS v4u*)(hist + 4 * lane);
    const unsigned t = c.x + c.y + c.z + c.w;
    const unsigned inc = wave_scan_incl(t);
    const unsigned total = lane_bcast(inc, 63);
    const unsigned sufx = total - inc;
    const bool found = (sufx < target) && (target <= sufx + t);
    unsigned mybin = 0, myab = 0;
    if (found) { unsigned a = sufx;
        if (a + c.w >= target) { mybin = 4 * lane + 3; myab = a; } else { a += c.w;
        if (a + c.z >= target) { mybin = 4 * lane + 2; myab = a; } else { a += c.z;
        if (a + c.y >= target) { mybin = 4 * lane + 1; myab = a; } else { a += c.y; mybin = 4 * lane; myab = a; } } } }
    const unsigned long long m = __ballot(found);
    const int src = m ? (int)__builtin_ctzll(m) : 0;
    bin = lane_bcast(mybin, src); above = lane_bcast(myab, src);
}

__device__ __forceinline__ void attn_unit(const Ctx& C, int l, int b, int qt) {
    const int lane = lane_now(), wid = C.wid, tid = wid * 64 + lane;
    const int p0 = 8 * qt, nk = p0 + 8, ntile = (nk + 31) >> 5, nkp = ntile * 32;
    LAS u16* SC = (LAS u16*)C.lds; LAS unsigned* HIST = (LAS unsigned*)(C.lds + LDS_HIST); LAS u16* IDX = (LAS u16*)(C.lds + LDS_IDX);
    for (int i = tid; i < 8 * 256; i += NT) HIST[i] = 0u;
    __syncthreads();
    const bf16* Z = C.Z();
    {
        const int r = lane & 31, half = lane >> 5;
        const int rowq = row_of(b, p0 + (r >> 2));
        bf16x8 Af[4];
#pragma unroll
        for (int s = 0; s < 4; ++s) Af[s] = *(const bf16x8*)(Z + (size_t)rowq * ZC + C_QI + (r & 3) * 64 + 16 * s + 8 * half);
        float wi[4][4];
#pragma unroll
        for (int g = 0; g < 4; ++g) { const int rg = row_of(b, p0 + 2 * g + half);
#pragma unroll
            for (int hh = 0; hh < 4; ++hh) wi[g][hh] = bf2f(Z[(size_t)rg * ZC + C_WI + hh]) * 0.0625f; }
        const unsigned char* kib = (const unsigned char*)(C.KI() + (size_t)b * TPAD * 64); const unsigned klane = (unsigned)lane * 16u;
        const unsigned char* kib2 = (const unsigned char*)(C.KI() + (size_t)((b + 1) & 3) * TPAD * 64);
#define SC_LOAD2(P, ka_, kb_) do { const int ka__ = (ka_), kb__ = (kb_); _Pragma("unroll") for (int s = 0; s < 4; ++s) { P[0][s] = *(const bf16x8*)(kib + ((unsigned)ka__ * 4096u + 1024u * s + klane)); P[1][s] = *(const bf16x8*)(kib + ((unsigned)kb__ * 4096u + 1024u * s + klane)); } } while (0)
#define SC_LOAD(P, kt_) do { _Pragma("unroll") for (int s = 0; s < 4; ++s) { P[0][s] = *(const bf16x8*)(kib + ((unsigned)(kt_) * 4096u + 1024u * s + klane)); P[1][s] = *(const bf16x8*)(kib + ((unsigned)((kt_) + 8) * 4096u + 1024u * s + klane)); \
    if (PROBE == 6) { bf16x8 d0 = *(const bf16x8*)(kib2 + ((unsigned)(kt_) * 4096u + 1024u * s + klane)), d1 = *(const bf16x8*)(kib2 + ((unsigned)((kt_) + 8) * 4096u + 1024u * s + klane)); asm volatile("" :: "v"(d0), "v"(d1)); } } } while (0)
#define SC_MFMA(acc, Bq) do { _Pragma("unroll") for (int e = 0; e < 16; ++e) acc[e] = 0.f; \
            _Pragma("unroll") for (int s = 0; s < 4; ++s) acc = __builtin_amdgcn_mfma_f32_32x32x16_bf16(Af[s], Bq[s], acc, 0, 0, 0); } while (0)
#define SC_KEY2(a_, b_) ({ const h2v hh_ = __builtin_convertvector((f32x2h){(a_), (b_)}, h2v); const unsigned w_ = __builtin_bit_cast(unsigned, hh_); \
            const s2v m_ = __builtin_bit_cast(s2v, w_) >> 15; w_ ^ (__builtin_bit_cast(unsigned, m_) | 0x80008000u); })
#define SC_SCORES(acc) float scv[4]; \
            _Pragma("unroll") for (int g = 0; g < 4; ++g) { \
                const float r0 = relu_i(acc[4 * g + 0]), r1 = relu_i(acc[4 * g + 1]), r2 = relu_i(acc[4 * g + 2]), r3 = relu_i(acc[4 * g + 3]); \
                scv[g] = __builtin_fmaf(wi[g][3], r3, __builtin_fmaf(wi[g][2], r2, __builtin_fmaf(wi[g][1], r1, wi[g][0] * r0))); } \
            const unsigned w01 = SC_KEY2(scv[0], scv[1]), w23 = SC_KEY2(scv[2], scv[3]);
#define SC_EMIT_FULL() do { \
                SC[(0 + half) * SCW + key] = (u16)w01; SC[(2 + half) * SCW + key] = (u16)(w01 >> 16); SC[(4 + half) * SCW + key] = (u16)w23; SC[(6 + half) * SCW + key] = (u16)(w23 >> 16); \
                atomicAdd((unsigned*)(HIST + (0 + half) * 256 + ((w01 >> 8) & 0xffu)), 1u); atomicAdd((unsigned*)(HIST + (2 + half) * 256 + (w01 >> 24)), 1u); \
                atomicAdd((unsigned*)(HIST + (4 + half) * 256 + ((w23 >> 8) & 0xffu)), 1u); atomicAdd((unsigned*)(HIST + (6 + half) * 256 + (w23 >> 24)), 1u); } while (0)
#define SC_VALU_FAST(acc, kt_) do { const int key = (kt_) * 32 + r; SC_SCORES(acc) SC_EMIT_FULL(); } while (0)
#define SC_VALU(acc, kt_) do { const int kt__ = (kt_); if (kt__ < ntile) { const int key = kt__ * 32 + r; SC_SCORES(acc) \
            if (kt__ * 32 + 31 <= p0) SC_EMIT_FULL(); \
            else { \
                _Pragma("unroll") for (int g = 0; g < 4; ++g) { const unsigned wp = g < 2 ? w01 : w23; unsigned k16 = (g & 1) ? (wp >> 16) : (wp & 0xffffu); \
                    const int qq = 2 * g + half; const bool valid = key <= p0 + qq; \
                    if (!valid) k16 = 0u; \
                    SC[qq * SCW + key] = (u16)k16; \
                    if (valid) atomicAdd((unsigned*)(HIST + qq * 256 + (k16 >> 8)), 1u); } } } } while (0)
        bf16x8 P0[2][4], P1[2][4], P2[2][4];
        _Pragma("unroll 1") for (int rep7 = 0, n7 = (PROBE == 7 ? launder2() : 1); rep7 < n7; ++rep7) {
        LAS unsigned* HISTsave = HIST; if (rep7) HIST = (LAS unsigned*)(C.lds + 144384);
        const int nst = (ntile + 7) >> 3, nfull = (p0 + 1) >> 5, jfull = nfull > wid ? (nfull - wid + 7) >> 3 : 0;
#define TIDX(j) (wid + 8 * (j))
#define TSAFE(j) ((j) < nst ? TIDX(j) : wid)
        SC_LOAD2(P0, TSAFE(0), TSAFE(1)); SC_LOAD2(P1, TSAFE(2), TSAFE(3));
        int j = 0;
        for (; j + 6 <= jfull; j += 6) {
            f32x16 acc0, acc1;
            SC_LOAD2(P2, TSAFE(j + 4), TSAFE(j + 5));
            SC_MFMA(acc0, P0[0]); SC_MFMA(acc1, P0[1]); SC_VALU_FAST(acc0, TIDX(j)); SC_VALU_FAST(acc1, TIDX(j + 1));
            SC_LOAD2(P0, TSAFE(j + 6), TSAFE(j + 7));
            SC_MFMA(acc0, P1[0]); SC_MFMA(acc1, P1[1]); SC_VALU_FAST(acc0, TIDX(j + 2)); SC_VALU_FAST(acc1, TIDX(j + 3));
            SC_LOAD2(P1, TSAFE(j + 8), TSAFE(j + 9));
            SC_MFMA(acc0, P2[0]); SC_MFMA(acc1, P2[1]); SC_VALU_FAST(acc0, TIDX(j + 4)); SC_VALU_FAST(acc1, TIDX(j + 5));
        }
        for (; j < nst; j += 6) {
            f32x16 acc0, acc1;
            SC_LOAD2(P2, TSAFE(j + 4), TSAFE(j + 5));
            SC_MFMA(acc0, P0[0]); SC_MFMA(acc1, P0[1]); SC_VALU(acc0, TSAFE(j)); if (j + 1 < nst) SC_VALU(acc1, TIDX(j + 1));
            SC_LOAD2(P0, TSAFE(j + 6), TSAFE(j + 7));
            SC_MFMA(acc0, P1[0]); SC_MFMA(acc1, P1[1]); if (j + 2 < nst) SC_VALU(acc0, TIDX(j + 2)); if (j + 3 < nst) SC_VALU(acc1, TIDX(j + 3));
            SC_LOAD2(P1, TSAFE(j + 8), TSAFE(j + 9));
            SC_MFMA(acc0, P2[0]); SC_MFMA(acc1, P2[1]); if (j + 4 < nst) SC_VALU(acc0, TIDX(j + 4)); if (j + 5 < nst) SC_VALU(acc1, TIDX(j + 5));
        }
#undef TIDX
#undef TSAFE
        HIST = HISTsave; }
#undef SC_LOAD
#undef SC_LOAD2
#undef SC_MFMA
#undef SC_VALU
#undef SC_VALU_FAST
#undef SC_SCORES
#undef SC_EMIT_FULL
#undef SC_KEY2
    }
    __syncthreads();
    const int q = wid, p = p0 + q, nvalid = p + 1, nsel = nvalid < 256 ? nvalid : 256;
    LAS u16* sc = SC + q * SCW; LAS unsigned* hist = HIST + q * 256; LAS u16* idx = IDX + q * 256;
    if (nvalid <= 256) { for (int i = lane; i < nvalid; i += 64) idx[i] = (u16)i; }
    else {
        unsigned b1, ab1; find_bin(hist, 256u, lane, b1, ab1);
        _Pragma("unroll 1") for (int rep8 = 0, n8 = (PROBE == 8 ? launder2() : 1); rep8 < n8; ++rep8) {
        asm volatile("s_waitcnt lgkmcnt(0)" ::: "memory");
        { unsigned z_ = 0u; asm volatile("" : "+v"(z_)); *(LAS v4u*)(hist + 4 * lane) = (v4u){z_, z_, z_, z_}; }
        asm volatile("s_waitcnt lgkmcnt(0)" ::: "memory");
        const int niter = (nkp + 255) >> 8;
        {   v2u cur = 4 * lane < nkp ? *(LAS v2u*)(sc + 4 * lane) : (v2u){0u, 0u};
            for (int it = 0; it < niter; ++it) { const int in = (it + 1) * 256 + 4 * lane; const v2u nxt = in < nkp ? *(LAS v2u*)(sc + in) : (v2u){0u, 0u};
                const unsigned k0 = cur.x & 0xffffu, k1 = cur.x >> 16, k2 = cur.y & 0xffffu, k3 = cur.y >> 16;
                if ((k0 >> 8) == b1) atomicAdd((unsigned*)(hist + (k0 & 255u)), 1u);
                if ((k1 >> 8) == b1) atomicAdd((unsigned*)(hist + (k1 & 255u)), 1u);
                if ((k2 >> 8) == b1) atomicAdd((unsigned*)(hist + (k2 & 255u)), 1u);
                if ((k3 >> 8) == b1) atomicAdd((unsigned*)(hist + (k3 & 255u)), 1u);
                cur = nxt; } }
        asm volatile("s_waitcnt lgkmcnt(0)" ::: "memory");
        unsigned b2, ab2; find_bin(hist, 256u - ab1, lane, b2, ab2);
        const unsigned T16 = (b1 << 8) | b2; const unsigned need_eq = 256u - ab1 - ab2;
        unsigned eq_base = 0u;
        LAS unsigned* bmp = (LAS unsigned*)sc;
        unsigned c0 = lane < nkp ? sc[lane] : 0u, c1 = 64 + lane < nkp ? sc[64 + lane] : 0u, c2 = 128 + lane < nkp ? sc[128 + lane] : 0u, c3 = 192 + lane < nkp ? sc[192 + lane] : 0u;
        for (int it = 0; it < niter; ++it) { const int nb = (it + 1) * 256 + lane;
            const unsigned n0 = nb < nkp ? sc[nb] : 0u, n1 = nb + 64 < nkp ? sc[nb + 64] : 0u, n2 = nb + 128 < nkp ? sc[nb + 128] : 0u, n3 = nb + 192 < nkp ? sc[nb + 192] : 0u;
            const unsigned k[4] = {c0, c1, c2, c3};
            unsigned long long mt[4];
#pragma unroll
            for (int j = 0; j < 4; ++j) mt[j] = __ballot(k[j] > T16);
            if (__ballot(k[0] == T16 || k[1] == T16 || k[2] == T16 || k[3] == T16)) {
#pragma unroll
                for (int j = 0; j < 4; ++j) { const bool eq = k[j] == T16; const unsigned long long me = __ballot(eq);
                    mt[j] |= __ballot(eq && (eq_base + mbcnt64(me)) < need_eq); eq_base += (unsigned)__popcll(me); }
            }
            if (lane == 0) { *(LAS v4u*)(bmp + it * 8) = (v4u){(unsigned)mt[0], (unsigned)(mt[0] >> 32), (unsigned)mt[1], (unsigned)(mt[1] >> 32)};
                             *(LAS v4u*)(bmp + it * 8 + 4) = (v4u){(unsigned)mt[2], (unsigned)(mt[2] >> 32), (unsigned)mt[3], (unsigned)(mt[3] >> 32)}; }
            c0 = n0; c1 = n1; c2 = n2; c3 = n3; }
        asm volatile("s_waitcnt lgkmcnt(0)" ::: "memory");
        {
            const int ndw = niter * 8;
            v4u d4 = (v4u){0u, 0u, 0u, 0u};
            if (4 * lane < ndw) d4 = *(const LAS v4u*)(bmp + 4 * lane);
            const unsigned cnt = (unsigned)(__builtin_popcount(d4.x) + __builtin_popcount(d4.y) + __builtin_popcount(d4.z) + __builtin_popcount(d4.w));
            const unsigned inc = wave_scan_incl(cnt);
            unsigned pos = inc - cnt; const unsigned tot = lane_bcast(inc, 63);
            const unsigned dt = ndw > 256 ? bmp[256] : 0u;
#pragma unroll
            for (int w = 0; w < 4; ++w) { unsigned d = d4[w]; while (d) { const unsigned bit = (unsigned)__builtin_ctz(d); if (pos < 256u) idx[pos] = (u16)((4 * lane + w) * 32 + bit); ++pos; d &= d - 1u; } }
            if (lane == 0) { unsigned d = dt, ps = tot; while (d) { const unsigned bit = (unsigned)__builtin_ctz(d); if (ps < 256u) idx[ps] = (u16)(8192u + bit); ++ps; d &= d - 1u; } }
        }
        }
    }
    asm volatile("s_waitcnt lgkmcnt(0)" ::: "memory");
    if (p < NMETA && b != 0) return;
    const int row = row_of(b, p);
    if (nsel < 256) { for (int i = nsel + lane; i < 256; i += 64) idx[i] = (u16)0; asm volatile("s_waitcnt lgkmcnt(0)" ::: "memory"); }
    _Pragma("unroll 1") for (int rep9 = 0, n9 = (PROBE == 9 ? launder2() : 1); rep9 < n9; ++rep9)
    {
        const int g = lane >> 4, c = lane & 15;
        const bf16x8 zero8 = (bf16x8){0, 0, 0, 0, 0, 0, 0, 0};
        bf16x8 qB[2];
#pragma unroll
        for (int ks = 0; ks < 2; ++ks) qB[ks] = c < 8 ? *(const bf16x8*)(Z + (size_t)row * ZC + C_Q + c * 64 + 32 * ks + 8 * g) : zero8;
        const unsigned char* kbase = (const unsigned char*)(C.KATT() + (size_t)b * TPAD * 64);
        f32x4 S[16];
        {
            bf16x8 Kf0[8][2], Kf1[8][2];
#pragma unroll
            for (int t4 = 0; t4 < 8; ++t4) { const int slot = 16 * t4 + c; const int kix = (int)idx[slot];
                const unsigned ko = (unsigned)kix * 128u + 16u * (unsigned)g; Kf0[t4][0] = *(const bf16x8*)(kbase + ko); Kf0[t4][1] = *(const bf16x8*)(kbase + ko + 64u); }
#pragma unroll
            for (int t4 = 0; t4 < 8; ++t4) { const int slot = 16 * (8 + t4) + c; const int kix = (int)idx[slot];
                const unsigned ko = (unsigned)kix * 128u + 16u * (unsigned)g; Kf1[t4][0] = *(const bf16x8*)(kbase + ko); Kf1[t4][1] = *(const bf16x8*)(kbase + ko + 64u); }
#pragma unroll
            for (int t4 = 0; t4 < 8; ++t4) { f32x4 a = mfma16(Kf0[t4][0], qB[0], (f32x4){0.f, 0.f, 0.f, 0.f}); S[t4] = mfma16(Kf0[t4][1], qB[1], a); }
#pragma unroll
            for (int t4 = 0; t4 < 8; ++t4) { f32x4 a = mfma16(Kf1[t4][0], qB[0], (f32x4){0.f, 0.f, 0.f, 0.f}); S[8 + t4] = mfma16(Kf1[t4][1], qB[1], a); }
            asm volatile("" ::: "memory");
        }
        LAS unsigned char* VL = (LAS unsigned char*)sc;
        const unsigned char* vbase = (const unsigned char*)(C.VATT() + (size_t)b * TPAD * 64);
        const unsigned tr_base = (unsigned)(size_t)VL + (unsigned)(((4 * g + ((lane & 15) >> 2)) * 64 + 4 * (lane & 3)) * 2);
        v4u vv0[16], vv1[16];
#define V_GATHER(vv, hf, i0, i1) do { _Pragma("unroll") for (int i = (i0); i < (i1); ++i) { const int e = i * 64 + lane; const int sl = (hf) * 128 + (e >> 3); const int kix = (int)idx[sl]; \
            vv[i] = *(const v4u*)(vbase + ((unsigned)kix * 128u + (unsigned)(e & 7) * 16u)); } } while (0)
        V_GATHER(vv0, 0, 0, 16);
        asm volatile("" ::: "memory");
        if (nsel < 256) {
#pragma unroll
            for (int kt = 0; kt < 16; ++kt)
#pragma unroll
                for (int r = 0; r < 4; ++r) { const int slot = 16 * kt + 4 * g + r; if (slot >= nsel) S[kt][r] = -INFINITY; }
        }
        float mx = -INFINITY;
#pragma unroll
        for (int kt = 0; kt < 16; ++kt)
#pragma unroll
            for (int r = 0; r < 4; ++r) mx = fmaxf(mx, S[kt][r]);
        mx = xor16_max(mx); mx = xor32_max(mx);
        const float sl2 = 0.125f * 1.4426950408889634f, m2 = mx * sl2;
        float sum = 0.f;
#pragma unroll
        for (int kt = 0; kt < 16; ++kt)
#pragma unroll
            for (int r = 0; r < 4; ++r) { const float e = __builtin_amdgcn_exp2f(__builtin_fmaf(S[kt][r], sl2, -m2)); S[kt][r] = e; sum += e; }
        sum = xor16_sum(sum); sum = xor32_sum(sum);
        const float inv = __builtin_amdgcn_rcpf(sum);
        f32x4 O[4];
#pragma unroll
        for (int dt = 0; dt < 4; ++dt) O[dt] = (f32x4){0.f, 0.f, 0.f, 0.f};
        asm volatile("" ::: "memory");
        V_GATHER(vv1, 1, 0, 8);
        asm volatile("" ::: "memory");
#define PV_HALF(vv, hf) do { \
            _Pragma("unroll") for (int i = 0; i < 16; ++i) *(LAS v4u*)(VL + (i * 64 + lane) * 16) = vv[i]; \
            if ((hf) == 0) { asm volatile("" ::: "memory"); V_GATHER(vv1, 1, 8, 16); } \
            asm volatile("s_waitcnt lgkmcnt(0)" ::: "memory"); \
            _Pragma("unroll") for (int kk = 0; kk < 4; ++kk) { \
                const bf16x8 Bp = cat8(pack4(S[(hf) * 8 + 2 * kk]), pack4(S[(hf) * 8 + 2 * kk + 1])); \
                s16x4 lo0, hi0, lo1, hi1, lo2, hi2, lo3, hi3; \
                asm volatile("ds_read_b64_tr_b16 %0, %8 offset:%c9\n\tds_read_b64_tr_b16 %1, %8 offset:%c10\n\tds_read_b64_tr_b16 %2, %8 offset:%c11\n\tds_read_b64_tr_b16 %3, %8 offset:%c12\n\t" \
                             "ds_read_b64_tr_b16 %4, %8 offset:%c13\n\tds_read_b64_tr_b16 %5, %8 offset:%c14\n\tds_read_b64_tr_b16 %6, %8 offset:%c15\n\tds_read_b64_tr_b16 %7, %8 offset:%c16\n\ts_waitcnt lgkmcnt(0)" \
                             : "=&v"(lo0), "=&v"(hi0), "=&v"(lo1), "=&v"(hi1), "=&v"(lo2), "=&v"(hi2), "=&v"(lo3), "=&v"(hi3) \
                             : "v"(tr_base), "i"(kk * 4096), "i"(kk * 4096 + 2048), "i"(kk * 4096 + 32), "i"(kk * 4096 + 32 + 2048), "i"(kk * 4096 + 64), "i"(kk * 4096 + 64 + 2048), "i"(kk * 4096 + 96), "i"(kk * 4096 + 96 + 2048) : "memory"); \
                O[0] = mfma16(cat8(lo0, hi0), Bp, O[0]); O[1] = mfma16(cat8(lo1, hi1), Bp, O[1]); O[2] = mfma16(cat8(lo2, hi2), Bp, O[2]); O[3] = mfma16(cat8(lo3, hi3), Bp, O[3]); } \
            asm volatile("" ::: "memory"); } while (0)
        PV_HALF(vv0, 0);
        PV_HALF(vv1, 1);
#undef V_GATHER
#undef PV_HALF
        if (c < 8) {
#pragma unroll
            for (int dt = 0; dt < 4; ++dt) { const f32x4 o = O[dt] * inv; *(v2u*)(C.U() + (size_t)row * DM + c * 64 + 16 * dt + 4 * g) = (v2u){pk2(o.x, o.y), pk2(o.z, o.w)}; }
        }
    }
}

constexpr int NUNITS = 1026 * NB;
__device__ __forceinline__ void phase_seq(const Ctx& C, int l, int half) {
    unsigned* ctr = C.CTL() + 64 + 64 * l;
    unsigned* done = C.CTL() + 64 * 8 + 64 * (2 * l + half);
    unsigned* flagw = C.CTL() + 64 * (40 + 2 * l + half);
    if (C.bid == 16 || C.bid == 17) {
        const int bhl = (C.bid - 16) * 8 + C.wid;
        { unsigned char* po = prep_unit<false>(C, l, 16 * half + bhl, bhl, 512, C.lds + C.wid * SLOT, nullptr); prep_copy(C.lds + C.wid * SLOT, po, lane_now()); }
        asm volatile("s_waitcnt vmcnt(0)" ::: "memory"); __syncthreads();
        if (C.wid == 0 && lane_now() == 0) { __builtin_amdgcn_fence(__ATOMIC_RELEASE, "agent"); asm volatile("s_waitcnt vmcnt(0)" ::: "memory"); __hip_atomic_fetch_add(flagw, 1u, __ATOMIC_RELAXED, __HIP_MEMORY_SCOPE_AGENT); }
        __syncthreads();
    }
    if (C.bid < 16) { _Pragma("unroll 1") for (int rep4 = 0, n4 = (PROBE == 4 ? launder2() : 1); rep4 < n4; ++rep4) { chain_phase(C, 16 * half + C.bid, C.bid, flagw); __syncthreads(); }
        if (C.wid == 0 && lane_now() == 0) __hip_atomic_fetch_add(done, 1u, __ATOMIC_RELAXED, __HIP_MEMORY_SCOPE_AGENT); }
    LAS unsigned* shu = (LAS unsigned*)(C.lds + LDS_MISC);
    _Pragma("unroll 1") for (int rep5 = 0, n5 = ((PROBE == 5 && half == 1) ? launder2() : 1); rep5 < n5; ++rep5) {
    int bpref = (int)(((unsigned)__builtin_amdgcn_s_getreg((3 << 11) | 20) & 7u) >> 1);
    unsigned* cb = C.CTL() + 64 * (16 + 8 * l + 4 * rep5);
    auto fetch = [&](int& bp) -> unsigned {
        if (half == 0 && __hip_atomic_load(done, __ATOMIC_RELAXED, __HIP_MEMORY_SCOPE_AGENT) >= 16u) return 0xffffffffu;
        for (int t = 0; t < 4; ++t) { const unsigned u = atomicAdd(cb + bp, 1u); if (u < 1026u) return u | ((unsigned)bp << 16); bp = (bp + 1) & 3; }
        return 0xffffffffu; };
    unsigned nxt = 0xffffffffu;
    if (C.wid == 0 && lane_now() == 0) shu[0] = fetch(bpref);
    __syncthreads();
    for (;;) {
        const unsigned u = shu[0];
        __syncthreads();
        if (u == 0xffffffffu) break;
        if (C.wid == 0 && lane_now() == 0) nxt = fetch(bpref);
        const int qt = 1025 - (int)(u & 0xffffu), b = (int)(u >> 16);
        if (!(qt < 2 && b != 0)) attn_unit(C, l, b, qt);
        __syncthreads();
        if (C.wid == 0 && lane_now() == 0) shu[0] = nxt;
        __syncthreads();
    }
    }
}

template <int ACT>
__device__ __forceinline__ void meta_gemm(const Ctx& C, const bf16* A, const bf16* Bt, int K, int N, bf16* O, int ldc) {
    int lane_ = lane_now(); const int lane = lane_, g = lane >> 4, c = lane & 15, wid = C.wid;
    LAS float* red = (LAS float*)C.lds;
    const int kw = K / NWAVES;
    for (int unit = C.bid; unit < N / 16; unit += C.G) {
        const bf16* ap = A + (size_t)(MAINR + c) * K + wid * kw + 8 * g; const bf16* bp = Bt + (size_t)(unit * 16 + c) * K + wid * kw + 8 * g;
        f32x4 acc = (f32x4){0.f, 0.f, 0.f, 0.f};
        for (int k0 = 0; k0 < kw; k0 += 128) {
            bf16x8 af[4], bfr[4];
#pragma unroll
            for (int s = 0; s < 4; ++s) { af[s] = *(const bf16x8*)(ap + k0 + 32 * s); bfr[s] = *(const bf16x8*)(bp + k0 + 32 * s); }
#pragma unroll
            for (int s = 0; s < 4; ++s) acc = mfma16(af[s], bfr[s], acc);
        }
        *(LAS f32x4*)(red + (wid * 64 + lane) * 4) = acc;
        __syncthreads();
        if (wid == 0) {
            f32x4 t = acc;
#pragma unroll
            for (int w = 1; w < NWAVES; ++w) t = t + *(const LAS f32x4*)(red + (w * 64 + lane) * 4);
#pragma unroll
            for (int r = 0; r < 4; ++r) { float v = t[r]; if (ACT == 2) { v = fmaxf(v, 0.f); v = v * v; }
                O[(size_t)(MAINR + 4 * g + r) * ldc + unit * 16 + c] = (bf16)f2bf(v); }
        }
        __syncthreads();
    }
}

template <int ACT, bool OUT8>
__device__ __forceinline__ void meta_gemm8(const Ctx& C, const unsigned char* A, const unsigned char* Bt, int K, int N, void* Ov, int ldc, float omul, float hmul) {
    int lane_ = lane_now(); const int lane = lane_, g = lane >> 4, c = lane & 15, wid = C.wid;
    LAS float* red = (LAS float*)C.lds;
    const int kw = K / NWAVES;
    for (int unit = C.bid; unit < N / 16; unit += C.G) {
        const unsigned char* ap = A + (size_t)(MAINR + c) * K + wid * kw + 8 * g; const unsigned char* bp = Bt + (size_t)(unit * 16 + c) * K + wid * kw + 8 * g;
        f32x4 acc = (f32x4){0.f, 0.f, 0.f, 0.f};
        for (int k0 = 0; k0 < kw; k0 += 128) {
            long af[4], bfr[4];
#pragma unroll
            for (int s = 0; s < 4; ++s) { af[s] = *(const long*)(ap + k0 + 32 * s); bfr[s] = *(const long*)(bp + k0 + 32 * s); }
#pragma unroll
            for (int s = 0; s < 4; ++s) acc = __builtin_amdgcn_mfma_f32_16x16x32_fp8_fp8(af[s], bfr[s], acc, 0, 0, 0);
        }
        *(LAS f32x4*)(red + (wid * 64 + lane) * 4) = acc;
        __syncthreads();
        if (wid == 0) {
            f32x4 t = acc;
#pragma unroll
            for (int w = 1; w < NWAVES; ++w) t = t + *(const LAS f32x4*)(red + (w * 64 + lane) * 4);
#pragma unroll
            for (int r = 0; r < 4; ++r) { float v = t[r] * omul; if (ACT == 2) { v = fmaxf(v, 0.f); v = v * v; }
                if (OUT8) ((unsigned char*)Ov)[(size_t)(MAINR + 4 * g + r) * ldc + unit * 16 + c] = (unsigned char)(pk4_fp8(v * hmul, 0.f, 0.f, 0.f) & 0xffu);
                else ((bf16*)Ov)[(size_t)(MAINR + 4 * g + r) * ldc + unit * 16 + c] = (bf16)f2bf(v); }
        }
        __syncthreads();
    }
}

#define XLAS __attribute__((address_space(3)))
#define XB_TMO      128
#define XB_XCNT(j)  (256  + 64 * (j))
#define XB_XSUB(j)  (1280 + 64 * (j))
#define XB_XGEN(j)  (2304 + 64 * (j))
#define XB_TOP      3328
#define XB_TOPGEN   3392
#define XCD_BAR_WORDS 3456
#define XB_SPIN_CAP (1u << 18)

__device__ __forceinline__ unsigned xb_ld(unsigned* p)              { return __hip_atomic_load(p, __ATOMIC_RELAXED, __HIP_MEMORY_SCOPE_AGENT); }
__device__ __forceinline__ unsigned xb_add(unsigned* p, unsigned v) { return __hip_atomic_fetch_add(p, v, __ATOMIC_RELAXED, __HIP_MEMORY_SCOPE_AGENT); }
__device__ __forceinline__ unsigned xb_xcc_id() { return (unsigned)__builtin_amdgcn_s_getreg((3 << 11) | 20) & 0xFu; }
#define XB_SPIN(cond, bar) do { unsigned _sp = 0; while (cond) { __builtin_amdgcn_s_sleep(1); \
    if ((++_sp & 255u) == 0u) { if (xb_ld(&(bar)[XB_TMO])) break; if (_sp > XB_SPIN_CAP) { atomicAdd(&(bar)[XB_TMO], 1u); break; } } } } while (0)

struct XcdBarrier {
    unsigned* bar; unsigned x;
    int w; bool first;
    volatile XLAS unsigned* st;
};

__device__ __forceinline__ XcdBarrier xcd_barrier_post(unsigned* bar, volatile XLAS unsigned* st, int wid0) {
    XcdBarrier b; b.bar = bar; b.x = xb_xcc_id(); b.st = st; b.w = wid0; b.first = wid0 == 0 && lane_now() == 0;
    if (b.first) (void)xb_add(&bar[XB_XCNT(b.x)], 1u);
    return b;
}
__device__ __forceinline__ void xcd_barrier_complete(unsigned* bar, unsigned x, unsigned& nloc, unsigned& nx) {
    const unsigned G = gridDim.x * gridDim.y * gridDim.z;
    unsigned sum, cnt, mine, sp = 0u;
    for (;;) {
        sum = 0u; cnt = 0u; mine = 0u;
#pragma unroll
        for (unsigned j = 0; j < 16; ++j) { const unsigned c = xb_ld(&bar[XB_XCNT(j)]); sum += c; cnt += (c > 0u) ? 1u : 0u; mine = (j == x) ? c : mine; }
        if (sum == G) break;
        __builtin_amdgcn_s_sleep(1);
        if ((++sp & 255u) == 0u) { if (xb_ld(&bar[XB_TMO])) break; if (sp > XB_SPIN_CAP) { atomicAdd(&bar[XB_TMO], 1u); break; } }
    }
    nloc = mine > 0u ? mine : 1u; nx = cnt > 0u ? cnt : 1u;
}

__device__ __forceinline__ void xcd_barrier(const XcdBarrier& b) {
    asm volatile("s_waitcnt vmcnt(0)" ::: "memory");
    __syncthreads();
    if (b.w == 0 && lane_now() == 0) {
        unsigned* bar = b.bar;
        __builtin_amdgcn_s_waitcnt(0);
        unsigned nloc = b.st[0], nx = b.st[1];
        if (nloc == 0u) { xcd_barrier_complete(bar, b.x, nloc, nx); b.st[0] = nloc; b.st[1] = nx; }
        const unsigned old = xb_add(&bar[XB_XSUB(b.x)], 1u);
        const unsigned gen = old / nloc;
        if (old + 1u == (gen + 1u) * nloc) {
            __builtin_amdgcn_fence(__ATOMIC_RELEASE, "agent");
            asm volatile("s_waitcnt vmcnt(0)" ::: "memory");
            const unsigned og = xb_add(&bar[XB_TOP], 1u);
            const unsigned tg = og / nx;
            if (og + 1u == (tg + 1u) * nx) xb_add(&bar[XB_TOPGEN], 1u);
            else XB_SPIN(xb_ld(&bar[XB_TOPGEN]) == tg, bar);
            __builtin_amdgcn_fence(__ATOMIC_ACQUIRE, "agent");
            xb_add(&bar[XB_XGEN(b.x)], 1u);
            asm volatile("s_waitcnt vmcnt(0)" ::: "memory");
        } else {
            XB_SPIN(xb_ld(&bar[XB_XGEN(b.x)]) == gen, bar);
            __builtin_amdgcn_fence(__ATOMIC_ACQUIRE, "agent");
            asm volatile("s_waitcnt vmcnt(0)" ::: "memory");
        }
    }
    __syncthreads();
}

__global__ void __launch_bounds__(NT, 2) fwd_kernel(Args args) {
    extern __shared__ __attribute__((aligned(16))) unsigned char lds_raw[];
    Ctx C; C.ppass = 0; C.in = args.in; C.out = args.out; C.ws = args.ws; C.lds = (LAS unsigned char*)lds_raw;
    int wid0 = __builtin_amdgcn_readfirstlane(threadIdx.x >> 6); asm volatile("" : "+s"(wid0));
    C.wid = wid0; C.lane = lane_now(); C.tid = wid0 * 64 + C.lane; C.G = gridDim.x; C.bid = blockIdx.x;
    const int lo = args.ph_lo, hi = args.ph_hi;
    int ph = 0;
    volatile XLAS unsigned* bst = (volatile XLAS unsigned*)(C.lds + LDS_BYTES - 64);
    if (C.tid < 2) bst[C.tid] = 0u;
    __syncthreads();
    const XcdBarrier bar = xcd_barrier_post(C.CTL() + 4096, bst, wid0);
#define REPLOOP _Pragma("unroll 1") for (int rep = 0, nrep_ = launder2(); rep < nrep_; ++rep)
#define NOREP for (int rep = 0; rep < 1; ++rep)
#if PROBE == 1 || PROBE == 11 || PROBE == 12
#define REP1 REPLOOP
#else
#define REP1 NOREP
#endif
#if PROBE == 2
#define REP2 REPLOOP
#else
#define REP2 NOREP
#endif
#if PROBE == 3
#define REP3 REPLOOP
#else
#define REP3 NOREP
#endif
#ifndef PHSEL
#define PHSEL 0xffff
#endif
#define PHASE_BEGIN if (ph >= lo && ph < hi) { { const int l_ = lane_now(); C.lane = l_; C.wid = wid0; C.tid = wid0 * 64 + l_; }
#define PHASE_END(last) if (ph + 1 < hi && !(last)) xcd_barrier(bar); } ++ph;

    PHASE_BEGIN if (PHSEL & (1 << 0)) { phase_prologue(C); phase_norm<false, false>(C, C.I(I_X), nullptr, nullptr, nullptr, C.I(I_NMPRE), C.I(I_META)); } PHASE_END(false)
    for (int l = 0; l < NL; ++l) {
        PHASE_BEGIN if (PHSEL & (1 << 2)) { REP3 { pg8::Gemm g{C.U(), (const bf16*)(C.ws + WS_WIN) + (size_t)l * ZC * 1024, MAINR, ZC, 1024}; pg8::StaticOrder S; S.init(MAINR, ZC, C.G, C.bid);
            pg8::EpiBf16<0> E{C.Z(), ZC}; pg8::gemm_phase<pg8::EpiBf16<0>, pg8::StaticOrder, true, true>(C.lds, g, S, E, C.tid); __syncthreads(); } meta_gemm<0>(C, C.U(), (const bf16*)(C.ws + WS_WIN) + (size_t)l * ZC * 1024, 1024, ZC, C.Z(), ZC); } PHASE_END(false)
        PHASE_BEGIN if (PHSEL & (1 << 3)) { REP2 phase_post(C, l, rep == 0); } PHASE_END(false)
        PHASE_BEGIN if (PHSEL & (1 << 4)) { REP1 { C.ppass = rep; phase_prep(C, l, 0); C.ppass = 0; } } PHASE_END(false)
        PHASE_BEGIN if (PHSEL & (1 << 10)) phase_seq(C, l, 0); PHASE_END(false)
        PHASE_BEGIN if (PHSEL & (1 << 4)) { REP1 { C.ppass = rep; phase_prep(C, l, 1); C.ppass = 0; } } PHASE_END(false)
        PHASE_BEGIN if (PHSEL & (1 << 10)) phase_seq(C, l, 1); PHASE_END(false)
        PHASE_BEGIN if (PHSEL & (1 << 5)) { REP3 { pg8::Gemm g{C.U(), (const bf16*)(C.ws + WS_WO) + (size_t)l * 1024 * 1024, MAINR, DM, 1024}; pg8::StaticOrder S; S.init(MAINR, DM, C.G, C.bid);
            pg8::EpiBf16<0> E{C.Z(), DM}; pg8::gemm_phase<pg8::EpiBf16<0>, pg8::StaticOrder, true, true>(C.lds, g, S, E, C.tid); __syncthreads(); } meta_gemm<0>(C, C.U(), (const bf16*)(C.ws + WS_WO) + (size_t)l * 1024 * 1024, 1024, DM, C.Z(), DM); } PHASE_END(false)
        PHASE_BEGIN if (PHSEL & (1 << 6)) { void* hmid = (l + 1 == NL) ? (void*)(C.ws + WS_HMID) : (void*)C.out;
            if (l == 0) phase_norm<false, true>(C, C.I(I_X), hmid, C.Z(), C.I(I_NMPOST) + l * DM, C.I(I_NFPRE) + l * DM, nullptr, true);
            else phase_norm<true, true>(C, C.out, hmid, C.Z(), C.I(I_NMPOST) + l * DM, C.I(I_NFPRE) + l * DM, nullptr, true); } PHASE_END(false)
        PHASE_BEGIN if (PHSEL & (1 << 7)) { REP3 { pg8::Gemm g{(const bf16*)C.U(), (const bf16*)(C.ws + WS_WUP + (size_t)l * FF * 1024), MAINR, FF, 512}; pg8::StaticOrder S; S.init(MAINR, FF, C.G, C.bid);
            pg8::EpiFp8<2> E{C.ws + WS_HID, FF, S8_H}; pg8::gemm_phase<pg8::EpiFp8<2>, pg8::StaticOrder, true, true, true, E8_WU, E8_X>(C.lds, g, S, E, C.tid); __syncthreads(); }
            meta_gemm8<2, true>(C, (const unsigned char*)C.U(), C.ws + WS_WUP + (size_t)l * FF * 1024, 1024, FF, C.ws + WS_HID, FF, 1.f / (S8_X * S8_WU), S8_H); } PHASE_END(false)
        PHASE_BEGIN if (PHSEL & (1 << 8)) { REP3 { pg8::Gemm g{(const bf16*)(C.ws + WS_HID), (const bf16*)(C.ws + WS_WDN + (size_t)l * DM * FF), MAINR, DM, FF / 2}; pg8::StaticOrder S; S.init(MAINR, DM, C.G, C.bid);
            pg8::EpiBf16<0> E{(bf16*)(C.ws + WS_TMP2), DM}; pg8::gemm_phase<pg8::EpiBf16<0>, pg8::StaticOrder, true, true, true, E8_WD, E8_H>(C.lds, g, S, E, C.tid); __syncthreads(); }
            meta_gemm8<0, false>(C, C.ws + WS_HID, C.ws + WS_WDN + (size_t)l * DM * FF, FF, DM, C.ws + WS_TMP2, DM, 1.f / (S8_H * S8_WD), 1.f); } PHASE_END(false)
        PHASE_BEGIN if (PHSEL & (1 << 9)) { if (l + 1 < NL) phase_norm<true, true>(C, C.out, C.out, (const bf16*)(C.ws + WS_TMP2), C.I(I_NFPOST) + l * DM, C.I(I_NMPRE) + (l + 1) * DM);
            else phase_norm<true, false>(C, C.ws + WS_HMID, C.out, (const bf16*)(C.ws + WS_TMP2), C.I(I_NFPOST) + l * DM, nullptr); } PHASE_END(l + 1 == NL)
    }
}

extern "C" void kernel_launch(void* const* d_in, const int* in_sizes, int n_in, void* d_out, int out_size, void* d_ws, size_t ws_size, hipStream_t stream) {
    static int grid = 0;
    if (grid == 0) {
        if (n_in != 30 || out_size != NB * SEQ * DM || ws_size < WS_END) { fprintf(stderr, "kernel_launch: unexpected shapes (n_in %d out %d ws %zu need %zu)\n", n_in, out_size, ws_size, (size_t)WS_END); grid = -1; return; }
        int dev = 0, cus = 0, per_cu = 0;
        (void)hipGetDevice(&dev); (void)hipDeviceGetAttribute(&cus, hipDeviceAttributeMultiprocessorCount, dev);
        (void)hipFuncSetAttribute((const void*)fwd_kernel, hipFuncAttributeMaxDynamicSharedMemorySize, LDS_BYTES);
        (void)hipOccupancyMaxActiveBlocksPerMultiprocessor(&per_cu, (const void*)fwd_kernel, NT, LDS_BYTES);
        (void)hipGetLastError();
        grid = cus;
        fprintf(stderr, "kernel_launch: cus %d per_cu %d ws %zu\n", cus, per_cu, ws_size);
    }
    if (grid < 0) return;
    (void)hipMemsetAsync((char*)d_ws + WS_CTL, 0, CTL_BYTES, stream);
    Args a{};
    for (int i = 0; i < 30; ++i) a.in[i] = (const float*)d_in[i];
    a.out = (float*)d_out; a.ws = (unsigned char*)d_ws;
    a.ph_lo = 0; a.ph_hi = 1000;
    void* kargs[] = {&a};
    hipError_t e = hipLaunchCooperativeKernel((const void*)fwd_kernel, dim3(grid), dim3(NT), kargs, LDS_BYTES, stream);
    if (e != hipSuccess) fprintf(stderr, "kernel_launch: cooperative launch failed: %s\n", hipGetErrorString(e));
}
```

```cpp
#include <hip/hip_runtime.h>
#include <hip/hip_cooperative_groups.h>
#include <cstdio>
#include <cstdint>
namespace cg = cooperative_groups;
namespace pg8 {
#define PG8_LAS __attribute__((address_space(3)))
typedef unsigned short bf16_t;
typedef short bf16x8 __attribute__((ext_vector_type(8)));
typedef float f32x4 __attribute__((ext_vector_type(4)));
typedef unsigned u32x4 __attribute__((ext_vector_type(4)));
typedef int i32x8 __attribute__((ext_vector_type(8)));
typedef int i32x4 __attribute__((ext_vector_type(4)));
constexpr int BM = 256, BK = 64, HALF = 128, HTB = HALF * BK * 2  , STAGE_BYTES = 8 * HTB, NXCD = 8, WGM = 8;

__host__ __device__ __forceinline__ int lds_byte(int r, int c) { const int st = (r >> 4) * 2 + (c >> 5), rr = r & 15, cc = c & 31, ob = rr * 64 + cc * 2; return st * 1024 + (ob ^ (((ob >> 9) & 1) << 5)); }
__host__ __device__ __forceinline__ void stage_rc(int b, int& R, int& C) { const int st = b / 1024, sb = b % 1024, swz = sb ^ (((sb >> 9) & 1) << 5); R = (st >> 1) * 16 + swz / 64; C = (st & 1) * 32 + (swz % 64) / 2; }
__host__ __device__ __forceinline__ int perm32(int rho) { const int n = rho >> 4, i = rho & 15; return 8 * (i >> 2) + 4 * n + (i & 3); }

struct Unit { int pm, pn; };
struct Gemm { const bf16_t* A; const bf16_t* Bt; int M, N, K; };

struct StaticOrder {
    int nM, nN, nwg, G, c;
    __host__ __device__ void init(int M, int N, int G_, int c_) { nM = M / BM; nN = N / BM; nwg = nM * nN; G = G_; c = c_; }
    __host__ __device__ bool next(int i, Unit& u) const {
        const long L = (long)i * G + c; if (L >= nwg) return false;
        int wgid = (int)L; { const int q = nwg / NXCD, r = nwg % NXCD, xcd = wgid % NXCD, off = wgid / NXCD; wgid = (xcd < r ? xcd * (q + 1) : r * (q + 1) + (xcd - r) * q) + off; }
        const int nig = WGM * nN, gid = wgid / nig, fm = gid * WGM, gsz = (nM - fm) < WGM ? (nM - fm) : WGM;
        u.pm = fm + ((wgid % nig) % gsz); u.pn = (wgid % nig) / gsz; return true;
    }
    __device__ __forceinline__ void a_ready(const Unit&) const {}
    __device__ __forceinline__ void done(const Unit&) const {}
};

__device__ __forceinline__ unsigned cvt_pk_bf16(float lo, float hi) { unsigned r; asm volatile("v_cvt_pk_bf16_f32 %0, %1, %2" : "=v"(r) : "v"(lo), "v"(hi)); return r; }
typedef float f32x2 __attribute__((ext_vector_type(2)));
template <int ACT> struct EpiBf16 {
    static constexpr bool PERM = true, AFTER_DRAIN = false;
    bf16_t* O; int ldc;
    __device__ __forceinline__ void operator()(const f32x4 (&acc)[2][2][4][2], const Unit& u, int wr, int wc, int fr, int fq) const {
        const int row0 = u.pm * BM + wr * 64 + fr; const int col0 = u.pn * BM + wc * 32 + 8 * fq;
#pragma unroll
        for (int ai = 0; ai < 2; ++ai)
#pragma unroll
            for (int m = 0; m < 4; ++m) { bf16_t* rowp = O + (size_t)(row0 + ai * HALF + m * 16) * ldc + col0;
#pragma unroll
                for (int bj = 0; bj < 2; ++bj) { f32x4 v0 = acc[ai][bj][m][0], v1 = acc[ai][bj][m][1];
                    if (ACT == 2) {
#pragma unroll
                        for (int e = 0; e < 4; ++e) { float a = fmaxf(v0[e], 0.f), b = fmaxf(v1[e], 0.f); v0[e] = a * a; v1[e] = b * b; } }
                    u32x4 w; w.x = cvt_pk_bf16(v0[0], v0[1]); w.y = cvt_pk_bf16(v0[2], v0[3]); w.z = cvt_pk_bf16(v1[0], v1[1]); w.w = cvt_pk_bf16(v1[2], v1[3]);
                    *(u32x4*)(rowp + bj * HALF) = w; } }
    }
};
typedef unsigned u32x2 __attribute__((ext_vector_type(2)));
template <int ACT> struct EpiFp8 {
    static constexpr bool PERM = true, AFTER_DRAIN = false;
    unsigned char* O; int ldc; float mul;
    __device__ __forceinline__ void operator()(const f32x4 (&acc)[2][2][4][2], const Unit& u, int wr, int wc, int fr, int fq) const {
        const int row0 = u.pm * BM + wr * 64 + fr; const int col0 = u.pn * BM + wc * 32 + 8 * fq;
#pragma unroll
        for (int ai = 0; ai < 2; ++ai)
#pragma unroll
            for (int m = 0; m < 4; ++m) { unsigned char* rowp = O + (size_t)(row0 + ai * HALF + m * 16) * ldc + col0;
#pragma unroll
                for (int bj = 0; bj < 2; ++bj) { f32x4 v0 = acc[ai][bj][m][0], v1 = acc[ai][bj][m][1];
#pragma unroll
                    for (int e = 0; e < 4; ++e) {
                        if (ACT == 2) { float a = fmaxf(v0[e], 0.f), b = fmaxf(v1[e], 0.f); v0[e] = fminf(a * a * mul, 448.f); v1[e] = fminf(b * b * mul, 448.f); }
                        else { v0[e] = __builtin_amdgcn_fmed3f(v0[e] * mul, -448.f, 448.f); v1[e] = __builtin_amdgcn_fmed3f(v1[e] * mul, -448.f, 448.f); } }
                    int lo = __builtin_amdgcn_cvt_pk_fp8_f32(v0[0], v0[1], 0, false); lo = __builtin_amdgcn_cvt_pk_fp8_f32(v0[2], v0[3], lo, true);
                    int hi = __builtin_amdgcn_cvt_pk_fp8_f32(v1[0], v1[1], 0, false); hi = __builtin_amdgcn_cvt_pk_fp8_f32(v1[2], v1[3], hi, true);
                    *(u32x2*)(rowp + bj * HALF) = (u32x2){(unsigned)lo, (unsigned)hi}; } }
    }
};
template <class Epi, class Sched, bool ALIGN_EPI = false, bool SP2 = false, bool FP8 = false, int SCW = 0x7f7f7f7f, int SCA = 0x7f7f7f7f>
__device__ __forceinline__ void gemm_phase(PG8_LAS unsigned char* lds, const Gemm g, const Sched& S, const Epi& E, const int tid_in) {
    int tid_l_ = tid_in; asm volatile("" : "+v"(tid_l_));
    const int tid = tid_l_, wid = __builtin_amdgcn_readfirstlane(tid >> 6), lane = tid & 63, wr = wid >> 2, wc = wid & 3, fr = lane & 15, fq = lane >> 4;
    const int K = g.K, nt = K / BK;
    unsigned voffA[2], voffB[2];
#pragma unroll
    for (int i = 0; i < 2; ++i) { int R, C; stage_rc(tid * 16 + i * 8192, R, C); const int Rb = Epi::PERM ? ((R & ~31) + perm32(R & 31)) : R;
        voffA[i] = (unsigned)(R * K + C) * 2u; voffB[i] = (unsigned)(Rb * K + C) * 2u; }
    const size_t kstep = (size_t)(BK * 2);
    const size_t hstep = (size_t)HALF * K * 2;
    const size_t tstep = 2 * hstep;
    const unsigned ldsw = (unsigned)wid * 1024u;
    const int aoff = lds_byte(wr * 64 + fr, fq * 8), boff = lds_byte(wc * 32 + fr, fq * 8);
#define PG8_SA(b, h) (((b) * 2 + (h)) * HTB)
#define PG8_SB(b, h) ((4 + (b) * 2 + (h)) * HTB)
#define PG8_STAGE(bufoff, gbase, voff) do { _Pragma("unroll") for (int _i = 0; _i < 2; ++_i) \
        __builtin_amdgcn_global_load_lds((const unsigned*)((const char*)(gbase) + (voff)[_i]), (PG8_LAS unsigned*)(lds + (bufoff) + ldsw + _i * 8192), 16, 0, 0); } while (0)
#define PG8_LD8(off) __builtin_shufflevector(*(const PG8_LAS i32x4*)(lds + (off)), *(const PG8_LAS i32x4*)(lds + (off) + 1024), 0, 1, 2, 3, 4, 5, 6, 7)
#define PG8_LDA(dst, b, h) do { if constexpr (FP8) { _Pragma("unroll") for (int m = 0; m < 4; ++m) dst##8[m] = PG8_LD8(PG8_SA(b, h) + aoff + m * 2048); } else { \
        _Pragma("unroll") for (int m = 0; m < 4; ++m) _Pragma("unroll") for (int k = 0; k < 2; ++k) dst[m][k] = *(const PG8_LAS bf16x8*)(lds + PG8_SA(b, h) + aoff + m * 2048 + k * 1024); } } while (0)
#define PG8_LDB(dst, b, h) do { if constexpr (FP8) { _Pragma("unroll") for (int n = 0; n < 2; ++n) dst##8[n] = PG8_LD8(PG8_SB(b, h) + boff + n * 2048); } else { \
        _Pragma("unroll") for (int n = 0; n < 2; ++n) _Pragma("unroll") for (int k = 0; k < 2; ++k) dst[n][k] = *(const PG8_LAS bf16x8*)(lds + PG8_SB(b, h) + boff + n * 2048 + k * 1024); } } while (0)
#define PG8_MMA(ai, bj, At, Bt) do { __builtin_amdgcn_s_setprio(1); if constexpr (FP8) { _Pragma("unroll") for (int m = 0; m < 4; ++m) _Pragma("unroll") for (int n = 0; n < 2; ++n) \
        asm volatile("v_mfma_scale_f32_16x16x128_f8f6f4 %0, %1, %2, %0, %3, %4 op_sel_hi:[0,0,0]" : "+v"(acc[ai][bj][m][n]) : "v"(Bt##8[n]), "v"(At##8[m]), "v"(scw_), "v"(sca_)); } else { \
        _Pragma("unroll") for (int m = 0; m < 4; ++m) _Pragma("unroll") for (int n = 0; n < 2; ++n) _Pragma("unroll") for (int k = 0; k < 2; ++k) \
        acc[ai][bj][m][n] = __builtin_amdgcn_mfma_f32_16x16x32_bf16(Bt[n][k], At[m][k], acc[ai][bj][m][n], 0, 0, 0); } __builtin_amdgcn_s_setprio(0); } while (0)
#define PG8_WAIT_V(n) asm volatile("s_waitcnt vmcnt(" #n ")" ::: "memory")
#define PG8_WAIT_L(n) asm volatile("s_waitcnt lgkmcnt(" #n ")" ::: "memory")
#define PG8_BAR __builtin_amdgcn_s_barrier()
#define PG8_SCHED __builtin_amdgcn_sched_barrier(0)
    Unit cur, nxt; int ui = 0;
    if (!S.next(0, cur)) return;
    f32x4 acc[2][2][4][2];
#pragma unroll
    for (int a = 0; a < 2; ++a)
#pragma unroll
        for (int b = 0; b < 2; ++b)
#pragma unroll
            for (int m = 0; m < 4; ++m)
#pragma unroll
                for (int n = 0; n < 2; ++n) acc[a][b][m][n] = (f32x4){0.f, 0.f, 0.f, 0.f};
    int scw_ = SCW, sca_ = SCA; asm volatile("" : "+v"(scw_), "+v"(sca_));
    bf16x8 At[4][2], B0[2][2], B1[2][2]; i32x8 At8[4], B08[2], B18[2];
    const char* cA = (const char*)g.A + (size_t)cur.pm * tstep; const char* cB = (const char*)g.Bt + (size_t)cur.pn * tstep;
    S.a_ready(cur);
    if constexpr (SP2) {
        PG8_STAGE(PG8_SB(0, 0), cB, voffB); PG8_STAGE(PG8_SB(0, 1), cB + hstep, voffB); PG8_STAGE(PG8_SA(0, 0), cA, voffA); PG8_STAGE(PG8_SA(0, 1), cA + hstep, voffA);
        if (wr == 1) PG8_BAR;
        PG8_WAIT_V(2); PG8_BAR;
        PG8_STAGE(PG8_SB(1, 0), cB + kstep, voffB); PG8_STAGE(PG8_SA(1, 0), cA + kstep, voffA); PG8_STAGE(PG8_SB(1, 1), cB + hstep + kstep, voffB);
        PG8_WAIT_V(6); PG8_BAR;
    } else {
        PG8_STAGE(PG8_SB(0, 0), cB, voffB); PG8_STAGE(PG8_SA(0, 0), cA, voffA); PG8_STAGE(PG8_SB(0, 1), cB + hstep, voffB); PG8_STAGE(PG8_SA(0, 1), cA + hstep, voffA);
        if (wr == 1) PG8_BAR;
        PG8_WAIT_V(4); PG8_BAR;
        PG8_STAGE(PG8_SB(1, 0), cB + kstep, voffB); PG8_STAGE(PG8_SA(1, 0), cA + kstep, voffA); PG8_STAGE(PG8_SB(1, 1), cB + hstep + kstep, voffB);
        PG8_WAIT_V(6); PG8_BAR;
    }
    for (;;) {
        const bool has_next = S.next(ui + 1, nxt);
        const char* nA = has_next ? (const char*)g.A + (size_t)nxt.pm * tstep : cA; const char* nB = has_next ? (const char*)g.Bt + (size_t)nxt.pn * tstep : cB;
        for (int t = 0; t < nt; t += 2) {
            const bool last = (t == nt - 2);
            const char* a1 = cA + (size_t)(t + 1) * kstep;
            const char* a2 = last ? nA : cA + (size_t)(t + 2) * kstep; const char* b2 = last ? nB : cB + (size_t)(t + 2) * kstep;
            const char* a3 = a2 + kstep; const char* b3 = b2 + kstep;
            if (last && has_next) S.a_ready(nxt);
            if constexpr (SP2) {
            PG8_LDB(B0, 0, 0); PG8_LDB(B1, 0, 1); PG8_SCHED; PG8_LDA(At, 0, 0); PG8_STAGE(PG8_SA(1, 1), a1 + hstep, voffA);
            PG8_WAIT_V(8); PG8_WAIT_L(0); PG8_BAR; PG8_MMA(0, 0, At, B0); PG8_MMA(0, 1, At, B1); PG8_BAR; PG8_SCHED;
            PG8_LDA(At, 0, 1); PG8_STAGE(PG8_SB(0, 0), b2, voffB); PG8_STAGE(PG8_SB(0, 1), b2 + hstep, voffB); PG8_STAGE(PG8_SA(0, 0), a2, voffA);
            PG8_WAIT_V(8); PG8_WAIT_L(0); PG8_BAR; PG8_MMA(1, 0, At, B0); PG8_MMA(1, 1, At, B1); PG8_BAR; PG8_SCHED;
            PG8_LDB(B0, 1, 0); PG8_LDB(B1, 1, 1); PG8_SCHED; PG8_LDA(At, 1, 0); PG8_STAGE(PG8_SA(0, 1), a2 + hstep, voffA);
            PG8_WAIT_V(8); PG8_WAIT_L(0); PG8_BAR; PG8_MMA(0, 0, At, B0); PG8_MMA(0, 1, At, B1); PG8_BAR; PG8_SCHED;
            PG8_LDA(At, 1, 1); PG8_STAGE(PG8_SB(1, 0), b3, voffB); PG8_STAGE(PG8_SB(1, 1), b3 + hstep, voffB); PG8_STAGE(PG8_SA(1, 0), a3, voffA);
            PG8_WAIT_V(8); PG8_WAIT_L(0); PG8_BAR; PG8_MMA(1, 0, At, B0); PG8_MMA(1, 1, At, B1); PG8_BAR; PG8_SCHED;
            } else {
            PG8_LDB(B0, 0, 0); PG8_SCHED; PG8_LDA(At, 0, 0); PG8_STAGE(PG8_SA(1, 1), a1 + hstep, voffA);
            PG8_WAIT_L(8); PG8_BAR; PG8_WAIT_L(0); PG8_MMA(0, 0, At, B0); PG8_BAR; PG8_SCHED;
            PG8_LDB(B1, 0, 1); PG8_STAGE(PG8_SB(0, 0), b2, voffB);
            PG8_BAR; PG8_WAIT_L(0); PG8_MMA(0, 1, At, B1); PG8_BAR;
            PG8_LDA(At, 0, 1); PG8_STAGE(PG8_SA(0, 0), a2, voffA);
            PG8_BAR; PG8_WAIT_L(0); PG8_MMA(1, 0, At, B0); PG8_BAR; PG8_SCHED;
            PG8_STAGE(PG8_SB(0, 1), b2 + hstep, voffB);
            PG8_WAIT_V(6); PG8_BAR; PG8_MMA(1, 1, At, B1); PG8_BAR;
            PG8_LDB(B0, 1, 0); PG8_SCHED; PG8_LDA(At, 1, 0); PG8_STAGE(PG8_SA(0, 1), a2 + hstep, voffA);
            PG8_WAIT_L(8); PG8_BAR; PG8_WAIT_L(0); PG8_MMA(0, 0, At, B0); PG8_BAR; PG8_SCHED;
            PG8_LDB(B1, 1, 1); PG8_STAGE(PG8_SB(1, 0), b3, voffB);
            PG8_BAR; PG8_WAIT_L(0); PG8_MMA(0, 1, At, B1); PG8_BAR;
            PG8_LDA(At, 1, 1); PG8_STAGE(PG8_SA(1, 0), a3, voffA);
            PG8_BAR; PG8_WAIT_L(0); PG8_MMA(1, 0, At, B0); PG8_BAR; PG8_SCHED;
            PG8_STAGE(PG8_SB(1, 1), b3 + hstep, voffB);
            PG8_WAIT_V(6); PG8_BAR; PG8_MMA(1, 1, At, B1); PG8_BAR;
            }
        }
        if constexpr (FP8) asm volatile("s_nop 15\n\ts_nop 15" ::: "memory");
        if constexpr (ALIGN_EPI) { if (wr == 0) PG8_BAR; }
        if constexpr (!Epi::AFTER_DRAIN) { E(acc, cur, wr, wc, fr, fq); S.done(cur); }
        if (!has_next) break;
#pragma unroll
        for (int a = 0; a < 2; ++a)
#pragma unroll
            for (int b = 0; b < 2; ++b)
#pragma unroll
                for (int m = 0; m < 4; ++m)
#pragma unroll
                    for (int n = 0; n < 2; ++n) acc[a][b][m][n] = (f32x4){0.f, 0.f, 0.f, 0.f};
        cur = nxt; cA = nA; cB = nB; ++ui;
        if constexpr (ALIGN_EPI) { if (wr == 1) PG8_BAR; }
    }
    PG8_WAIT_V(0);
    if constexpr (!ALIGN_EPI) { if (wr == 0) PG8_BAR; }
    PG8_BAR;
    if constexpr (Epi::AFTER_DRAIN) { E.fused(acc, cur, wr, wc, fr, fq, lds, wid, lane); S.done(cur); }
#undef PG8_SA
#undef PG8_SB
#undef PG8_STAGE
#undef PG8_LDA
#undef PG8_LDB
#undef PG8_MMA
#undef PG8_LD8
#undef PG8_WAIT_V
#undef PG8_WAIT_L
#undef PG8_BAR
#undef PG8_SCHED
}
}

#ifndef PROBE
#define PROBE 0
#endif
#define LAS __attribute__((address_space(3)))
typedef unsigned short bf16;
typedef unsigned short u16;
typedef _Float16 h2v __attribute__((ext_vector_type(2)));
typedef short s2v __attribute__((ext_vector_type(2)));
typedef unsigned v4u __attribute__((ext_vector_type(4)));
typedef unsigned v2u __attribute__((ext_vector_type(2)));
typedef float f32x4 __attribute__((ext_vector_type(4)));
typedef float f32x16 __attribute__((ext_vector_type(16)));
typedef short bf16x8 __attribute__((ext_vector_type(8)));

constexpr int NB = 4, SEQ = 8192, NMETA = 16, TT = 8208, DM = 1024, NL = 2;
constexpr int MAINR = 32768, RREAL = 32784, RPAD = 33024;
constexpr int ZC = 3072, LC = 2048, FF = 4096;
constexpr int C_Q = 0, C_CKV = 512, C_QI = 768, C_KI = 1024, C_WI = 1088, C_R = 1152, C_K = 1664, C_V = 2176, C_XW = 2688, C_XA = 2752, C_XG = 2816, C_XV = 2976;
constexpr int TPAD = 8320;
constexpr float NORM_EPS = 1e-6f, GN_EPS = 64e-5f;
constexpr int NT = 512, NWAVES = 8;
constexpr int LDS_BYTES = 155648;

constexpr size_t MiB = 1u << 20;
constexpr size_t WS_CTL = 0, CTL_BYTES = 65536;
constexpr size_t WS_ROPE = 1 * MiB;
constexpr size_t WS_HX = 2 * MiB;
constexpr size_t WS_WIN = 4 * MiB, WS_WO = 16 * MiB, WS_WUP = 20 * MiB, WS_WDN = 36 * MiB;
constexpr size_t WS_KATT = 52 * MiB, WS_VATT = 57 * MiB, WS_KI = 62 * MiB;
constexpr size_t WS_VF = 67 * MiB;
constexpr size_t WS_U = 100 * MiB;
constexpr size_t WS_Z = 165 * MiB;
constexpr size_t WS_L = WS_Z + (size_t)RPAD * ZC * 2;
constexpr size_t WS_HID = WS_Z;
constexpr size_t WS_TMP2 = WS_HID + (size_t)RPAD * FF * 2;
constexpr size_t WS_HMID = WS_HID + (size_t)RPAD * FF;
static_assert(WS_HMID + (size_t)MAINR * DM * 2 <= WS_TMP2 && WS_HMID >= WS_Z + (size_t)RPAD * DM * 2, "ws map");
constexpr size_t WS_ACT = WS_L + (size_t)RPAD * LC * 2;
constexpr int ACTC = 320, OPSB = 16384;
constexpr size_t WS_OPS = WS_L, WS_WLT = 3 * MiB, WS_WKV = 3 * MiB + 768 * 1024;
constexpr size_t WS_END = WS_ACT + (size_t)RPAD * ACTC * 2;
static_assert((size_t)16 * 513 * OPSB <= (size_t)RPAD * LC * 2, "ops fits");
static_assert(WS_END <= 512 * MiB, "ws total");
static_assert(WS_TMP2 + (size_t)RPAD * DM * 2 <= WS_ACT, "ws map");
static_assert(WS_U + (size_t)RPAD * DM * 2 <= WS_Z, "ws map");
static_assert(WS_VF + (size_t)RPAD * 512 * 2 <= WS_U, "ws map");

struct Args { const float* in[30]; float* out; unsigned char* ws; int ph_lo, ph_hi; };

enum { I_X = 0, I_META, I_NMPRE, I_NMPOST, I_NFPRE, I_NFPOST, I_WIN, I_MU, I_KVN, I_WUK, I_WUV, I_IDXG, I_IDXB, I_W0, I_W2, I_A0, I_A2, I_G2,
       I_KK, I_KA, I_RK, I_LNW, I_LNB, I_WINV, I_MUV, I_V0, I_V2, I_WO, I_WUP, I_WDN };

__device__ __forceinline__ float bf2f(bf16 b) { return __uint_as_float((unsigned)b << 16); }
typedef float f32x2h __attribute__((ext_vector_type(2)));
typedef __bf16 bf16x2h __attribute__((ext_vector_type(2)));
__device__ __forceinline__ unsigned pk2(float lo, float hi) { const bf16x2h v = __builtin_convertvector((f32x2h){lo, hi}, bf16x2h); return __builtin_bit_cast(unsigned, v); }
constexpr float S8_X = 16.f, S8_WU = 256.f, S8_H = 4.f, S8_WD = 512.f;
constexpr int E8_X = 0x7b7b7b7b, E8_WU = 0x77777777, E8_H = 0x7d7d7d7d, E8_WD = 0x76767676;
__device__ __forceinline__ float sat8(float x) { return __builtin_amdgcn_fmed3f(x, -448.f, 448.f); }
__device__ __forceinline__ unsigned pk4_fp8(float a, float b, float c, float d) { int p = __builtin_amdgcn_cvt_pk_fp8_f32(sat8(a), sat8(b), 0, false); p = __builtin_amdgcn_cvt_pk_fp8_f32(sat8(c), sat8(d), p, true); return (unsigned)p; }
__device__ __forceinline__ unsigned f2bf(float f) { return (unsigned)__builtin_bit_cast(unsigned short, (__bf16)f); }
template <int CTRL> __device__ __forceinline__ float dpp_f(float v) { return __int_as_float(__builtin_amdgcn_update_dpp(0, __float_as_int(v), CTRL, 0xf, 0xf, true)); }
__device__ __forceinline__ float row16_sum(float v) { v += dpp_f<0xB1>(v); v += dpp_f<0x4E>(v); v += dpp_f<0x141>(v); v += dpp_f<0x140>(v); return v; }
__device__ __forceinline__ float quad_sum(float v) { v += dpp_f<0xB1>(v); v += dpp_f<0x4E>(v); return v; }
template <int CTRL, int RM> __device__ __forceinline__ unsigned dpp_u(unsigned v) { return (unsigned)__builtin_amdgcn_update_dpp(0, (int)v, CTRL, RM, 0xf, false); }
__device__ __forceinline__ unsigned wave_scan_incl(unsigned x) {
    x += dpp_u<0x111, 0xf>(x); x += dpp_u<0x112, 0xf>(x); x += dpp_u<0x114, 0xf>(x); x += dpp_u<0x118, 0xf>(x);
    x += dpp_u<0x142, 0xa>(x); x += dpp_u<0x143, 0xc>(x); return x; }
__device__ __forceinline__ unsigned lane_bcast(unsigned v, int srclane) { return (unsigned)__builtin_amdgcn_readlane((int)v, srclane); }
typedef unsigned u2v __attribute__((ext_vector_type(2)));
__device__ __forceinline__ float xor16_sum(float v) { const u2v r = __builtin_amdgcn_permlane16_swap(__float_as_uint(v), __float_as_uint(v), false, false); return __uint_as_float(r.x) + __uint_as_float(r.y); }
__device__ __forceinline__ float xor32_sum(float v) { const u2v r = __builtin_amdgcn_permlane32_swap(__float_as_uint(v), __float_as_uint(v), false, false); return __uint_as_float(r.x) + __uint_as_float(r.y); }
__device__ __forceinline__ float xor16_max(float v) { const u2v r = __builtin_amdgcn_permlane16_swap(__float_as_uint(v), __float_as_uint(v), false, false); return fmaxf(__uint_as_float(r.x), __uint_as_float(r.y)); }
__device__ __forceinline__ float xor32_max(float v) { const u2v r = __builtin_amdgcn_permlane32_swap(__float_as_uint(v), __float_as_uint(v), false, false); return fmaxf(__uint_as_float(r.x), __uint_as_float(r.y)); }
__device__ __forceinline__ float wave_sum(float v) { v = row16_sum(v); v = xor16_sum(v); v = xor32_sum(v); return v; }
__device__ __forceinline__ float wave_max(float v) {
#pragma unroll
    for (int o = 1; o < 64; o <<= 1) v = fmaxf(v, __shfl_xor(v, o));
    return v;
}
__device__ __forceinline__ int row_of(int b, int p) { return p < NMETA ? MAINR + p : b * SEQ + (p - NMETA); }
__device__ __forceinline__ float relu_i(float x) { const int xi = __float_as_int(x); return __int_as_float(xi > 0 ? xi : 0); }
__device__ __forceinline__ float sigmoidf_(float x) { return __builtin_amdgcn_rcpf(1.f + __expf(-x)); }

__device__ __forceinline__ int lane_now() { int l; asm volatile("v_mbcnt_lo_u32_b32 %0, -1, 0\n\tv_mbcnt_hi_u32_b32 %0, -1, %0" : "=v"(l)); return l; }
__device__ __forceinline__ int launder2() { int n = 2; asm volatile("" : "+s"(n)); return n; }
struct Ctx {
    const float* const* in; float* out; unsigned char* ws;
    LAS unsigned char* lds; int tid, lane, wid, G, bid; int ppass;
    __device__ __forceinline__ const float* I(int i) const { return in[i]; }
    __device__ __forceinline__ bf16* Z() const { return (bf16*)(ws + WS_Z); }
    __device__ __forceinline__ bf16* ACT() const { return (bf16*)(ws + WS_ACT); }
    __device__ __forceinline__ bf16* WLT() const { return (bf16*)(ws + WS_WLT); }
    __device__ __forceinline__ bf16* U() const { return (bf16*)(ws + WS_U); }
    __device__ __forceinline__ bf16* VF() const { return (bf16*)(ws + WS_VF); }
    __device__ __forceinline__ bf16* KATT() const { return (bf16*)(ws + WS_KATT); }
    __device__ __forceinline__ bf16* VATT() const { return (bf16*)(ws + WS_VATT); }
    __device__ __forceinline__ bf16* KI() const { return (bf16*)(ws + WS_KI); }
    __device__ __forceinline__ float* HX() const { return (float*)(ws + WS_HX); }
    __device__ __forceinline__ float* COS() const { return (float*)(ws + WS_ROPE); }
    __device__ __forceinline__ float* SIN() const { return (float*)(ws + WS_ROPE) + TT * 8; }
    __device__ __forceinline__ unsigned* CTL() const { return (unsigned*)(ws + WS_CTL); }
};

template <class Src, bool FRAG = false>
__device__ __forceinline__ void transpose_item(const Src& src, bf16* WT, int K, int k0, int n0, LAS float* scr, int lane) {
#pragma unroll
    for (int i = 0; i < 8; ++i) { const int kk = 8 * i + (lane >> 3), nn = 4 * (lane & 7); const f32x4 v = src.v4(k0 + kk, n0 + nn);
        scr[kk * 33 + nn] = v.x; scr[kk * 33 + nn + 1] = v.y; scr[kk * 33 + nn + 2] = v.z; scr[kk * 33 + nn + 3] = v.w; }
    asm volatile("s_waitcnt lgkmcnt(0)" ::: "memory");
    const int c = lane & 7;
#pragma unroll
    for (int j = 0; j < 4; ++j) { const int n = (lane >> 3) + 8 * j; const LAS float* s = scr + (8 * c) * 33 + n;
        v4u o; o.x = pk2(s[0 * 33], s[1 * 33]); o.y = pk2(s[2 * 33], s[3 * 33]); o.z = pk2(s[4 * 33], s[5 * 33]); o.w = pk2(s[6 * 33], s[7 * 33]);
        if (FRAG) { const int ch = n0 + n, kq = (k0 >> 3) + c; *(v4u*)(WT + (size_t)((((ch >> 6) * 4 + (ch & 3)) * 10 + (kq >> 2)) * 64 + (kq & 3) * 16 + ((ch & 63) >> 2)) * 8) = o; }
        else *(v4u*)(WT + (size_t)(n0 + n) * K + k0 + 8 * c) = o; }
    asm volatile("s_waitcnt lgkmcnt(0)" ::: "memory");
}
template <class Src>
__device__ __forceinline__ void transpose_item8(const Src& src, unsigned char* WT, int K, int k0, int n0, LAS float* scr, int lane, float mul) {
#pragma unroll
    for (int i = 0; i < 8; ++i) { const int kk = 8 * i + (lane >> 3), nn = 4 * (lane & 7); const f32x4 v = src.v4(k0 + kk, n0 + nn);
        scr[kk * 33 + nn] = v.x; scr[kk * 33 + nn + 1] = v.y; scr[kk * 33 + nn + 2] = v.z; scr[kk * 33 + nn + 3] = v.w; }
    asm volatile("s_waitcnt lgkmcnt(0)" ::: "memory");
    const int c = lane & 7;
#pragma unroll
    for (int j = 0; j < 4; ++j) { const int n = (lane >> 3) + 8 * j; const LAS float* s = scr + (8 * c) * 33 + n;
        v2u o; o.x = pk4_fp8(s[0 * 33] * mul, s[1 * 33] * mul, s[2 * 33] * mul, s[3 * 33] * mul); o.y = pk4_fp8(s[4 * 33] * mul, s[5 * 33] * mul, s[6 * 33] * mul, s[7 * 33] * mul);
        *(v2u*)(WT + (size_t)(n0 + n) * K + k0 + 8 * c) = o; }
    asm volatile("s_waitcnt lgkmcnt(0)" ::: "memory");
}
struct SrcKV { const float* wk; const float* wv;
    __device__ __forceinline__ f32x4 v4(int k, int n) const { return n < 64 ? *(const f32x4*)(wk + (size_t)k * 64 + n) : *(const f32x4*)(wv + (size_t)k * 64 + n - 64); } };
struct SrcLora { const float* w2; const float* a2; const float* g2; const float* v2; int has_v;
    __device__ __forceinline__ f32x4 v4(int k, int n) const {
        if (k < 64) return *(const f32x4*)(w2 + (size_t)k * 512 + n);
        if (k < 128) return *(const f32x4*)(a2 + (size_t)(k - 64) * 512 + n);
        if (k < 288) return *(const f32x4*)(g2 + (size_t)(k - 128) * 512 + n);
        return has_v ? *(const f32x4*)(v2 + (size_t)(k - 288) * 512 + n) : (f32x4){0.f, 0.f, 0.f, 0.f}; } };
struct SrcPlain { const float* W; int ldw; __device__ __forceinline__ f32x4 v4(int k, int n) const { return *(const f32x4*)(W + (size_t)k * ldw + n); } };
struct SrcWin { const float* W; const float* Wv; int has_v;
    __device__ __forceinline__ f32x4 v4(int k, int n) const {
        if (n < 1092) return *(const f32x4*)(W + (size_t)k * 2916 + n);
        if (n >= C_R && n < C_XV) return *(const f32x4*)(W + (size_t)k * 2916 + 1092 + (n - C_R));
        if (n >= C_XV && n < C_XV + 32 && has_v) return *(const f32x4*)(Wv + (size_t)k * 32 + (n - C_XV));
        return (f32x4){0.f, 0.f, 0.f, 0.f}; } };

__device__ __forceinline__ void phase_prologue(const Ctx& C) {
    LAS float* scr = (LAS float*)(C.lds + C.wid * 16384);
    const int gw = C.bid * NWAVES + C.wid, NGW = C.G * NWAVES;
    constexpr int IT_WIN = 16 * 96, IT_WO = 16 * 32, IT_WUP = 16 * 128, IT_WDN = 64 * 32, IT_L = IT_WIN + IT_WO + IT_WUP + IT_WDN;
    for (int it = gw; it < 2 * IT_L; it += NGW) {
        const int l = it / IT_L; int r = it % IT_L;
        if (r < IT_WIN) { SrcWin s{C.I(I_WIN) + (size_t)l * 1024 * 2916, C.I(I_WINV), l == 1}; const int kb = r / 96, nb = r % 96;
            transpose_item(s, (bf16*)(C.ws + WS_WIN) + (size_t)l * ZC * 1024, 1024, 64 * kb, 32 * nb, scr, C.lane); continue; } r -= IT_WIN;
        if (r < IT_WO) { SrcPlain s{C.I(I_WO) + (size_t)l * 1024 * 1024, 1024}; const int kb = r / 32, nb = r % 32;
            transpose_item(s, (bf16*)(C.ws + WS_WO) + (size_t)l * 1024 * 1024, 1024, 64 * kb, 32 * nb, scr, C.lane); continue; } r -= IT_WO;
        if (r < IT_WUP) { SrcPlain s{C.I(I_WUP) + (size_t)l * 1024 * 4096, 4096}; const int kb = r / 128, nb = r % 128;
            transpose_item8(s, C.ws + WS_WUP + (size_t)l * 4096 * 1024, 1024, 64 * kb, 32 * nb, scr, C.lane, S8_WU); continue; } r -= IT_WUP;
        { SrcPlain s{C.I(I_WDN) + (size_t)l * 4096 * 1024, 1024}; const int kb = r / 32, nb = r % 32;
            transpose_item8(s, C.ws + WS_WDN + (size_t)l * 1024 * 4096, 4096, 64 * kb, 32 * nb, scr, C.lane, S8_WD); }
    }
    for (int it = gw; it < 2 * 16; it += NGW) { const int l = it / 16, r = it % 16, kb = r / 4, nb = r % 4;
        SrcKV s{C.I(I_WUK) + (size_t)l * 256 * 64, C.I(I_WUV) + (size_t)l * 256 * 64};
        transpose_item(s, (bf16*)(C.ws + WS_WKV) + (size_t)l * 128 * 256, 256, 64 * kb, 32 * nb, scr, C.lane); }
    for (int it = gw; it < 2 * 80; it += NGW) { const int l = it / 80, r = it % 80, kb = r / 16, nb = r % 16;
        SrcLora s{C.I(I_W2) + (size_t)l * 64 * 512, C.I(I_A2) + (size_t)l * 64 * 512, C.I(I_G2) + (size_t)l * 160 * 512, C.I(I_V2), l == 1};
        transpose_item<SrcLora, true>(s, C.WLT() + (size_t)l * 512 * ACTC, ACTC, 64 * kb, 32 * nb, scr, C.lane); }
    const int gt = C.bid * NT + C.tid, NGT = C.G * NT;
    for (int i = gt; i < TT * 8; i += NGT) {
        const int p = i >> 3, f = i & 7;
        const float invf = powf(500000.0f, -(float)(2 * f) / 16.0f);
        const float ang = (float)p * invf;
        const double ad = (double)ang; const double n = rint(ad * 0.15915494309189535); const float rr = (float)(ad - n * 6.283185307179586);
        C.COS()[i] = cosf(rr); C.SIN()[i] = sinf(rr);
    }
    for (int i = gt; i < 256 * DM; i += NGT) C.HX()[i] = (i < NMETA * DM) ? C.I(I_META)[i] : 0.f;
}

template <bool HIN16, bool HOUT16>
__device__ __forceinline__ void phase_norm(const Ctx& C, const void* hin_main, void* hout_main, const bf16* tmp, const float* g_post, const float* g_next, const float* hx_in = nullptr, const bool out8 = false) {
    const int gw = C.bid * NWAVES + C.wid, NGW = C.G * NWAVES; const int lane = C.lane;
    constexpr int NR = 2;
    for (int row0 = gw; row0 < RPAD; row0 += NR * NGW) {
        f32x4 h[NR][4]; v2u tw[NR][4];
#pragma unroll
        for (int u = 0; u < NR; ++u) { const int row = row0 + u * NGW; if (row >= RREAL) continue;
            const bool mainrow = row < MAINR;
            if (HIN16 && mainrow) {
#pragma unroll
                for (int j = 0; j < 4; ++j) { const v2u w = *(const v2u*)((const bf16*)hin_main + (size_t)row * DM + lane * 4 + 256 * j);
                    h[u][j] = (f32x4){__uint_as_float(w.x << 16), __uint_as_float(w.x & 0xffff0000u), __uint_as_float(w.y << 16), __uint_as_float(w.y & 0xffff0000u)}; }
            } else {
                const float* hp = mainrow ? (const float*)hin_main + (size_t)row * DM : (hx_in ? hx_in : (const float*)C.HX()) + (size_t)(row - MAINR) * DM;
#pragma unroll
                for (int j = 0; j < 4; ++j) h[u][j] = *(const f32x4*)(hp + lane * 4 + 256 * j);
            }
            if (tmp) {
#pragma unroll
                for (int j = 0; j < 4; ++j) tw[u][j] = *(const v2u*)(tmp + (size_t)row * DM + lane * 4 + 256 * j); }
        }
#pragma unroll
        for (int u = 0; u < NR; ++u) { const int row = row0 + u * NGW; if (row >= RPAD) continue;
            bf16* urow = C.U() + (size_t)row * DM;
            if (row >= RREAL) { if (g_next && !out8) {
#pragma unroll
                    for (int j = 0; j < 4; ++j) *(v2u*)(urow + lane * 4 + 256 * j) = (v2u){0u, 0u}; }
                continue; }
            const bool mainrow = row < MAINR;
            if (tmp) {
                f32x4 t[4]; float ss = 0.f;
#pragma unroll
                for (int j = 0; j < 4; ++j) { const v2u w = tw[u][j];
                    t[j] = (f32x4){__uint_as_float(w.x << 16), __uint_as_float(w.x & 0xffff0000u), __uint_as_float(w.y << 16), __uint_as_float(w.y & 0xffff0000u)};
                    ss += (t[j].x * t[j].x + t[j].y * t[j].y) + (t[j].z * t[j].z + t[j].w * t[j].w); }
                const float rstd = __builtin_amdgcn_rsqf(wave_sum(ss) * (1.f / DM) + NORM_EPS);
#pragma unroll
                for (int j = 0; j < 4; ++j) { const f32x4 g = *(const f32x4*)(g_post + lane * 4 + 256 * j); h[u][j] = h[u][j] + t[j] * rstd * g;
                    if (HOUT16 && mainrow) *(v2u*)((bf16*)hout_main + (size_t)row * DM + lane * 4 + 256 * j) = (v2u){pk2(h[u][j].x, h[u][j].y), pk2(h[u][j].z, h[u][j].w)};
                    else { float* ho = mainrow ? (float*)hout_main + (size_t)row * DM : C.HX() + (size_t)(row - MAINR) * DM; *(f32x4*)(ho + lane * 4 + 256 * j) = h[u][j]; } }
            }
            if (g_next) {
                float ss = 0.f;
#pragma unroll
                for (int j = 0; j < 4; ++j) ss += (h[u][j].x * h[u][j].x + h[u][j].y * h[u][j].y) + (h[u][j].z * h[u][j].z + h[u][j].w * h[u][j].w);
                const float rstd = __builtin_amdgcn_rsqf(wave_sum(ss) * (1.f / DM) + NORM_EPS);
#pragma unroll
                for (int j = 0; j < 4; ++j) { const f32x4 g = *(const f32x4*)(g_next + lane * 4 + 256 * j); const f32x4 y = h[u][j] * rstd * g;
                    if (out8) *(unsigned*)((unsigned char*)C.U() + (size_t)row * DM + lane * 4 + 256 * j) = pk4_fp8(y.x * S8_X, y.y * S8_X, y.z * S8_X, y.w * S8_X);
                    else *(v2u*)(urow + lane * 4 + 256 * j) = (v2u){pk2(y.x, y.y), pk2(y.z, y.w)}; }
            }
        }
    }
}

typedef short s16x4 __attribute__((ext_vector_type(4)));
constexpr int SLOT = 18432;
constexpr int O_W = 0, O_R = 2048, O_BK = 4096, O_ARK = 8192, O_TA = 9216, O_GAM = 9728, O_VT = 10240, O_TMP = 12288, O_B = 12288, O_K = 14336, O_AT = 16384;
constexpr int OPS_SH = 10240, OPS_VT = 10240, OPS_G = 12288, OPS_BG = 14336;
constexpr int NCHUNK = TT / 16;
__device__ __forceinline__ bf16x8 cat8(s16x4 a, s16x4 b) { return __builtin_shufflevector(a, b, 0, 1, 2, 3, 4, 5, 6, 7); }
__device__ __forceinline__ s16x4 pack4(f32x4 v) { v2u w = (v2u){pk2(v.x, v.y), pk2(v.z, v.w)}; return __builtin_bit_cast(s16x4, w); }
__device__ __forceinline__ s16x4 pack4f(float a, float b, float c, float d) { v2u w = (v2u){pk2(a, b), pk2(c, d)}; return __builtin_bit_cast(s16x4, w); }
__device__ __forceinline__ f32x4 mfma16(bf16x8 a, bf16x8 b, f32x4 c) { return __builtin_amdgcn_mfma_f32_16x16x32_bf16(a, b, c, 0, 0, 0); }
__device__ __forceinline__ void unpack4(v2u w, float (&o)[4]) { o[0] = __uint_as_float(w.x << 16); o[1] = __uint_as_float(w.x & 0xffff0000u); o[2] = __uint_as_float(w.y << 16); o[3] = __uint_as_float(w.y & 0xffff0000u); }


struct PostLd { unsigned short q1, q2, qi1, qi2, ki, a0, a1, a2, a3, a4; v2u ckv; float cs, sn; };
__device__ __forceinline__ void post_load(const Ctx& C, int l, int row, int lane, PostLd& o) {
    const int p = row < MAINR ? NMETA + (row & 8191) : row - MAINR;
    const bf16* z = C.Z() + (size_t)row * ZC;
    const int hh = lane >> 3, i = lane & 7;
    o.cs = C.COS()[p * 8 + i]; o.sn = C.SIN()[p * 8 + i];
    o.q1 = z[C_Q + hh * 64 + i]; o.q2 = z[C_Q + hh * 64 + 8 + i];
    o.qi1 = z[C_QI + (hh & 3) * 64 + i]; o.qi2 = z[C_QI + (hh & 3) * 64 + 8 + i];
    o.ki = z[C_KI + lane];
    o.ckv = *(const v2u*)(z + C_CKV + lane * 4);
    o.a0 = z[C_XW + lane]; o.a1 = z[C_XA + lane]; o.a2 = z[C_XG + lane]; o.a3 = z[C_XG + 64 + lane];
    o.a4 = lane < 32 ? z[C_XG + 128 + lane] : (l == 1 ? z[C_XV + lane - 32] : (unsigned short)0);
}
__device__ __forceinline__ float shiftf(unsigned short a_, unsigned short p_, float mu) { const float a = bf2f(a_), pr = bf2f(p_); return a + (pr - a) * mu; }
__device__ __forceinline__ void post_compute(const Ctx& C, int l, int row, int lane, const PostLd& d, const unsigned short (&pv)[5], const float (&mu)[5], const f32x4 kvg, const float ig, const float ib, LAS unsigned char* cl) {
    int b, p; if (row < MAINR) { b = row >> 13; p = NMETA + (row & 8191); } else { b = -1; p = row - MAINR; }
    bf16* z = C.Z() + (size_t)row * ZC;
    const int hh = lane >> 3, i = lane & 7; const float c = d.cs, s = d.sn;
    { const float t1 = bf2f(d.q1), t2 = bf2f(d.q2);
      z[C_Q + hh * 64 + i] = (bf16)f2bf(t1 * c - t2 * s); z[C_Q + hh * 64 + 8 + i] = (bf16)f2bf(t2 * c + t1 * s); }
    if (lane < 32) { const float t1 = bf2f(d.qi1), t2 = bf2f(d.qi2);
      z[C_QI + hh * 64 + i] = (bf16)f2bf(t1 * c - t2 * s); z[C_QI + hh * 64 + 8 + i] = (bf16)f2bf(t2 * c + t1 * s); }
    {
        const float x = bf2f(d.ki);
        const float mu_ = wave_sum(x) * (1.f / 64.f); const float dd = x - mu_; const float var = wave_sum(dd * dd) * (1.f / 64.f);
        float y = dd * __builtin_amdgcn_rsqf(var + NORM_EPS) * ig + ib;
        const float o = dpp_f<0x128>(y);
        if (lane < 8) y = y * c - o * s; else if (lane < 16) y = y * c + o * s;
        const bf16 yb = (bf16)f2bf(y);
        const size_t ko = ((size_t)((p >> 5) * 4 + (lane >> 4)) * 64 + ((lane >> 3) & 1) * 32 + (p & 31)) * 8 + (lane & 7);
        if (b >= 0) C.KI()[(size_t)b * TPAD * 64 + ko] = yb;
        else {
#pragma unroll
            for (int bb = 0; bb < NB; ++bb) C.KI()[(size_t)bb * TPAD * 64 + ko] = yb; }
    }
    {
        const v2u w = d.ckv;
        f32x4 x = (f32x4){__uint_as_float(w.x << 16), __uint_as_float(w.x & 0xffff0000u), __uint_as_float(w.y << 16), __uint_as_float(w.y & 0xffff0000u)};
        const float ms = wave_sum((x.x * x.x + x.y * x.y) + (x.z * x.z + x.w * x.w)) * (1.f / 256.f);
        const float rstd = __builtin_amdgcn_rsqf(ms + NORM_EPS);
        x = x * rstd * kvg;
        *(LAS v2u*)((LAS unsigned char*)cl + lane * 8) = (v2u){pk2(x.x, x.y), pk2(x.z, x.w)};
    }
    bf16* ar = C.ACT() + (size_t)(row >> 4) * (16 * ACTC) + ((lane >> 3) * 16 + (row & 15)) * 8 + (lane & 7);
    const float x0 = shiftf(d.a0, pv[0], mu[0]); ar[0] = (bf16)f2bf(2.f * sigmoidf_(2.f * x0) - 1.f);
    ar[1024] = (bf16)f2bf(shiftf(d.a1, pv[1], mu[1]));
    ar[2048] = (bf16)f2bf(sigmoidf_(shiftf(d.a2, pv[2], mu[2])));
    ar[3072] = (bf16)f2bf(sigmoidf_(shiftf(d.a3, pv[3], mu[3])));
    float x4;
    if (lane < 32) x4 = sigmoidf_(shiftf(d.a4, pv[4], mu[4])); else x4 = l == 1 ? shiftf(d.a4, pv[4], mu[4]) : 0.f;
    ar[4096] = (bf16)f2bf(x4);
}
constexpr int CLP = 528;
constexpr int PW_ACT = 16 * CLP, PW_KI = PW_ACT + 5120, PW_BYTES = PW_KI + 2048;
__device__ __forceinline__ void post_compute_f(const Ctx& C, int l, int row, int rr, int lane, const PostLd& d, const unsigned short (&pv)[5], const float (&mu)[5], const f32x4 kvg, const float ig, const float ib, LAS unsigned char* W) {
    bf16* z = C.Z() + (size_t)row * ZC;
    const int hh = lane >> 3, i = lane & 7; const float c = d.cs, s = d.sn; const bool odd = lane & 1;
    { const float t1 = bf2f(d.q1), t2 = bf2f(d.q2); const float a1 = t1 * c - t2 * s, a2 = t2 * c + t1 * s;
      const float x1 = dpp_f<0xB1>(a1), x2 = dpp_f<0xB1>(a2);
      *(unsigned*)(z + C_Q + hh * 64 + (odd ? 8 + i - 1 : i)) = odd ? pk2(x2, a2) : pk2(a1, x1); }
    { const float t1 = bf2f(d.qi1), t2 = bf2f(d.qi2); const float a1 = t1 * c - t2 * s, a2 = t2 * c + t1 * s;
      const float x1 = dpp_f<0xB1>(a1), x2 = dpp_f<0xB1>(a2);
      if (lane < 32) *(unsigned*)(z + C_QI + hh * 64 + (odd ? 8 + i - 1 : i)) = odd ? pk2(x2, a2) : pk2(a1, x1); }
    {
        const float x = bf2f(d.ki);
        const float mu_ = wave_sum(x) * (1.f / 64.f); const float dd = x - mu_; const float var = wave_sum(dd * dd) * (1.f / 64.f);
        float y = dd * __builtin_amdgcn_rsqf(var + NORM_EPS) * ig + ib;
        const float o = dpp_f<0x128>(y);
        if (lane < 8) y = y * c - o * s; else if (lane < 16) y = y * c + o * s;
        *(LAS bf16*)(W + PW_KI + (((lane >> 3) * 16 + rr) * 8 + (lane & 7)) * 2) = (bf16)f2bf(y);
    }
    {
        const v2u w = d.ckv;
        f32x4 x = (f32x4){__uint_as_float(w.x << 16), __uint_as_float(w.x & 0xffff0000u), __uint_as_float(w.y << 16), __uint_as_float(w.y & 0xffff0000u)};
        const float ms = wave_sum((x.x * x.x + x.y * x.y) + (x.z * x.z + x.w * x.w)) * (1.f / 256.f);
        const float rstd = __builtin_amdgcn_rsqf(ms + NORM_EPS);
        x = x * rstd * kvg;
        *(LAS v2u*)(W + rr * CLP + lane * 8) = (v2u){pk2(x.x, x.y), pk2(x.z, x.w)};
    }
    LAS bf16* ar = (LAS bf16*)(W + PW_ACT) + ((lane >> 3) * 8 + (rr & 7)) * 8 + (lane & 7);
    const float x0 = shiftf(d.a0, pv[0], mu[0]); ar[0] = (bf16)f2bf(2.f * sigmoidf_(2.f * x0) - 1.f);
    ar[512] = (bf16)f2bf(shiftf(d.a1, pv[1], mu[1]));
    ar[1024] = (bf16)f2bf(sigmoidf_(shiftf(d.a2, pv[2], mu[2])));
    ar[1536] = (bf16)f2bf(sigmoidf_(shiftf(d.a3, pv[3], mu[3])));
    float x4;
    if (lane < 32) x4 = sigmoidf_(shiftf(d.a4, pv[4], mu[4])); else x4 = l == 1 ? shiftf(d.a4, pv[4], mu[4]) : 0.f;
    ar[2048] = (bf16)f2bf(x4);
}
__device__ __forceinline__ void phase_post(const Ctx& C, int l, bool doA) {
    int lane_ = lane_now(); const int lane = lane_, g = lane >> 4, cc = lane & 15;
    const int gw = C.bid * NWAVES + C.wid, NGW = C.G * NWAVES;
    const float* mup = C.I(I_MU) + l * 1824;
    const float mu[5] = {mup[1536 + lane], mup[1600 + lane], mup[1664 + lane], mup[1728 + lane], lane < 32 ? mup[1792 + lane] : (l == 1 ? C.I(I_MUV)[lane - 32] : 0.f)};
    const f32x4 kvg = *(const f32x4*)(C.I(I_KVN) + l * 256 + lane * 4); const float ig = C.I(I_IDXG)[l * 64 + lane], ib = C.I(I_IDXB)[l * 64 + lane];
    const bf16* wkv = (const bf16*)(C.ws + WS_WKV) + (size_t)l * 128 * 256 + (size_t)cc * 256 + 8 * g;
#define POST_PREV(prow_, has_, pv_) do { const bf16* zp_ = C.Z() + (size_t)(prow_) * ZC; \
        pv_[0] = zp_[C_XW + lane]; pv_[1] = zp_[C_XA + lane]; pv_[2] = zp_[C_XG + lane]; pv_[3] = zp_[C_XG + 64 + lane]; pv_[4] = lane < 32 ? zp_[C_XG + 128 + lane] : (l == 1 ? zp_[C_XV + lane - 32] : (unsigned short)0); \
        if (!(has_)) { pv_[0] = 0; pv_[1] = 0; pv_[2] = 0; pv_[3] = 0; pv_[4] = 0; } } while (0)
#define POST_NEXT(pv_, d_) do { pv_[0] = d_.a0; pv_[1] = d_.a1; pv_[2] = d_.a2; pv_[3] = d_.a3; pv_[4] = d_.a4; } while (0)
#define POST_KV(row0_, cl_) do { const int kvrow0 = (row0_); \
        bf16x8 Af[8]; \
        _Pragma("unroll") for (int ks = 0; ks < 8; ++ks) Af[ks] = *(const LAS bf16x8*)((cl_) + cc * CLP + (32 * ks + 8 * g) * 2); \
        const bool ismeta = kvrow0 >= MAINR; const int bq = ismeta ? 0 : kvrow0 >> 13; const int pb = ismeta ? kvrow0 - MAINR : NMETA + (kvrow0 & 8191); \
        _Pragma("unroll 2") for (int nt = 0; nt < 8; ++nt) { \
            bf16x8 Bf[8]; \
            _Pragma("unroll") for (int ks = 0; ks < 8; ++ks) Bf[ks] = *(const bf16x8*)(wkv + (size_t)nt * 16 * 256 + 32 * ks); \
            f32x4 acc = (f32x4){0.f, 0.f, 0.f, 0.f}; \
            _Pragma("unroll") for (int ks = 0; ks < 8; ++ks) acc = mfma16(Af[ks], Bf[ks], acc); \
            bf16* dst = (nt < 4 ? C.KATT() : C.VATT()) + (nt & 3) * 16 + cc; \
            _Pragma("unroll") for (int r = 0; r < 4; ++r) { const int p = pb + 4 * g + r; float v = acc[r]; \
                if (nt == 0) { const float o = dpp_f<0x128>(v); const float cs = C.COS()[p * 8 + (cc & 7)], sn = C.SIN()[p * 8 + (cc & 7)]; v = cc < 8 ? v * cs - o * sn : v * cs + o * sn; } \
                const bf16 vb = (bf16)f2bf(v); \
                if (!ismeta) dst[((size_t)bq * TPAD + p) * 64] = vb; \
                else { _Pragma("unroll") for (int bb = 0; bb < NB; ++bb) dst[((size_t)bb * TPAD + p) * 64] = vb; } } } } while (0)
    LAS unsigned char* W = C.lds + C.wid * PW_BYTES;
    for (int grp = gw; grp < MAINR / 16; grp += NGW) {
        const int row0 = grp * 16, bq = row0 >> 13, pb = NMETA + (row0 & 8191);
        unsigned short pv[5];
        { const int s0 = row0 & 8191; POST_PREV(s0 == 0 ? MAINR + 15 : row0 - 1, true, pv); }
        PostLd d0, d1; post_load(C, l, row0, lane, d0);
#pragma unroll 1
        for (int rr = 0; rr < 16; rr += 2) {
            post_load(C, l, row0 + rr + 1, lane, d1);
            post_compute_f(C, l, row0 + rr, rr, lane, d0, pv, mu, kvg, ig, ib, W); POST_NEXT(pv, d0);
            if (rr + 2 < 16) post_load(C, l, row0 + rr + 2, lane, d0);
            post_compute_f(C, l, row0 + rr + 1, rr + 1, lane, d1, pv, mu, kvg, ig, ib, W); POST_NEXT(pv, d1);
            if ((rr & 7) == 6) {
                asm volatile("s_waitcnt lgkmcnt(0)" ::: "memory");
                bf16* ag = C.ACT() + (size_t)grp * (16 * ACTC) + (rr & 8) * 8;
#pragma unroll
                for (int it = 0; it < 5; ++it) { const int q = it * 64 + lane; *(v4u*)(ag + ((q >> 3) * 16 + (q & 7)) * 8) = *(const LAS v4u*)(W + PW_ACT + q * 16); }
                asm volatile("s_waitcnt lgkmcnt(0)" ::: "memory");
            }
        }
        {
            bf16* kg = C.KI() + (size_t)bq * TPAD * 64;
#pragma unroll
            for (int it = 0; it < 2; ++it) { const int q = it * 64 + lane, d8 = q >> 4, r = q & 15;
                *(v4u*)(kg + ((size_t)((pb >> 5) * 4 + (d8 >> 1)) * 64 + (d8 & 1) * 32 + (pb & 31) + r) * 8) = *(const LAS v4u*)(W + PW_KI + q * 16); }
        }
        {
            bf16x8 Af[8];
#pragma unroll
            for (int ks = 0; ks < 8; ++ks) Af[ks] = *(const LAS bf16x8*)(W + cc * CLP + (32 * ks + 8 * g) * 2);
            _Pragma("unroll 2") for (int nt = 0; nt < 8; ++nt) {
                bf16x8 Bf[8];
#pragma unroll
                for (int ks = 0; ks < 8; ++ks) Bf[ks] = *(const bf16x8*)(wkv + (size_t)nt * 16 * 256 + 32 * ks);
                f32x4 acc = (f32x4){0.f, 0.f, 0.f, 0.f};
#pragma unroll
                for (int ks = 0; ks < 8; ++ks) acc = mfma16(Af[ks], Bf[ks], acc);
#pragma unroll
                for (int r = 0; r < 4; ++r) { const int p = pb + 4 * g + r; float v = acc[r];
                    if (nt == 0) { const float o = dpp_f<0x128>(v); const float cs = C.COS()[p * 8 + (cc & 7)], sn = C.SIN()[p * 8 + (cc & 7)]; v = cc < 8 ? v * cs - o * sn : v * cs + o * sn; }
                    *(LAS bf16*)(W + PW_ACT + (nt < 4 ? 0 : 2048) + ((4 * g + r) * 64 + (nt & 3) * 16 + cc) * 2) = (bf16)f2bf(v); } }
            asm volatile("s_waitcnt lgkmcnt(0)" ::: "memory");
#pragma unroll
            for (int it = 0; it < 4; ++it) { const int q = it * 64 + lane;
                bf16* dst = (q < 128 ? C.KATT() : C.VATT()) + ((size_t)bq * TPAD + pb) * 64 + (q & 127) * 8;
                *(v4u*)dst = *(const LAS v4u*)(W + PW_ACT + q * 16); }
            asm volatile("s_waitcnt lgkmcnt(0)" ::: "memory");
        }
    }
    if (C.bid == C.G - 1) {
        LAS unsigned char* clm = C.lds + NWAVES * PW_BYTES;
        const int r0 = MAINR + 2 * C.wid;
        unsigned short pv[5]; POST_PREV(r0 == MAINR ? r0 : r0 - 1, r0 != MAINR, pv);
        PostLd d0, d1; post_load(C, l, r0, lane, d0); post_load(C, l, r0 + 1, lane, d1);
        post_compute(C, l, r0, lane, d0, pv, mu, kvg, ig, ib, clm + (2 * C.wid) * CLP); POST_NEXT(pv, d0);
        post_compute(C, l, r0 + 1, lane, d1, pv, mu, kvg, ig, ib, clm + (2 * C.wid + 1) * CLP);
        asm volatile("s_waitcnt lgkmcnt(0)" ::: "memory");
        __syncthreads();
        if (C.wid == 0) POST_KV(MAINR, clm);
    }
#undef POST_PREV
#undef POST_NEXT
#undef POST_KV
}

__device__ __forceinline__ void prep_copy(LAS unsigned char* sl, unsigned char* ops, int lane) {
#pragma unroll
    for (int i = 0; i < 12; ++i) *(v4u*)(ops + (i * 64 + lane) * 16) = *(const LAS v4u*)(sl + (i * 64 + lane) * 16);
    asm volatile("s_waitcnt lgkmcnt(0)" ::: "memory");
}
template <bool SHARED>
__device__ __forceinline__ unsigned char* prep_unit(const Ctx& C, int l, int bh, int bhl, int cidx, LAS unsigned char* sl, unsigned char* prev_ops) {
    int lane_ = lane_now(); const int lane = lane_, g = lane >> 4, c = lane & 15;
    const int b = bh >> 3, h = bh & 7;
    const int row0 = cidx == 0 ? MAINR : b * SEQ + 16 * (cidx - 1);
    const bf16x8 zero8 = (bf16x8){0, 0, 0, 0, 0, 0, 0, 0};
    const f32x4 z4 = (f32x4){0.f, 0.f, 0.f, 0.f};
    f32x4 aw[4], aa[4], ag[4], av[4];
    const int ch0 = h * 64 + 4 * c;
    const bf16* zb = C.Z() + C_R + ch0;
    v2u wr[4], wk[4], wv[4], wf[4], pwr, pwk, pwv;
    const bf16* act = C.ACT() + (size_t)(row0 >> 4) * (16 * ACTC) + lane * 8;
    const bf16* wl = C.WLT() + (size_t)l * 512 * ACTC + (size_t)(h * 4) * (10 * 512) + lane * 8;
    bf16x8 Af[10], BfA[10], BfB[10];
#define PREP_LDB(Bf, n) do { if (SHARED) { _Pragma("unroll") for (int ks = 0; ks < 10; ++ks) Bf[ks] = *(const LAS bf16x8*)(C.lds + (((n) * 10 + ks) * 64 + lane) * 16); } \
        else { _Pragma("unroll") for (int ks = 0; ks < 10; ++ks) Bf[ks] = *(const bf16x8*)(wl + ((n) * 10 + ks) * 512); } } while (0)
#define PREP_MM(Bf, n) do { aw[n] = mfma16(Af[1], Bf[1], mfma16(Af[0], Bf[0], z4)); aa[n] = mfma16(Af[3], Bf[3], mfma16(Af[2], Bf[2], z4)); \
        { f32x4 t = z4; _Pragma("unroll") for (int ks = 4; ks < 9; ++ks) t = mfma16(Af[ks], Bf[ks], t); ag[n] = t; } av[n] = mfma16(Af[9], Bf[9], z4); } while (0)
    if (SHARED) {
        __syncthreads();
#pragma unroll
        for (int i = 0; i < 5; ++i) { const int blk = C.wid + 8 * i;
            __builtin_amdgcn_global_load_lds((const unsigned*)(wl - lane * 8 + blk * 512 + lane * 8), (LAS unsigned*)(C.lds + blk * 1024), 16, 0, 0); }
    }
#pragma unroll
    for (int ks = 0; ks < 10; ++ks) Af[ks] = *(const bf16x8*)(act + 512 * ks);
    if (!SHARED) { PREP_LDB(BfA, 0); PREP_LDB(BfB, 1); }
#pragma unroll
    for (int r = 0; r < 4; ++r) { const size_t row = row0 + 4 * g + r;
        wr[r] = *(const v2u*)(zb + row * ZC); wk[r] = *(const v2u*)(zb + row * ZC + 512); wv[r] = *(const v2u*)(zb + row * ZC + 1024);
        wf[r] = l == 1 ? *(const v2u*)(C.VF() + row * 512 + ch0) : (v2u){0u, 0u}; }
    {
        bool hasprev = true; int prow;
        if (g > 0) prow = row0 + 4 * g - 1; else if (cidx == 0) { hasprev = false; prow = row0; } else prow = cidx == 1 ? MAINR + 15 : row0 - 1;
        pwr = *(const v2u*)(zb + (size_t)prow * ZC); pwk = *(const v2u*)(zb + (size_t)prow * ZC + 512); pwv = *(const v2u*)(zb + (size_t)prow * ZC + 1024);
        if (!hasprev) { pwr = (v2u){0u, 0u}; pwk = pwr; pwv = pwr; }
    }
    asm volatile("" ::: "memory");
    if (prev_ops) prep_copy(sl, prev_ops, lane);
    asm volatile("" ::: "memory");
    if (SHARED) { asm volatile("s_waitcnt vmcnt(0)" ::: "memory"); __syncthreads(); PREP_LDB(BfA, 0); PREP_LDB(BfB, 1); }
    PREP_MM(BfA, 0);
    asm volatile("" ::: "memory");
    PREP_LDB(BfA, 2);
    asm volatile("" ::: "memory");
    PREP_MM(BfB, 1);
    asm volatile("" ::: "memory");
    PREP_LDB(BfB, 3);
    const f32x4 w0v = *(const f32x4*)(C.I(I_W0) + l * 512 + ch0), a0v = *(const f32x4*)(C.I(I_A0) + l * 512 + ch0);
    const f32x4 v0v = l == 1 ? *(const f32x4*)(C.I(I_V0) + ch0) : z4;
    const f32x4 mur = *(const f32x4*)(C.I(I_MU) + l * 1824 + ch0), muk = *(const f32x4*)(C.I(I_MU) + l * 1824 + 512 + ch0), muv = *(const f32x4*)(C.I(I_MU) + l * 1824 + 1024 + ch0);
    const f32x4 kkc = *(const f32x4*)(C.I(I_KK) + l * 512 + ch0), kac = *(const f32x4*)(C.I(I_KA) + l * 512 + ch0), rkc = *(const f32x4*)(C.I(I_RK) + l * 512 + ch0);
    const f32x4 lnw = *(const f32x4*)(C.I(I_LNW) + l * 512 + ch0), lnb = *(const f32x4*)(C.I(I_LNB) + l * 512 + ch0);
    asm volatile("" ::: "memory");
    PREP_MM(BfA, 2);
    PREP_MM(BfB, 3);
    asm volatile("" ::: "memory");
    if (SHARED) { asm volatile("s_waitcnt lgkmcnt(0)" ::: "memory"); __syncthreads(); }
#undef PREP_LDB
#undef PREP_MM
    float At[4][4], Bt[4][4], Kt[4][4], Vv[4][4], gam[4];
    unsigned char* ops = C.ws + WS_OPS + ((size_t)bhl * NCHUNK + cidx) * OPSB;
    {
        float lw[4][4], cum[4][4];
#pragma unroll
        for (int r = 0; r < 4; ++r)
#pragma unroll
            for (int n = 0; n < 4; ++n) lw[r][n] = -0.6065306597126334f * sigmoidf_(w0v[n] + aw[n][r]);
#pragma unroll
        for (int n = 0; n < 4; ++n) { cum[0][n] = lw[0][n]; cum[1][n] = cum[0][n] + lw[1][n]; cum[2][n] = cum[1][n] + lw[2][n]; cum[3][n] = cum[2][n] + lw[3][n];
            const float tot = cum[3][n];
            const u2v r16 = __builtin_amdgcn_permlane16_swap(__float_as_uint(tot), __float_as_uint(tot), false, false);
            const float x16 = __uint_as_float((g & 1) ? r16.x : r16.y), pr2 = tot + x16;
            const u2v r32 = __builtin_amdgcn_permlane32_swap(__float_as_uint(pr2), __float_as_uint(pr2), false, false);
            const float off = ((g & 1) ? x16 : 0.f) + ((g & 2) ? __uint_as_float(r32.x) : 0.f);
#pragma unroll
            for (int r = 0; r < 4; ++r) cum[r][n] += off;
            gam[n] = 0.f; }
        float pr[4], pk[4], pv[4]; unpack4(pwr, pr); unpack4(pwk, pk); unpack4(pwv, pv);
        float ecp[4];
#pragma unroll
        for (int n = 0; n < 4; ++n) ecp[n] = __expf(cum[0][n] - lw[0][n]);
#pragma unroll
        for (int r = 0; r < 4; ++r) {
            float rr[4], kr[4], vr[4], vf[4]; unpack4(wr[r], rr); unpack4(wk[r], kr); unpack4(wv[r], vr); unpack4(wf[r], vf);
            float rs[4], ks[4], vs[4], kk[4], ss = 0.f;
#pragma unroll
            for (int n = 0; n < 4; ++n) { rs[n] = rr[n] + (pr[n] - rr[n]) * mur[n]; ks[n] = kr[n] + (pk[n] - kr[n]) * muk[n]; vs[n] = vr[n] + (pv[n] - vr[n]) * muv[n];
                pr[n] = rr[n]; pk[n] = kr[n]; pv[n] = vr[n]; kk[n] = ks[n] * kkc[n]; ss += kk[n] * kk[n]; }
            ss = row16_sum(ss);
            const float inv = __builtin_amdgcn_rcpf(fmaxf(__builtin_amdgcn_sqrtf(ss), 1e-12f));
            float k2[4], v2[4], Rt[4], Gp[4], BGp[4], rks = 0.f;
#pragma unroll
            for (int n = 0; n < 4; ++n) { const float a = sigmoidf_(a0v[n] + aa[n][r]); kk[n] *= inv; k2[n] = ks[n] * (1.f + (a - 1.f) * kac[n]);
                const float bb = kk[n] * a; v2[n] = l == 0 ? vs[n] : vs[n] + (vf[n] - vs[n]) * sigmoidf_(v0v[n] + av[n][r]);
                rks += rs[n] * k2[n] * rkc[n];
                const float ec = __expf(cum[r][n]), en = __builtin_amdgcn_rcpf(ec), ep = ecp[n]; ecp[n] = ec; if (r == 3) gam[n] = ec;
                At[r][n] = -kk[n] * ep; Bt[r][n] = bb * en; Kt[r][n] = k2[n] * en; Rt[n] = rs[n] * ec; Vv[r][n] = v2[n]; }
            rks = row16_sum(rks);
#pragma unroll
            for (int n = 0; n < 4; ++n) { const float gg = ag[n][r]; Gp[n] = lnw[n] * gg; BGp[n] = (lnb[n] + rks * v2[n]) * gg; }
            { const int t = 4 * g + r;
              *(LAS s16x4*)(sl + O_W + (t * 64 + 4 * c) * 2) = pack4f(At[r][0], At[r][1], At[r][2], At[r][3]);
              *(LAS s16x4*)(sl + O_B + (t * 64 + 4 * c) * 2) = pack4f(Bt[r][0], Bt[r][1], Bt[r][2], Bt[r][3]);
              *(LAS s16x4*)(sl + O_K + (t * 64 + 4 * c) * 2) = pack4f(Kt[r][0], Kt[r][1], Kt[r][2], Kt[r][3]);
              *(LAS s16x4*)(sl + O_R + (t * 64 + 4 * c) * 2) = pack4f(Rt[0], Rt[1], Rt[2], Rt[3]);
              *(s16x4*)(ops + OPS_G + (t * 64 + 4 * c) * 2) = pack4f(Gp[0], Gp[1], Gp[2], Gp[3]);
              *(s16x4*)(ops + OPS_BG + (t * 64 + 4 * c) * 2) = pack4f(BGp[0], BGp[1], BGp[2], BGp[3]); }
            if (l == 0) *(v2u*)(C.VF() + (size_t)(row0 + 4 * g + r) * 512 + ch0) = (v2u){pk2(vs[0], vs[1]), pk2(vs[2], vs[3])};
        }
    }
#pragma unroll
    for (int n = 0; n < 4; ++n) { const int j = 4 * c + n;
        *(LAS s16x4*)(sl + O_AT + (j * 16 + 4 * g) * 2) = pack4f(At[0][n], At[1][n], At[2][n], At[3][n]);
        *(LAS s16x4*)(sl + O_BK + (j * 32 + 4 * g) * 2) = pack4f(Bt[0][n], Bt[1][n], Bt[2][n], Bt[3][n]);
        *(LAS s16x4*)(sl + O_BK + (j * 32 + 16 + 4 * g) * 2) = pack4f(Kt[0][n], Kt[1][n], Kt[2][n], Kt[3][n]);
        *(LAS s16x4*)(sl + O_VT + (j * 16 + 4 * g) * 2) = pack4f(Vv[0][n], Vv[1][n], Vv[2][n], Vv[3][n]); }
    if (g == 3) *(LAS f32x4*)(sl + O_GAM + 4 * c * 4) = (f32x4){gam[0], gam[1], gam[2], gam[3]};
    asm volatile("s_waitcnt lgkmcnt(0)" ::: "memory");
    {
        f32x4 aab = z4, aak = z4, arb = z4, ark = z4;
#pragma unroll
        for (int ks = 0; ks < 2; ++ks) {
            const bf16x8 Aa = *(const LAS bf16x8*)(sl + O_W + (c * 64 + 32 * ks + 8 * g) * 2), Ar = *(const LAS bf16x8*)(sl + O_R + (c * 64 + 32 * ks + 8 * g) * 2);
            const bf16x8 Bb = *(const LAS bf16x8*)(sl + O_B + (c * 64 + 32 * ks + 8 * g) * 2), Bk = *(const LAS bf16x8*)(sl + O_K + (c * 64 + 32 * ks + 8 * g) * 2);
            aab = mfma16(Aa, Bb, aab); aak = mfma16(Aa, Bk, aak); arb = mfma16(Ar, Bb, arb); ark = mfma16(Ar, Bk, ark);
        }
        asm volatile("" ::: "memory");
        f32x4 mk;
#pragma unroll
        for (int r = 0; r < 4; ++r) { const int t = 4 * g + r; const bool lo = c < t, li = c <= t;
            *(LAS float*)(sl + O_B + (t * 16 + c) * 4) = lo ? aab[r] : 0.f;
            mk[r] = lo ? aak[r] : 0.f;
            *(LAS bf16*)(sl + O_ARK + (t * 32 + c) * 2) = (bf16)f2bf(li ? arb[r] : 0.f);
            *(LAS bf16*)(sl + O_ARK + (t * 32 + 16 + c) * 2) = (bf16)f2bf(li ? ark[r] : 0.f); }
        *(LAS s16x4*)(sl + O_K + (c * 16 + 4 * g) * 2) = pack4(mk);
    }
    asm volatile("s_waitcnt lgkmcnt(0)" ::: "memory");
    {
        float X[16];
#pragma unroll
        for (int t = 0; t < 16; ++t) { float acc = (t == c) ? 1.f : 0.f;
#pragma unroll
            for (int s4 = 0; s4 < (t + 3) / 4; ++s4) { const f32x4 a4 = *(const LAS f32x4*)(sl + O_B + (t * 16 + 4 * s4) * 4);
#pragma unroll
                for (int e = 0; e < 4; ++e) if (4 * s4 + e < t) acc += a4[e] * X[4 * s4 + e]; }
            X[t] = acc; }
#pragma unroll
        for (int t = 0; t < 16; ++t) *(LAS bf16*)(sl + O_K + 512 + (t * 16 + c) * 2) = (bf16)f2bf(X[t]);
    }
    asm volatile("s_waitcnt lgkmcnt(0)" ::: "memory");
    {
        const bf16x8 Top = g < 2 ? *(const LAS bf16x8*)(sl + O_K + 512 + (c * 16 + 8 * g) * 2) : zero8;
#pragma unroll
        for (int n = 0; n < 4; ++n) { const bf16x8 Bop = g < 2 ? *(const LAS bf16x8*)(sl + O_AT + ((16 * n + c) * 16 + 8 * g) * 2) : zero8;
            const f32x4 wacc = mfma16(Top, Bop, z4);
#pragma unroll
            for (int r = 0; r < 4; ++r) *(LAS bf16*)(sl + O_W + ((4 * g + r) * 64 + 16 * n + c) * 2) = (bf16)f2bf(wacc[r]); }
        const bf16x8 Bop = g < 2 ? *(const LAS bf16x8*)(sl + O_K + (c * 16 + 8 * g) * 2) : zero8;
        const f32x4 ta = mfma16(Top, Bop, z4);
#pragma unroll
        for (int r = 0; r < 4; ++r) *(LAS bf16*)(sl + O_TA + ((4 * g + r) * 16 + c) * 2) = (bf16)f2bf(ta[r]);
    }
    asm volatile("s_waitcnt lgkmcnt(0)" ::: "memory");
    return ops;
}

__device__ __forceinline__ void phase_prep(const Ctx& C, int l, int half) {
    const int gw = C.bid * NWAVES + C.wid, NGW = C.G * NWAVES;
    LAS unsigned char* sl = C.lds + C.wid * SLOT;
    unsigned char* pops = nullptr;
    for (int u = gw; u < 16 * 512; u += NGW) { const int bhl = u >> 9, cidx = u & 511; pops = prep_unit<false>(C, l, 16 * half + bhl, bhl, cidx, sl, pops); }
    if (pops) prep_copy(sl, pops, lane_now());
}

struct OpsSet { v4u d[10]; };
struct GbSet { v4u d[4]; };
struct VtSet { v2u v4[4]; };
constexpr int RING_SLOT = 11520, YB_OFF = 8 * RING_SLOT, YB_SLOT = 4096;
__device__ __forceinline__ int swz(int x) { return x + ((x >> 7) << 4); }

__device__ __forceinline__ void ld_ops(OpsSet& s, const unsigned char* ops, int c, int lane) {
    const unsigned char* p = ops + (size_t)(c < NCHUNK ? c : NCHUNK - 1) * OPSB + lane * 16;
#pragma unroll
    for (int i = 0; i < 10; ++i) s.d[i] = *(const v4u*)(p + i * 1024);
}
__device__ __forceinline__ void st_ops(const OpsSet& s, LAS unsigned char* ring, int c, int lane) {
    LAS unsigned char* p = ring + (c & 7) * RING_SLOT + lane * 16 + (lane >> 3) * 16;
#pragma unroll
    for (int i = 0; i < 10; ++i) *(LAS v4u*)(p + i * 1152) = s.d[i];
}
__device__ __forceinline__ void ld_gb(GbSet& s, const unsigned char* ops, int c, int lane) {
    const int t = lane >> 2, cg = lane & 3;
    const unsigned char* p = ops + (size_t)(c < NCHUNK ? c : NCHUNK - 1) * OPSB + (t * 64 + 16 * cg) * 2;
    s.d[0] = *(const v4u*)(p + OPS_G); s.d[1] = *(const v4u*)(p + OPS_G + 16); s.d[2] = *(const v4u*)(p + OPS_BG); s.d[3] = *(const v4u*)(p + OPS_BG + 16);
}
__device__ __forceinline__ void ld_vt(VtSet& s, const unsigned char* ops, int j, int wid, int lane) {
    const int g = lane >> 4, c = lane & 15;
#pragma unroll
    for (int u = 0; u < 4; ++u) { const int ch = 4 * j + u; const unsigned char* p = ops + (size_t)(ch < NCHUNK ? ch : NCHUNK - 1) * OPSB + OPS_VT + (16 * wid + c) * 32;
        s.v4[u] = *(const v2u*)(p + g * 8); }
}
__device__ __forceinline__ void out_stage(const Ctx& C, const GbSet& s, LAS unsigned char* ybuf, int b, int hh, int c, int lane) {
    const int t = lane >> 2, cg = lane & 3;
    const int row = (c == 0 ? MAINR : b * SEQ + 16 * (c - 1)) + t;
    const LAS float* yp = (const LAS float*)(ybuf + (c & 7) * YB_SLOT) + t * 64 + 16 * cg;
    f32x4 y[4];
#pragma unroll
    for (int i = 0; i < 4; ++i) y[i] = *(const LAS f32x4*)(yp + 4 * i);
    float s1 = 0.f;
#pragma unroll
    for (int i = 0; i < 4; ++i) s1 += (y[i].x + y[i].y) + (y[i].z + y[i].w);
    s1 = quad_sum(s1);
    const float mean = s1 * (1.f / 64.f); float s2 = 0.f;
#pragma unroll
    for (int i = 0; i < 4; ++i) { y[i] = y[i] - mean; s2 += (y[i].x * y[i].x + y[i].y * y[i].y) + (y[i].z * y[i].z + y[i].w * y[i].w); }
    s2 = quad_sum(s2);
    const float rstd = __builtin_amdgcn_rsqf(s2 * (1.f / 64.f) + GN_EPS);
    v4u o[2];
#pragma unroll
    for (int k = 0; k < 2; ++k) {
        const v4u gw = s.d[k], bw = s.d[2 + k]; unsigned ow[4];
#pragma unroll
        for (int e = 0; e < 4; ++e) { const f32x4 yy = y[2 * k + (e >> 1)]; const float ya = (e & 1) ? yy.z : yy.x, yb = (e & 1) ? yy.w : yy.y;
            const float g0 = __uint_as_float(gw[e] << 16), g1 = __uint_as_float(gw[e] & 0xffff0000u), b0 = __uint_as_float(bw[e] << 16), b1 = __uint_as_float(bw[e] & 0xffff0000u);
            ow[e] = pk2(ya * rstd * g0 + b0, yb * rstd * g1 + b1); }
        o[k] = (v4u){ow[0], ow[1], ow[2], ow[3]};
    }
    bf16* dst = C.U() + (size_t)row * DM + 512 + hh * 64 + 16 * cg;
    *(v4u*)dst = o[0]; *(v4u*)(dst + 8) = o[1];
}

struct ChEarly { bf16x8 Wp[2], Rp[2]; s16x4 TAop; };
struct ChLate { bf16x8 ARKp, BKp[4]; f32x4 gam[4]; };
__device__ __forceinline__ void chain_load_e(ChEarly& o, const LAS unsigned char* p1, const LAS unsigned char* p2, const int so) {
#pragma unroll
    for (int ks = 0; ks < 2; ++ks) {
        o.Wp[ks] = cat8(*(const LAS s16x4*)(p1 + so + 64 * ks), *(const LAS s16x4*)(p1 + so + 64 * ks + 32));
        o.Rp[ks] = cat8(*(const LAS s16x4*)(p1 + so + 2304 + 64 * ks), *(const LAS s16x4*)(p1 + so + 2304 + 64 * ks + 32)); }
    o.TAop = *(const LAS s16x4*)(p2 + so + 10368);
}
__device__ __forceinline__ void chain_load_l(ChLate& o, const LAS unsigned char* p3, const LAS unsigned char* p4, const int so) {
    o.ARKp = cat8(*(const LAS s16x4*)(p3 + so + 9216), *(const LAS s16x4*)(p3 + so + 9216 + 32));
#pragma unroll
    for (int q = 0; q < 4; ++q) { o.BKp[q] = cat8(*(const LAS s16x4*)(p3 + so + 4608 + 1152 * q), *(const LAS s16x4*)(p3 + so + 4608 + 1152 * q + 32));
        o.gam[q] = *(const LAS f32x4*)(p4 + so + 9728 + 76 * 16 + 64 * q + (q >= 2 ? 16 : 0)); }
}
__device__ __forceinline__ f32x4 chain_compute(const ChEarly& e, const ChLate& o, const v2u v4w, f32x4 (&ST)[4]) {
    const s16x4 V4 = __builtin_bit_cast(s16x4, v4w); const s16x4 zero4 = (s16x4){0, 0, 0, 0};
    const bf16x8 TAop = cat8(e.TAop, zero4), Vb = cat8(V4, zero4);
    const f32x4 z4 = (f32x4){0.f, 0.f, 0.f, 0.f};
    const bf16x8 Bk0 = cat8(pack4(ST[0]), pack4(ST[1])), Bk1 = cat8(pack4(ST[2]), pack4(ST[3]));
    f32x4 U = mfma16(e.Wp[0], Bk0, z4); U = mfma16(e.Wp[1], Bk1, U); U = mfma16(TAop, Vb, U);
    f32x4 Y = mfma16(e.Rp[0], Bk0, z4); Y = mfma16(e.Rp[1], Bk1, Y);
    const bf16x8 UV = cat8(pack4(U), V4);
    Y = mfma16(o.ARKp, UV, Y);
#pragma unroll
    for (int q = 0; q < 4; ++q) { ST[q] = mfma16(o.BKp[q], UV, ST[q]); ST[q] = ST[q] * o.gam[q]; }
    return Y;
}

#define WAIT_LAST() do { unsigned sp_ = 0; while (__hip_atomic_load(flagw, __ATOMIC_RELAXED, __HIP_MEMORY_SCOPE_AGENT) < 2u && ++sp_ < (1u << 20)) __builtin_amdgcn_s_sleep(8); \
    __builtin_amdgcn_fence(__ATOMIC_ACQUIRE, "agent"); asm volatile("s_waitcnt vmcnt(0)" ::: "memory"); } while (0)
#define WG_BAR() do { asm volatile("s_waitcnt lgkmcnt(0)" ::: "memory"); __builtin_amdgcn_s_barrier(); asm volatile("" ::: "memory"); } while (0)
#define YSTORE(ch, Yv) do { _Pragma("unroll") for (int r = 0; r < 4; ++r) *(LAS float*)(ybuf + ((ch) & 7) * YB_SLOT + ((4 * (lane >> 4) + r) * 64 + 16 * wid + (lane & 15)) * 4) = (Yv)[r]; } while (0)
#define CHAIN_IT(j, VTU, HB) do { \
    ChEarly ea, eb; ChLate la; f32x4 Yv; \
    chain_load_e(ea, p1 + HB, p2 + HB, 0); \
    chain_load_l(la, p3 + HB, p4 + HB, 0); chain_load_e(eb, p1 + HB, p2 + HB, RING_SLOT); \
    Yv = chain_compute(ea, la, VTU.v4[0], ST); YSTORE(4 * (j) + 0, Yv); \
    chain_load_l(la, p3 + HB, p4 + HB, RING_SLOT); chain_load_e(ea, p1 + HB, p2 + HB, 2 * RING_SLOT); \
    Yv = chain_compute(eb, la, VTU.v4[1], ST); YSTORE(4 * (j) + 1, Yv); \
    chain_load_l(la, p3 + HB, p4 + HB, 2 * RING_SLOT); chain_load_e(eb, p1 + HB, p2 + HB, 3 * RING_SLOT); \
    Yv = chain_compute(ea, la, VTU.v4[2], ST); YSTORE(4 * (j) + 2, Yv); \
    chain_load_l(la, p3 + HB, p4 + HB, 3 * RING_SLOT); \
    Yv = chain_compute(eb, la, VTU.v4[3], ST); YSTORE(4 * (j) + 3, Yv); \
    ld_vt(VTU, ops, (j) + 2, wid, lane); WG_BAR(); } while (0)
#define LOAD_IT(j, OSW, OSI, GBO, GBI) do { \
    const int co = 4 * ((j) - 1) + lw; if ((j) >= 1 && co < NCHUNK) out_stage(C, GBO, ybuf, b, hh, co, lane); \
    const int cn = 4 * ((j) + 1) + lw; if (cn < NCHUNK) st_ops(OSW, ring, cn, lane); \
    ld_ops(OSI, ops, 4 * ((j) + 3) + lw, lane); ld_gb(GBI, ops, cn, lane); WG_BAR(); } while (0)

__device__ __forceinline__ void chain_phase(const Ctx& C, int bh, int bhl, unsigned* flagw) {
    int lane_ = lane_now(); const int lane = lane_, wid = C.wid;
    const int b = bh >> 3, hh = bh & 7;
    LAS unsigned char* ring = C.lds; LAS unsigned char* ybuf = C.lds + YB_OFF;
    const unsigned char* ops = C.ws + WS_OPS + (size_t)bhl * NCHUNK * OPSB;
    constexpr int NIT = 132;
    if (wid < 4) {
        f32x4 ST[4];
#pragma unroll
        for (int q = 0; q < 4; ++q) ST[q] = (f32x4){0.f, 0.f, 0.f, 0.f};
        VtSet vt0, vt1;
        ld_vt(vt0, ops, 0, wid, lane); ld_vt(vt1, ops, 1, wid, lane);
        WG_BAR();
        __builtin_amdgcn_s_setprio(3);
        const int g_ = lane >> 4, c_ = lane & 15;
        const LAS unsigned char* p1 = ring + c_ * 144 + 8 * g_;
        const LAS unsigned char* p2 = ring + c_ * 32 + 8 * g_ + (c_ >> 2) * 16;
        const LAS unsigned char* p3 = ring + c_ * 64 + 8 * g_ + (c_ >> 1) * 16;
        const LAS unsigned char* p4 = ring + 16 * g_;
#pragma unroll 1
        for (int j = 0; j < NIT; j += 2) {
            if (j == 96) WAIT_LAST();
#ifndef NOCHAIN
            CHAIN_IT(j, vt0, 0); CHAIN_IT(j + 1, vt1, 4 * RING_SLOT);
#endif
        }
        __builtin_amdgcn_s_setprio(0);
    } else {
        const int lw = wid - 4;
        OpsSet os0, os1, os2; GbSet gb0, gb1, gb2;
        ld_ops(os0, ops, lw, lane); ld_ops(os1, ops, 4 + lw, lane); ld_ops(os2, ops, 8 + lw, lane); ld_gb(gb0, ops, lw, lane); st_ops(os0, ring, lw, lane);
        gb1 = gb0; gb2 = gb0;
        WG_BAR();
#pragma unroll 1
        for (int j = 0; j < NIT; j += 3) {
            if (j == 96) WAIT_LAST();
#ifndef NOLOADER
            LOAD_IT(j, os1, os0, gb2, gb1); LOAD_IT(j + 1, os2, os1, gb0, gb2); LOAD_IT(j + 2, os0, os2, gb1, gb0);
#endif
        }
    }
}

constexpr int SCW = 8224;
constexpr int LDS_HIST = 8 * SCW * 2;
constexpr int LDS_IDX = LDS_HIST + 8 * 256 * 4;
constexpr int LDS_MISC = LDS_IDX + 8 * 256 * 2;
static_assert(LDS_MISC + 64 <= LDS_BYTES && 8 * 18432 <= LDS_BYTES && 8 * 10240 + 8 * 4096 <= LDS_MISC, "lds map");

__device__ __forceinline__ unsigned mbcnt64(unsigned long long m) { return __builtin_amdgcn_mbcnt_hi((unsigned)(m >> 32), __builtin_amdgcn_mbcnt_lo((unsigned)m, 0u)); }

__device__ __forceinline__ void find_bin(LAS unsigned* hist, unsigned target, int lane, unsigned& bin, unsigned& above) {
    const v4u c = *(LAS v4u*)(hist + 4 * lane);
    const unsigned t = c.x + c.y + c.z + c.w;
    const unsigned inc = wave_scan_incl(t);
    const unsigned total = lane_bcast(inc, 63);
    const unsigned sufx = total - inc;
    const bool found = (sufx < target) && (target <= sufx + t);
    unsigned mybin = 0, myab = 0;
    if (found) { unsigned a = sufx;
        if (a + c.w >= target) { mybin = 4 * lane + 3; myab = a; } else { a += c.w;
        if (a + c.z >= target) { mybin = 4 * lane + 2; myab = a; } else { a += c.z;
        if (a + c.y >= target) { mybin = 4 * lane + 1; myab = a; } else { a += c.y; mybin = 4 * lane; myab = a; } } } }
    const unsigned long long m = __ballot(found);
    const int src = m ? (int)__builtin_ctzll(m) : 0;
    bin = lane_bcast(mybin, src); above = lane_bcast(myab, src);
}

__device__ __forceinline__ void attn_unit(const Ctx& C, int l, int b, int qt) {
    const int lane = lane_now(), wid = C.wid, tid = wid * 64 + lane;
    const int p0 = 8 * qt, nk = p0 + 8, ntile = (nk + 31) >> 5, nkp = ntile * 32;
    LAS u16* SC = (LAS u16*)C.lds; LAS unsigned* HIST = (LAS unsigned*)(C.lds + LDS_HIST); LAS u16* IDX = (LAS u16*)(C.lds + LDS_IDX);
    for (int i = tid; i < 8 * 256; i += NT) HIST[i] = 0u;
    __syncthreads();
    const bf16* Z = C.Z();
    {
        const int r = lane & 31, half = lane >> 5;
        const int rowq = row_of(b, p0 + (r >> 2));
        bf16x8 Af[4];
#pragma unroll
        for (int s = 0; s < 4; ++s) Af[s] = *(const bf16x8*)(Z + (size_t)rowq * ZC + C_QI + (r & 3) * 64 + 16 * s + 8 * half);
        float wi[4][4];
#pragma unroll
        for (int g = 0; g < 4; ++g) { const int rg = row_of(b, p0 + 2 * g + half);
#pragma unroll
            for (int hh = 0; hh < 4; ++hh) wi[g][hh] = bf2f(Z[(size_t)rg * ZC + C_WI + hh]) * 0.0625f; }
        const unsigned char* kib = (const unsigned char*)(C.KI() + (size_t)b * TPAD * 64); const unsigned klane = (unsigned)lane * 16u;
        const unsigned char* kib2 = (const unsigned char*)(C.KI() + (size_t)((b + 1) & 3) * TPAD * 64);
#define SC_LOAD2(P, ka_, kb_) do { const int ka__ = (ka_), kb__ = (kb_); _Pragma("unroll") for (int s = 0; s < 4; ++s) { P[0][s] = *(const bf16x8*)(kib + ((unsigned)ka__ * 4096u + 1024u * s + klane)); P[1][s] = *(const bf16x8*)(kib + ((unsigned)kb__ * 4096u + 1024u * s + klane)); } } while (0)
#define SC_LOAD(P, kt_) do { _Pragma("unroll") for (int s = 0; s < 4; ++s) { P[0][s] = *(const bf16x8*)(kib + ((unsigned)(kt_) * 4096u + 1024u * s + klane)); P[1][s] = *(const bf16x8*)(kib + ((unsigned)((kt_) + 8) * 4096u + 1024u * s + klane)); \
    if (PROBE == 6) { bf16x8 d0 = *(const bf16x8*)(kib2 + ((unsigned)(kt_) * 4096u + 1024u * s + klane)), d1 = *(const bf16x8*)(kib2 + ((unsigned)((kt_) + 8) * 4096u + 1024u * s + klane)); asm volatile("" :: "v"(d0), "v"(d1)); } } } while (0)
#define SC_MFMA(acc, Bq) do { _Pragma("unroll") for (int e = 0; e < 16; ++e) acc[e] = 0.f; \
            _Pragma("unroll") for (int s = 0; s < 4; ++s) acc = __builtin_amdgcn_mfma_f32_32x32x16_bf16(Af[s], Bq[s], acc, 0, 0, 0); } while (0)
#define SC_KEY2(a_, b_) ({ const h2v hh_ = __builtin_convertvector((f32x2h){(a_), (b_)}, h2v); const unsigned w_ = __builtin_bit_cast(unsigned, hh_); \
            const s2v m_ = __builtin_bit_cast(s2v, w_) >> 15; w_ ^ (__builtin_bit_cast(unsigned, m_) | 0x80008000u); })
#define SC_SCORES(acc) float scv[4]; \
            _Pragma("unroll") for (int g = 0; g < 4; ++g) { \
                const float r0 = relu_i(acc[4 * g + 0]), r1 = relu_i(acc[4 * g + 1]), r2 = relu_i(acc[4 * g + 2]), r3 = relu_i(acc[4 * g + 3]); \
                scv[g] = __builtin_fmaf(wi[g][3], r3, __builtin_fmaf(wi[g][2], r2, __builtin_fmaf(wi[g][1], r1, wi[g][0] * r0))); } \
            const unsigned w01 = SC_KEY2(scv[0], scv[1]), w23 = SC_KEY2(scv[2], scv[3]);
#define SC_EMIT_FULL() do { \
                SC[(0 + half) * SCW + key] = (u16)w01; SC[(2 + half) * SCW + key] = (u16)(w01 >> 16); SC[(4 + half) * SCW + key] = (u16)w23; SC[(6 + half) * SCW + key] = (u16)(w23 >> 16); \
                atomicAdd((unsigned*)(HIST + (0 + half) * 256 + ((w01 >> 8) & 0xffu)), 1u); atomicAdd((unsigned*)(HIST + (2 + half) * 256 + (w01 >> 24)), 1u); \
                atomicAdd((unsigned*)(HIST + (4 + half) * 256 + ((w23 >> 8) & 0xffu)), 1u); atomicAdd((unsigned*)(HIST + (6 + half) * 256 + (w23 >> 24)), 1u); } while (0)
#define SC_VALU_FAST(acc, kt_) do { const int key = (kt_) * 32 + r; SC_SCORES(acc) SC_EMIT_FULL(); } while (0)
#define SC_VALU(acc, kt_) do { const int kt__ = (kt_); if (kt__ < ntile) { const int key = kt__ * 32 + r; SC_SCORES(acc) \
            if (kt__ * 32 + 31 <= p0) SC_EMIT_FULL(); \
            else { \
                _Pragma("unroll") for (int g = 0; g < 4; ++g) { const unsigned wp = g < 2 ? w01 : w23; unsigned k16 = (g & 1) ? (wp >> 16) : (wp & 0xffffu); \
                    const int qq = 2 * g + half; const bool valid = key <= p0 + qq; \
                    if (!valid) k16 = 0u; \
                    SC[qq * SCW + key] = (u16)k16; \
                    if (valid) atomicAdd((unsigned*)(HIST + qq * 256 + (k16 >> 8)), 1u); } } } } while (0)
        bf16x8 P0[2][4], P1[2][4], P2[2][4];
        _Pragma("unroll 1") for (int rep7 = 0, n7 = (PROBE == 7 ? launder2() : 1); rep7 < n7; ++rep7) {
        LAS unsigned* HISTsave = HIST; if (rep7) HIST = (LAS unsigned*)(C.lds + 144384);
        const int nst = (ntile + 7) >> 3, nfull = (p0 + 1) >> 5, jfull = nfull > wid ? (nfull - wid + 7) >> 3 : 0;
#define TIDX(j) (wid + 8 * (j))
#define TSAFE(j) ((j) < nst ? TIDX(j) : wid)
        SC_LOAD2(P0, TSAFE(0), TSAFE(1)); SC_LOAD2(P1, TSAFE(2), TSAFE(3));
        int j = 0;
        for (; j + 6 <= jfull; j += 6) {
            f32x16 acc0, acc1;
            SC_LOAD2(P2, TSAFE(j + 4), TSAFE(j + 5));
            SC_MFMA(acc0, P0[0]); SC_MFMA(acc1, P0[1]); SC_VALU_FAST(acc0, TIDX(j)); SC_VALU_FAST(acc1, TIDX(j + 1));
            SC_LOAD2(P0, TSAFE(j + 6), TSAFE(j + 7));
            SC_MFMA(acc0, P1[0]); SC_MFMA(acc1, P1[1]); SC_VALU_FAST(acc0, TIDX(j + 2)); SC_VALU_FAST(acc1, TIDX(j + 3));
            SC_LOAD2(P1, TSAFE(j + 8), TSAFE(j + 9));
            SC_MFMA(acc0, P2[0]); SC_MFMA(acc1, P2[1]); SC_VALU_FAST(acc0, TIDX(j + 4)); SC_VALU_FAST(acc1, TIDX(j + 5));
        }
        for (; j < nst; j += 6) {
            f32x16 acc0, acc1;
            SC_LOAD2(P2, TSAFE(j + 4), TSAFE(j + 5));
            SC_MFMA(acc0, P0[0]); SC_MFMA(acc1, P0[1]); SC_VALU(acc0, TSAFE(j)); if (j + 1 < nst) SC_VALU(acc1, TIDX(j + 1));
            SC_LOAD2(P0, TSAFE(j + 6), TSAFE(j + 7));
            SC_MFMA(acc0, P1[0]); SC_MFMA(acc1, P1[1]); if (j + 2 < nst) SC_VALU(acc0, TIDX(j + 2)); if (j + 3 < nst) SC_VALU(acc1, TIDX(j + 3));
            SC_LOAD2(P1, TSAFE(j + 8), TSAFE(j + 9));
            SC_MFMA(acc0, P2[0]); SC_MFMA(acc1, P2[1]); if (j + 4 < nst) SC_VALU(acc0, TIDX(j + 4)); if (j + 5 < nst) SC_VALU(acc1, TIDX(j + 5));
        }
#undef TIDX
#undef TSAFE
        HIST = HISTsave; }
#undef SC_LOAD
#undef SC_LOAD2
#undef SC_MFMA
#undef SC_VALU
#undef SC_VALU_FAST
#undef SC_SCORES
#undef SC_EMIT_FULL
#undef SC_KEY2
    }
    __syncthreads();
    const int q = wid, p = p0 + q, nvalid = p + 1, nsel = nvalid < 256 ? nvalid : 256;
    LAS u16* sc = SC + q * SCW; LAS unsigned* hist = HIST + q * 256; LAS u16* idx = IDX + q * 256;
    if (nvalid <= 256) { for (int i = lane; i < nvalid; i += 64) idx[i] = (u16)i; }
    else {
        unsigned b1, ab1; find_bin(hist, 256u, lane, b1, ab1);
        _Pragma("unroll 1") for (int rep8 = 0, n8 = (PROBE == 8 ? launder2() : 1); rep8 < n8; ++rep8) {
        asm volatile("s_waitcnt lgkmcnt(0)" ::: "memory");
        { unsigned z_ = 0u; asm volatile("" : "+v"(z_)); *(LAS v4u*)(hist + 4 * lane) = (v4u){z_, z_, z_, z_}; }
        asm volatile("s_waitcnt lgkmcnt(0)" ::: "memory");
        const int niter = (nkp + 255) >> 8;
        {   v2u cur = 4 * lane < nkp ? *(LAS v2u*)(sc + 4 * lane) : (v2u){0u, 0u};
            for (int it = 0; it < niter; ++it) { const int in = (it + 1) * 256 + 4 * lane; const v2u nxt = in < nkp ? *(LAS v2u*)(sc + in) : (v2u){0u, 0u};
                const unsigned k0 = cur.x & 0xffffu, k1 = cur.x >> 16, k2 = cur.y & 0xffffu, k3 = cur.y >> 16;
                if ((k0 >> 8) == b1) atomicAdd((unsigned*)(hist + (k0 & 255u)), 1u);
                if ((k1 >> 8) == b1) atomicAdd((unsigned*)(hist + (k1 & 255u)), 1u);
                if ((k2 >> 8) == b1) atomicAdd((unsigned*)(hist + (k2 & 255u)), 1u);
                if ((k3 >> 8) == b1) atomicAdd((unsigned*)(hist + (k3 & 255u)), 1u);
                cur = nxt; } }
        asm volatile("s_waitcnt lgkmcnt(0)" ::: "memory");
        unsigned b2, ab2; find_bin(hist, 256u - ab1, lane, b2, ab2);
        const unsigned T16 = (b1 << 8) | b2; const unsigned need_eq = 256u - ab1 - ab2;
        unsigned eq_base = 0u;
        LAS unsigned* bmp = (LAS unsigned*)sc;
        unsigned c0 = lane < nkp ? sc[lane] : 0u, c1 = 64 + lane < nkp ? sc[64 + lane] : 0u, c2 = 128 + lane < nkp ? sc[128 + lane] : 0u, c3 = 192 + lane < nkp ? sc[192 + lane] : 0u;
        for (int it = 0; it < niter; ++it) { const int nb = (it + 1) * 256 + lane;
            const unsigned n0 = nb < nkp ? sc[nb] : 0u, n1 = nb + 64 < nkp ? sc[nb + 64] : 0u, n2 = nb + 128 < nkp ? sc[nb + 128] : 0u, n3 = nb + 192 < nkp ? sc[nb + 192] : 0u;
            const unsigned k[4] = {c0, c1, c2, c3};
            unsigned long long mt[4];
#pragma unroll
            for (int j = 0; j < 4; ++j) mt[j] = __ballot(k[j] > T16);
            if (__ballot(k[0] == T16 || k[1] == T16 || k[2] == T16 || k[3] == T16)) {
#pragma unroll
                for (int j = 0; j < 4; ++j) { const bool eq = k[j] == T16; const unsigned long long me = __ballot(eq);
                    mt[j] |= __ballot(eq && (eq_base + mbcnt64(me)) < need_eq); eq_base += (unsigned)__popcll(me); }
            }
            if (lane == 0) { *(LAS v4u*)(bmp + it * 8) = (v4u){(unsigned)mt[0], (unsigned)(mt[0] >> 32), (unsigned)mt[1], (unsigned)(mt[1] >> 32)};
                             *(LAS v4u*)(bmp + it * 8 + 4) = (v4u){(unsigned)mt[2], (unsigned)(mt[2] >> 32), (unsigned)mt[3], (unsigned)(mt[3] >> 32)}; }
            c0 = n0; c1 = n1; c2 = n2; c3 = n3; }
        asm volatile("s_waitcnt lgkmcnt(0)" ::: "memory");
        {
            const int ndw = niter * 8;
            v4u d4 = (v4u){0u, 0u, 0u, 0u};
            if (4 * lane < ndw) d4 = *(const LAS v4u*)(bmp + 4 * lane);
            const unsigned cnt = (unsigned)(__builtin_popcount(d4.x) + __builtin_popcount(d4.y) + __builtin_popcount(d4.z) + __builtin_popcount(d4.w));
            const unsigned inc = wave_scan_incl(cnt);
            unsigned pos = inc - cnt; const unsigned tot = lane_bcast(inc, 63);
            const unsigned dt = ndw > 256 ? bmp[256] : 0u;
#pragma unroll
            for (int w = 0; w < 4; ++w) { unsigned d = d4[w]; while (d) { const unsigned bit = (unsigned)__builtin_ctz(d); if (pos < 256u) idx[pos] = (u16)((4 * lane + w) * 32 + bit); ++pos; d &= d - 1u; } }
            if (lane == 0) { unsigned d = dt, ps = tot; while (d) { const unsigned bit = (unsigned)__builtin_ctz(d); if (ps < 256u) idx[ps] = (u16)(8192u + bit); ++ps; d &= d - 1u; } }
        }
        }
    }
    asm volatile("s_waitcnt lgkmcnt(0)" ::: "memory");
    if (p < NMETA && b != 0) return;
    const int row = row_of(b, p);
    if (nsel < 256) { for (int i = nsel + lane; i < 256; i += 64) idx[i] = (u16)0; asm volatile("s_waitcnt lgkmcnt(0)" ::: "memory"); }
    _Pragma("unroll 1") for (int rep9 = 0, n9 = (PROBE == 9 ? launder2() : 1); rep9 < n9; ++rep9)
    {
        const int g = lane >> 4, c = lane & 15;
        const bf16x8 zero8 = (bf16x8){0, 0, 0, 0, 0, 0, 0, 0};
        bf16x8 qB[2];
#pragma unroll
        for (int ks = 0; ks < 2; ++ks) qB[ks] = c < 8 ? *(const bf16x8*)(Z + (size_t)row * ZC + C_Q + c * 64 + 32 * ks + 8 * g) : zero8;
        const unsigned char* kbase = (const unsigned char*)(C.KATT() + (size_t)b * TPAD * 64);
        f32x4 S[16];
        {
            bf16x8 Kf0[8][2], Kf1[8][2];
#pragma unroll
            for (int t4 = 0; t4 < 8; ++t4) { const int slot = 16 * t4 + c; const int kix = (int)idx[slot];
                const unsigned ko = (unsigned)kix * 128u + 16u * (unsigned)g; Kf0[t4][0] = *(const bf16x8*)(kbase + ko); Kf0[t4][1] = *(const bf16x8*)(kbase + ko + 64u); }
#pragma unroll
            for (int t4 = 0; t4 < 8; ++t4) { const int slot = 16 * (8 + t4) + c; const int kix = (int)idx[slot];
                const unsigned ko = (unsigned)kix * 128u + 16u * (unsigned)g; Kf1[t4][0] = *(const bf16x8*)(kbase + ko); Kf1[t4][1] = *(const bf16x8*)(kbase + ko + 64u); }
#pragma unroll
            for (int t4 = 0; t4 < 8; ++t4) { f32x4 a = mfma16(Kf0[t4][0], qB[0], (f32x4){0.f, 0.f, 0.f, 0.f}); S[t4] = mfma16(Kf0[t4][1], qB[1], a); }
#pragma unroll
            for (int t4 = 0; t4 < 8; ++t4) { f32x4 a = mfma16(Kf1[t4][0], qB[0], (f32x4){0.f, 0.f, 0.f, 0.f}); S[8 + t4] = mfma16(Kf1[t4][1], qB[1], a); }
            asm volatile("" ::: "memory");
        }
        LAS unsigned char* VL = (LAS unsigned char*)sc;
        const unsigned char* vbase = (const unsigned char*)(C.VATT() + (size_t)b * TPAD * 64);
        const unsigned tr_base = (unsigned)(size_t)VL + (unsigned)(((4 * g + ((lane & 15) >> 2)) * 64 + 4 * (lane & 3)) * 2);
        v4u vv0[16], vv1[16];
#define V_GATHER(vv, hf, i0, i1) do { _Pragma("unroll") for (int i = (i0); i < (i1); ++i) { const int e = i * 64 + lane; const int sl = (hf) * 128 + (e >> 3); const int kix = (int)idx[sl]; \
            vv[i] = *(const v4u*)(vbase + ((unsigned)kix * 128u + (unsigned)(e & 7) * 16u)); } } while (0)
        V_GATHER(vv0, 0, 0, 16);
        asm volatile("" ::: "memory");
        if (nsel < 256) {
#pragma unroll
            for (int kt = 0; kt < 16; ++kt)
#pragma unroll
                for (int r = 0; r < 4; ++r) { const int slot = 16 * kt + 4 * g + r; if (slot >= nsel) S[kt][r] = -INFINITY; }
        }
        float mx = -INFINITY;
#pragma unroll
        for (int kt = 0; kt < 16; ++kt)
#pragma unroll
            for (int r = 0; r < 4; ++r) mx = fmaxf(mx, S[kt][r]);
        mx = xor16_max(mx); mx = xor32_max(mx);
        const float sl2 = 0.125f * 1.4426950408889634f, m2 = mx * sl2;
        float sum = 0.f;
#pragma unroll
        for (int kt = 0; kt < 16; ++kt)
#pragma unroll
            for (int r = 0; r < 4; ++r) { const float e = __builtin_amdgcn_exp2f(__builtin_fmaf(S[kt][r], sl2, -m2)); S[kt][r] = e; sum += e; }
        sum = xor16_sum(sum); sum = xor32_sum(sum);
        const float inv = __builtin_amdgcn_rcpf(sum);
        f32x4 O[4];
#pragma unroll
        for (int dt = 0; dt < 4; ++dt) O[dt] = (f32x4){0.f, 0.f, 0.f, 0.f};
        asm volatile("" ::: "memory");
        V_GATHER(vv1, 1, 0, 8);
        asm volatile("" ::: "memory");
#define PV_HALF(vv, hf) do { \
            _Pragma("unroll") for (int i = 0; i < 16; ++i) *(LAS v4u*)(VL + (i * 64 + lane) * 16) = vv[i]; \
            if ((hf) == 0) { asm volatile("" ::: "memory"); V_GATHER(vv1, 1, 8, 16); } \
            asm volatile("s_waitcnt lgkmcnt(0)" ::: "memory"); \
            _Pragma("unroll") for (int kk = 0; kk < 4; ++kk) { \
                const bf16x8 Bp = cat8(pack4(S[(hf) * 8 + 2 * kk]), pack4(S[(hf) * 8 + 2 * kk + 1])); \
                s16x4 lo0, hi0, lo1, hi1, lo2, hi2, lo3, hi3; \
                asm volatile("ds_read_b64_tr_b16 %0, %8 offset:%c9\n\tds_read_b64_tr_b16 %1, %8 offset:%c10\n\tds_read_b64_tr_b16 %2, %8 offset:%c11\n\tds_read_b64_tr_b16 %3, %8 offset:%c12\n\t" \
                             "ds_read_b64_tr_b16 %4, %8 offset:%c13\n\tds_read_b64_tr_b16 %5, %8 offset:%c14\n\tds_read_b64_tr_b16 %6, %8 offset:%c15\n\tds_read_b64_tr_b16 %7, %8 offset:%c16\n\ts_waitcnt lgkmcnt(0)" \
                             : "=&v"(lo0), "=&v"(hi0), "=&v"(lo1), "=&v"(hi1), "=&v"(lo2), "=&v"(hi2), "=&v"(lo3), "=&v"(hi3) \
                             : "v"(tr_base), "i"(kk * 4096), "i"(kk * 4096 + 2048), "i"(kk * 4096 + 32), "i"(kk * 4096 + 32 + 2048), "i"(kk * 4096 + 64), "i"(kk * 4096 + 64 + 2048), "i"(kk * 4096 + 96), "i"(kk * 4096 + 96 + 2048) : "memory"); \
                O[0] = mfma16(cat8(lo0, hi0), Bp, O[0]); O[1] = mfma16(cat8(lo1, hi1), Bp, O[1]); O[2] = mfma16(cat8(lo2, hi2), Bp, O[2]); O[3] = mfma16(cat8(lo3, hi3), Bp, O[3]); } \
            asm volatile("" ::: "memory"); } while (0)
        PV_HALF(vv0, 0);
        PV_HALF(vv1, 1);
#undef V_GATHER
#undef PV_HALF
        if (c < 8) {
#pragma unroll
            for (int dt = 0; dt < 4; ++dt) { const f32x4 o = O[dt] * inv; *(v2u*)(C.U() + (size_t)row * DM + c * 64 + 16 * dt + 4 * g) = (v2u){pk2(o.x, o.y), pk2(o.z, o.w)}; }
        }
    }
}

constexpr int NUNITS = 1026 * NB;
__device__ __forceinline__ void phase_seq(const Ctx& C, int l, int half) {
    unsigned* ctr = C.CTL() + 64 + 64 * l;
    unsigned* done = C.CTL() + 64 * 8 + 64 * (2 * l + half);
    unsigned* flagw = C.CTL() + 64 * (40 + 2 * l + half);
    if (C.bid == 16 || C.bid == 17) {
        const int bhl = (C.bid - 16) * 8 + C.wid;
        { unsigned char* po = prep_unit<false>(C, l, 16 * half + bhl, bhl, 512, C.lds + C.wid * SLOT, nullptr); prep_copy(C.lds + C.wid * SLOT, po, lane_now()); }
        asm volatile("s_waitcnt vmcnt(0)" ::: "memory"); __syncthreads();
        if (C.wid == 0 && lane_now() == 0) { __builtin_amdgcn_fence(__ATOMIC_RELEASE, "agent"); asm volatile("s_waitcnt vmcnt(0)" ::: "memory"); __hip_atomic_fetch_add(flagw, 1u, __ATOMIC_RELAXED, __HIP_MEMORY_SCOPE_AGENT); }
        __syncthreads();
    }
    if (C.bid < 16) { _Pragma("unroll 1") for (int rep4 = 0, n4 = (PROBE == 4 ? launder2() : 1); rep4 < n4; ++rep4) { chain_phase(C, 16 * half + C.bid, C.bid, flagw); __syncthreads(); }
        if (C.wid == 0 && lane_now() == 0) __hip_atomic_fetch_add(done, 1u, __ATOMIC_RELAXED, __HIP_MEMORY_SCOPE_AGENT); }
    LAS unsigned* shu = (LAS unsigned*)(C.lds + LDS_MISC);
    _Pragma("unroll 1") for (int rep5 = 0, n5 = ((PROBE == 5 && half == 1) ? launder2() : 1); rep5 < n5; ++rep5) {
    int bpref = (int)(((unsigned)__builtin_amdgcn_s_getreg((3 << 11) | 20) & 7u) >> 1);
    unsigned* cb = C.CTL() + 64 * (16 + 8 * l + 4 * rep5);
    auto fetch = [&](int& bp) -> unsigned {
        if (half == 0 && __hip_atomic_load(done, __ATOMIC_RELAXED, __HIP_MEMORY_SCOPE_AGENT) >= 16u) return 0xffffffffu;
        for (int t = 0; t < 4; ++t) { const unsigned u = atomicAdd(cb + bp, 1u); if (u < 1026u) return u | ((unsigned)bp << 16); bp = (bp + 1) & 3; }
        return 0xffffffffu; };
    unsigned nxt = 0xffffffffu;
    if (C.wid == 0 && lane_now() == 0) shu[0] = fetch(bpref);
    __syncthreads();
    for (;;) {
        const unsigned u = shu[0];
        __syncthreads();
        if (u == 0xffffffffu) break;
        if (C.wid == 0 && lane_now() == 0) nxt = fetch(bpref);
        const int qt = 1025 - (int)(u & 0xffffu), b = (int)(u >> 16);
        if (!(qt < 2 && b != 0)) attn_unit(C, l, b, qt);
        __syncthreads();
        if (C.wid == 0 && lane_now() == 0) shu[0] = nxt;
        __syncthreads();
    }
    }
}

template <int ACT>
__device__ __forceinline__ void meta_gemm(const Ctx& C, const bf16* A, const bf16* Bt, int K, int N, bf16* O, int ldc) {
    int lane_ = lane_now(); const int lane = lane_, g = lane >> 4, c = lane & 15, wid = C.wid;
    LAS float* red = (LAS float*)C.lds;
    const int kw = K / NWAVES;
    for (int unit = C.bid; unit < N / 16; unit += C.G) {
        const bf16* ap = A + (size_t)(MAINR + c) * K + wid * kw + 8 * g; const bf16* bp = Bt + (size_t)(unit * 16 + c) * K + wid * kw + 8 * g;
        f32x4 acc = (f32x4){0.f, 0.f, 0.f, 0.f};
        for (int k0 = 0; k0 < kw; k0 += 128) {
            bf16x8 af[4], bfr[4];
#pragma unroll
            for (int s = 0; s < 4; ++s) { af[s] = *(const bf16x8*)(ap + k0 + 32 * s); bfr[s] = *(const bf16x8*)(bp + k0 + 32 * s); }
#pragma unroll
            for (int s = 0; s < 4; ++s) acc = mfma16(af[s], bfr[s], acc);
        }
        *(LAS f32x4*)(red + (wid * 64 + lane) * 4) = acc;
        __syncthreads();
        if (wid == 0) {
            f32x4 t = acc;
#pragma unroll
            for (int w = 1; w < NWAVES; ++w) t = t + *(const LAS f32x4*)(red + (w * 64 + lane) * 4);
#pragma unroll
            for (int r = 0; r < 4; ++r) { float v = t[r]; if (ACT == 2) { v = fmaxf(v, 0.f); v = v * v; }
                O[(size_t)(MAINR + 4 * g + r) * ldc + unit * 16 + c] = (bf16)f2bf(v); }
        }
        __syncthreads();
    }
}

template <int ACT, bool OUT8>
__device__ __forceinline__ void meta_gemm8(const Ctx& C, const unsigned char* A, const unsigned char* Bt, int K, int N, void* Ov, int ldc, float omul, float hmul) {
    int lane_ = lane_now(); const int lane = lane_, g = lane >> 4, c = lane & 15, wid = C.wid;
    LAS float* red = (LAS float*)C.lds;
    const int kw = K / NWAVES;
    for (int unit = C.bid; unit < N / 16; unit += C.G) {
        const unsigned char* ap = A + (size_t)(MAINR + c) * K + wid * kw + 8 * g; const unsigned char* bp = Bt + (size_t)(unit * 16 + c) * K + wid * kw + 8 * g;
        f32x4 acc = (f32x4){0.f, 0.f, 0.f, 0.f};
        for (int k0 = 0; k0 < kw; k0 += 128) {
            long af[4], bfr[4];
#pragma unroll
            for (int s = 0; s < 4; ++s) { af[s] = *(const long*)(ap + k0 + 32 * s); bfr[s] = *(const long*)(bp + k0 + 32 * s); }
#pragma unroll
            for (int s = 0; s < 4; ++s) acc = __builtin_amdgcn_mfma_f32_16x16x32_fp8_fp8(af[s], bfr[s], acc, 0, 0, 0);
        }
        *(LAS f32x4*)(red + (wid * 64 + lane) * 4) = acc;
        __syncthreads();
        if (wid == 0) {
            f32x4 t = acc;
#pragma unroll
            for (int w = 1; w < NWAVES; ++w) t = t + *(const LAS f32x4*)(red + (w * 64 + lane) * 4);
#pragma unroll
            for (int r = 0; r < 4; ++r) { float v = t[r] * omul; if (ACT == 2) { v = fmaxf(v, 0.f); v = v * v; }
                if (OUT8) ((unsigned char*)Ov)[(size_t)(MAINR + 4 * g + r) * ldc + unit * 16 + c] = (unsigned char)(pk4_fp8(v * hmul, 0.f, 0.f, 0.f) & 0xffu);
                else ((bf16*)Ov)[(size_t)(MAINR + 4 * g + r) * ldc + unit * 16 + c] = (bf16)f2bf(v); }
        }
        __syncthreads();
    }
}

#define XLAS __attribute__((address_space(3)))
#define XB_TMO      128
#define XB_XCNT(j)  (256  + 64 * (j))
#define XB_XSUB(j)  (1280 + 64 * (j))
#define XB_XGEN(j)  (2304 + 64 * (j))
#define XB_TOP      3328
#define XB_TOPGEN   3392
#define XCD_BAR_WORDS 3456
#define XB_SPIN_CAP (1u << 18)

__device__ __forceinline__ unsigned xb_ld(unsigned* p)              { return __hip_atomic_load(p, __ATOMIC_RELAXED, __HIP_MEMORY_SCOPE_AGENT); }
__device__ __forceinline__ unsigned xb_add(unsigned* p, unsigned v) { return __hip_atomic_fetch_add(p, v, __ATOMIC_RELAXED, __HIP_MEMORY_SCOPE_AGENT); }
__device__ __forceinline__ unsigned xb_xcc_id() { return (unsigned)__builtin_amdgcn_s_getreg((3 << 11) | 20) & 0xFu; }
#define XB_SPIN(cond, bar) do { unsigned _sp = 0; while (cond) { __builtin_amdgcn_s_sleep(1); \
    if ((++_sp & 255u) == 0u) { if (xb_ld(&(bar)[XB_TMO])) break; if (_sp > XB_SPIN_CAP) { atomicAdd(&(bar)[XB_TMO], 1u); break; } } } } while (0)

struct XcdBarrier {
    unsigned* bar; unsigned x;
    int w; bool first;
    volatile XLAS unsigned* st;
};

__device__ __forceinline__ XcdBarrier xcd_barrier_post(unsigned* bar, volatile XLAS unsigned* st, int wid0) {
    XcdBarrier b; b.bar = bar; b.x = xb_xcc_id(); b.st = st; b.w = wid0; b.first = wid0 == 0 && lane_now() == 0;
    if (b.first) (void)xb_add(&bar[XB_XCNT(b.x)], 1u);
    return b;
}
__device__ __forceinline__ void xcd_barrier_complete(unsigned* bar, unsigned x, unsigned& nloc, unsigned& nx) {
    const unsigned G = gridDim.x * gridDim.y * gridDim.z;
    unsigned sum, cnt, mine, sp = 0u;
    for (;;) {
        sum = 0u; cnt = 0u; mine = 0u;
#pragma unroll
        for (unsigned j = 0; j < 16; ++j) { const unsigned c = xb_ld(&bar[XB_XCNT(j)]); sum += c; cnt += (c > 0u) ? 1u : 0u; mine = (j == x) ? c : mine; }
        if (sum == G) break;
        __builtin_amdgcn_s_sleep(1);
        if ((++sp & 255u) == 0u) { if (xb_ld(&bar[XB_TMO])) break; if (sp > XB_SPIN_CAP) { atomicAdd(&bar[XB_TMO], 1u); break; } }
    }
    nloc = mine > 0u ? mine : 1u; nx = cnt > 0u ? cnt : 1u;
}

__device__ __forceinline__ void xcd_barrier(const XcdBarrier& b) {
    asm volatile("s_waitcnt vmcnt(0)" ::: "memory");
    __syncthreads();
    if (b.w == 0 && lane_now() == 0) {
        unsigned* bar = b.bar;
        __builtin_amdgcn_s_waitcnt(0);
        unsigned nloc = b.st[0], nx = b.st[1];
        if (nloc == 0u) { xcd_barrier_complete(bar, b.x, nloc, nx); b.st[0] = nloc; b.st[1] = nx; }
        const unsigned old = xb_add(&bar[XB_XSUB(b.x)], 1u);
        const unsigned gen = old / nloc;
        if (old + 1u == (gen + 1u) * nloc) {
            __builtin_amdgcn_fence(__ATOMIC_RELEASE, "agent");
            asm volatile("s_waitcnt vmcnt(0)" ::: "memory");
            const unsigned og = xb_add(&bar[XB_TOP], 1u);
            const unsigned tg = og / nx;
            if (og + 1u == (tg + 1u) * nx) xb_add(&bar[XB_TOPGEN], 1u);
            else XB_SPIN(xb_ld(&bar[XB_TOPGEN]) == tg, bar);
            __builtin_amdgcn_fence(__ATOMIC_ACQUIRE, "agent");
            xb_add(&bar[XB_XGEN(b.x)], 1u);
            asm volatile("s_waitcnt vmcnt(0)" ::: "memory");
        } else {
            XB_SPIN(xb_ld(&bar[XB_XGEN(b.x)]) == gen, bar);
            __builtin_amdgcn_fence(__ATOMIC_ACQUIRE, "agent");
            asm volatile("s_waitcnt vmcnt(0)" ::: "memory");
        }
    }
    __syncthreads();
}

__global__ void __launch_bounds__(NT, 2) fwd_kernel(Args args) {
    extern __shared__ __attribute__((aligned(16))) unsigned char lds_raw[];
    Ctx C; C.ppass = 0; C.in = args.in; C.out = args.out; C.ws = args.ws; C.lds = (LAS unsigned char*)lds_raw;
    int wid0 = __builtin_amdgcn_readfirstlane(threadIdx.x >> 6); asm volatile("" : "+s"(wid0));
    C.wid = wid0; C.lane = lane_now(); C.tid = wid0 * 64 + C.lane; C.G = gridDim.x; C.bid = blockIdx.x;
    const int lo = args.ph_lo, hi = args.ph_hi;
    int ph = 0;
    volatile XLAS unsigned* bst = (volatile XLAS unsigned*)(C.lds + LDS_BYTES - 64);
    if (C.tid < 2) bst[C.tid] = 0u;
    __syncthreads();
    const XcdBarrier bar = xcd_barrier_post(C.CTL() + 4096, bst, wid0);
#define REPLOOP _Pragma("unroll 1") for (int rep = 0, nrep_ = launder2(); rep < nrep_; ++rep)
#define NOREP for (int rep = 0; rep < 1; ++rep)
#if PROBE == 1 || PROBE == 11 || PROBE == 12
#define REP1 REPLOOP
#else
#define REP1 NOREP
#endif
#if PROBE == 2
#define REP2 REPLOOP
#else
#define REP2 NOREP
#endif
#if PROBE == 3
#define REP3 REPLOOP
#else
#define REP3 NOREP
#endif
#ifndef PHSEL
#define PHSEL 0xffff
#endif
#define PHASE_BEGIN if (ph >= lo && ph < hi) { { const int l_ = lane_now(); C.lane = l_; C.wid = wid0; C.tid = wid0 * 64 + l_; }
#define PHASE_END(last) if (ph + 1 < hi && !(last)) xcd_barrier(bar); } ++ph;

    PHASE_BEGIN if (PHSEL & (1 << 0)) { phase_prologue(C); phase_norm<false, false>(C, C.I(I_X), nullptr, nullptr, nullptr, C.I(I_NMPRE), C.I(I_META)); } PHASE_END(false)
    for (int l = 0; l < NL; ++l) {
        PHASE_BEGIN if (PHSEL & (1 << 2)) { REP3 { pg8::Gemm g{C.U(), (const bf16*)(C.ws + WS_WIN) + (size_t)l * ZC * 1024, MAINR, ZC, 1024}; pg8::StaticOrder S; S.init(MAINR, ZC, C.G, C.bid);
            pg8::EpiBf16<0> E{C.Z(), ZC}; pg8::gemm_phase<pg8::EpiBf16<0>, pg8::StaticOrder, true, true>(C.lds, g, S, E, C.tid); __syncthreads(); } meta_gemm<0>(C, C.U(), (const bf16*)(C.ws + WS_WIN) + (size_t)l * ZC * 1024, 1024, ZC, C.Z(), ZC); } PHASE_END(false)
        PHASE_BEGIN if (PHSEL & (1 << 3)) { REP2 phase_post(C, l, rep == 0); } PHASE_END(false)
        PHASE_BEGIN if (PHSEL & (1 << 4)) { REP1 { C.ppass = rep; phase_prep(C, l, 0); C.ppass = 0; } } PHASE_END(false)
        PHASE_BEGIN if (PHSEL & (1 << 10)) phase_seq(C, l, 0); PHASE_END(false)
        PHASE_BEGIN if (PHSEL & (1 << 4)) { REP1 { C.ppass = rep; phase_prep(C, l, 1); C.ppass = 0; } } PHASE_END(false)
        PHASE_BEGIN if (PHSEL & (1 << 10)) phase_seq(C, l, 1); PHASE_END(false)
        PHASE_BEGIN if (PHSEL & (1 << 5)) { REP3 { pg8::Gemm g{C.U(), (const bf16*)(C.ws + WS_WO) + (size_t)l * 1024 * 1024, MAINR, DM, 1024}; pg8::StaticOrder S; S.init(MAINR, DM, C.G, C.bid);
            pg8::EpiBf16<0> E{C.Z(), DM}; pg8::gemm_phase<pg8::EpiBf16<0>, pg8::StaticOrder, true, true>(C.lds, g, S, E, C.tid); __syncthreads(); } meta_gemm<0>(C, C.U(), (const bf16*)(C.ws + WS_WO) + (size_t)l * 1024 * 1024, 1024, DM, C.Z(), DM); } PHASE_END(false)
        PHASE_BEGIN if (PHSEL & (1 << 6)) { void* hmid = (l + 1 == NL) ? (void*)(C.ws + WS_HMID) : (void*)C.out;
            if (l == 0) phase_norm<false, true>(C, C.I(I_X), hmid, C.Z(), C.I(I_NMPOST) + l * DM, C.I(I_NFPRE) + l * DM, nullptr, true);
            else phase_norm<true, true>(C, C.out, hmid, C.Z(), C.I(I_NMPOST) + l * DM, C.I(I_NFPRE) + l * DM, nullptr, true); } PHASE_END(false)
        PHASE_BEGIN if (PHSEL & (1 << 7)) { REP3 { pg8::Gemm g{(const bf16*)C.U(), (const bf16*)(C.ws + WS_WUP + (size_t)l * FF * 1024), MAINR, FF, 512}; pg8::StaticOrder S; S.init(MAINR, FF, C.G, C.bid);
            pg8::EpiFp8<2> E{C.ws + WS_HID, FF, S8_H}; pg8::gemm_phase<pg8::EpiFp8<2>, pg8::StaticOrder, true, true, true, E8_WU, E8_X>(C.lds, g, S, E, C.tid); __syncthreads(); }
            meta_gemm8<2, true>(C, (const unsigned char*)C.U(), C.ws + WS_WUP + (size_t)l * FF * 1024, 1024, FF, C.ws + WS_HID, FF, 1.f / (S8_X * S8_WU), S8_H); } PHASE_END(false)
        PHASE_BEGIN if (PHSEL & (1 << 8)) { REP3 { pg8::Gemm g{(const bf16*)(C.ws + WS_HID), (const bf16*)(C.ws + WS_WDN + (size_t)l * DM * FF), MAINR, DM, FF / 2}; pg8::StaticOrder S; S.init(MAINR, DM, C.G, C.bid);
            pg8::EpiBf16<0> E{(bf16*)(C.ws + WS_TMP2), DM}; pg8::gemm_phase<pg8::EpiBf16<0>, pg8::StaticOrder, true, true, true, E8_WD, E8_H>(C.lds, g, S, E, C.tid); __syncthreads(); }
            meta_gemm8<0, false>(C, C.ws + WS_HID, C.ws + WS_WDN + (size_t)l * DM * FF, FF, DM, C.ws + WS_TMP2, DM, 1.f / (S8_H * S8_WD), 1.f); } PHASE_END(false)
        PHASE_BEGIN if (PHSEL & (1 << 9)) { if (l + 1 < NL) phase_norm<true, true>(C, C.out, C.out, (const bf16*)(C.ws + WS_TMP2), C.I(I_NFPOST) + l * DM, C.I(I_NMPRE) + (l + 1) * DM);
            else phase_norm<true, false>(C, C.ws + WS_HMID, C.out, (const bf16*)(C.ws + WS_TMP2), C.I(I_NFPOST) + l * DM, nullptr); } PHASE_END(l + 1 == NL)
    }
}

extern "C" void kernel_launch(void* const* d_in, const int* in_sizes, int n_in, void* d_out, int out_size, void* d_ws, size_t ws_size, hipStream_t stream) {
    static int grid = 0;
    if (grid == 0) {
        if (n_in != 30 || out_size != NB * SEQ * DM || ws_size < WS_END) { fprintf(stderr, "kernel_launch: unexpected shapes (n_in %d out %d ws %zu need %zu)\n", n_in, out_size, ws_size, (size_t)WS_END); grid = -1; return; }
        int dev = 0, cus = 0, per_cu = 0;
        (void)hipGetDevice(&dev); (void)hipDeviceGetAttribute(&cus, hipDeviceAttributeMultiprocessorCount, dev);
        (void)hipFuncSetAttribute((const void*)fwd_kernel, hipFuncAttributeMaxDynamicSharedMemorySize, LDS_BYTES);
        (void)hipOccupancyMaxActiveBlocksPerMultiprocessor(&per_cu, (const void*)fwd_kernel, NT, LDS_BYTES);
        (void)hipGetLastError();
        grid = cus;
        fprintf(stderr, "kernel_launch: cus %d per_cu %d ws %zu\n", cus, per_cu, ws_size);
    }
    if (grid < 0) return;
    (void)hipMemsetAsync((char*)d_ws + WS_CTL, 0, CTL_BYTES, stream);
    Args a{};
    for (int i = 0; i < 30; ++i) a.in[i] = (const float*)d_in[i];
    a.out = (float*)d_out; a.ws = (unsigned char*)d_ws;
    a.ph_lo = 0; a.ph_hi = 1000;
    void* kargs[] = {&a};
    hipError_t e = hipLaunchCooperativeKernel((const void*)fwd_kernel, dim3(grid), dim3(NT), kargs, LDS_BYTES, stream);
    if (e != hipSuccess) fprintf(stderr, "kernel_launch: cooperative launch failed: %s\n", hipGetErrorString(e));
}
```

```cpp
#include <hip/hip_runtime.h>
#include <hip/hip_cooperative_groups.h>
#include <cstdio>
#include <cstdint>
namespace cg = cooperative_groups;
namespace pg8 {
#define PG8_LAS __attribute__((address_space(3)))
typedef unsigned short bf16_t;
typedef short bf16x8 __attribute__((ext_vector_type(8)));
typedef float f32x4 __attribute__((ext_vector_type(4)));
typedef unsigned u32x4 __attribute__((ext_vector_type(4)));
typedef int i32x8 __attribute__((ext_vector_type(8)));
typedef int i32x4 __attribute__((ext_vector_type(4)));
constexpr int BM = 256, BK = 64, HALF = 128, HTB = HALF * BK * 2  , STAGE_BYTES = 8 * HTB, NXCD = 8, WGM = 8;

__host__ __device__ __forceinline__ int lds_byte(int r, int c) { const int st = (r >> 4) * 2 + (c >> 5), rr = r & 15, cc = c & 31, ob = rr * 64 + cc * 2; return st * 1024 + (ob ^ (((ob >> 9) & 1) << 5)); }
__host__ __device__ __forceinline__ void stage_rc(int b, int& R, int& C) { const int st = b / 1024, sb = b % 1024, swz = sb ^ (((sb >> 9) & 1) << 5); R = (st >> 1) * 16 + swz / 64; C = (st & 1) * 32 + (swz % 64) / 2; }
__host__ __device__ __forceinline__ int perm32(int rho) { const int n = rho >> 4, i = rho & 15; return 8 * (i >> 2) + 4 * n + (i & 3); }

struct Unit { int pm, pn; };
struct Gemm { const bf16_t* A; const bf16_t* Bt; int M, N, K; };

struct StaticOrder {
    int nM, nN, nwg, G, c;
    __host__ __device__ void init(int M, int N, int G_, int c_) { nM = M / BM; nN = N / BM; nwg = nM * nN; G = G_; c = c_; }
    __host__ __device__ bool next(int i, Unit& u) const {
        const long L = (long)i * G + c; if (L >= nwg) return false;
        int wgid = (int)L; { const int q = nwg / NXCD, r = nwg % NXCD, xcd = wgid % NXCD, off = wgid / NXCD; wgid = (xcd < r ? xcd * (q + 1) : r * (q + 1) + (xcd - r) * q) + off; }
        const int nig = WGM * nN, gid = wgid / nig, fm = gid * WGM, gsz = (nM - fm) < WGM ? (nM - fm) : WGM;
        u.pm = fm + ((wgid % nig) % gsz); u.pn = (wgid % nig) / gsz; return true;
    }
    __device__ __forceinline__ void a_ready(const Unit&) const {}
    __device__ __forceinline__ void done(const Unit&) const {}
};

__device__ __forceinline__ unsigned cvt_pk_bf16(float lo, float hi) { unsigned r; asm volatile("v_cvt_pk_bf16_f32 %0, %1, %2" : "=v"(r) : "v"(lo), "v"(hi)); return r; }
typedef float f32x2 __attribute__((ext_vector_type(2)));
template <int ACT> struct EpiBf16 {
    static constexpr bool PERM = true, AFTER_DRAIN = false;
    bf16_t* O; int ldc;
    __device__ __forceinline__ void operator()(const f32x4 (&acc)[2][2][4][2], const Unit& u, int wr, int wc, int fr, int fq) const {
        const int row0 = u.pm * BM + wr * 64 + fr; const int col0 = u.pn * BM + wc * 32 + 8 * fq;
#pragma unroll
        for (int ai = 0; ai < 2; ++ai)
#pragma unroll
            for (int m = 0; m < 4; ++m) { bf16_t* rowp = O + (size_t)(row0 + ai * HALF + m * 16) * ldc + col0;
#pragma unroll
                for (int bj = 0; bj < 2; ++bj) { f32x4 v0 = acc[ai][bj][m][0], v1 = acc[ai][bj][m][1];
                    if (ACT == 2) {
#pragma unroll
                        for (int e = 0; e < 4; ++e) { float a = fmaxf(v0[e], 0.f), b = fmaxf(v1[e], 0.f); v0[e] = a * a; v1[e] = b * b; } }
                    u32x4 w; w.x = cvt_pk_bf16(v0[0], v0[1]); w.y = cvt_pk_bf16(v0[2], v0[3]); w.z = cvt_pk_bf16(v1[0], v1[1]); w.w = cvt_pk_bf16(v1[2], v1[3]);
                    *(u32x4*)(rowp + bj * HALF) = w; } }
    }
};
typedef unsigned u32x2 __attribute__((ext_vector_type(2)));
template <int ACT> struct EpiFp8 {
    static constexpr bool PERM = true, AFTER_DRAIN = false;
    unsigned char* O; int ldc; float mul;
    __device__ __forceinline__ void operator()(const f32x4 (&acc)[2][2][4][2], const Unit& u, int wr, int wc, int fr, int fq) const {
        const int row0 = u.pm * BM + wr * 64 + fr; const int col0 = u.pn * BM + wc * 32 + 8 * (fq & ~1);
        const float sm = __builtin_amdgcn_sqrtf(mul), cap = __builtin_amdgcn_sqrtf(448.f);
#pragma unroll
        for (int ai = 0; ai < 2; ++ai)
#pragma unroll
            for (int mp = 0; mp < 2; ++mp) {
                unsigned char* rowp = O + (size_t)(row0 + ai * HALF + (2 * mp + (fq & 1)) * 16) * ldc + col0;
#pragma unroll
                for (int bj = 0; bj < 2; ++bj) {
                    unsigned w[2][2];
#pragma unroll
                    for (int mq = 0; mq < 2; ++mq) { f32x4 v0 = acc[ai][bj][2 * mp + mq][0], v1 = acc[ai][bj][2 * mp + mq][1];
#pragma unroll
                        for (int e = 0; e < 4; ++e) {
                            if (ACT == 2) { const float a = __builtin_amdgcn_fmed3f(v0[e] * sm, 0.f, cap), b = __builtin_amdgcn_fmed3f(v1[e] * sm, 0.f, cap); v0[e] = a * a; v1[e] = b * b; }
                            else { v0[e] = __builtin_amdgcn_fmed3f(v0[e] * mul, -448.f, 448.f); v1[e] = __builtin_amdgcn_fmed3f(v1[e] * mul, -448.f, 448.f); } }
                        int lo = __builtin_amdgcn_cvt_pk_fp8_f32(v0[0], v0[1], 0, false); lo = __builtin_amdgcn_cvt_pk_fp8_f32(v0[2], v0[3], lo, true);
                        int hi = __builtin_amdgcn_cvt_pk_fp8_f32(v1[0], v1[1], 0, false); hi = __builtin_amdgcn_cvt_pk_fp8_f32(v1[2], v1[3], hi, true);
                        w[mq][0] = (unsigned)lo; w[mq][1] = (unsigned)hi; }
                    const u32x2 sl = __builtin_amdgcn_permlane16_swap(w[0][0], w[1][0], false, false), sh = __builtin_amdgcn_permlane16_swap(w[0][1], w[1][1], false, false);
                    *(u32x4*)(rowp + bj * HALF) = (u32x4){sl.x, sh.x, sl.y, sh.y}; } }
    }
};
template <class Epi, class Sched, bool ALIGN_EPI = false, bool SP2 = false, bool FP8 = false, int SCW = 0x7f7f7f7f, int SCA = 0x7f7f7f7f>
__device__ __forceinline__ void gemm_phase(PG8_LAS unsigned char* lds, const Gemm g, const Sched& S, const Epi& E, const int tid_in) {
    int tid_l_ = tid_in; asm volatile("" : "+v"(tid_l_));
    const int tid = tid_l_, wid = __builtin_amdgcn_readfirstlane(tid >> 6), lane = tid & 63, wr = wid >> 2, wc = wid & 3, fr = lane & 15, fq = lane >> 4;
    const int K = g.K, nt = K / BK;
    unsigned voffA[2], voffB[2];
#pragma unroll
    for (int i = 0; i < 2; ++i) { int R, C; stage_rc(tid * 16 + i * 8192, R, C); const int Rb = Epi::PERM ? ((R & ~31) + perm32(R & 31)) : R;
        voffA[i] = (unsigned)(R * K + C) * 2u; voffB[i] = (unsigned)(Rb * K + C) * 2u; }
    const size_t kstep = (size_t)(BK * 2);
    const size_t hstep = (size_t)HALF * K * 2;
    const size_t tstep = 2 * hstep;
    const unsigned ldsw = (unsigned)wid * 1024u;
    const int aoff = lds_byte(wr * 64 + fr, fq * 8), boff = lds_byte(wc * 32 + fr, fq * 8);
#define PG8_SA(b, h) (((b) * 2 + (h)) * HTB)
#define PG8_SB(b, h) ((4 + (b) * 2 + (h)) * HTB)
#define PG8_STAGE(bufoff, gbase, voff) do { _Pragma("unroll") for (int _i = 0; _i < 2; ++_i) \
        __builtin_amdgcn_global_load_lds((const unsigned*)((const char*)(gbase) + (voff)[_i]), (PG8_LAS unsigned*)(lds + (bufoff) + ldsw + _i * 8192), 16, 0, 0); } while (0)
#define PG8_LD8(off) __builtin_shufflevector(*(const PG8_LAS i32x4*)(lds + (off)), *(const PG8_LAS i32x4*)(lds + (off) + 1024), 0, 1, 2, 3, 4, 5, 6, 7)
#define PG8_LDA(dst, b, h) do { if constexpr (FP8) { _Pragma("unroll") for (int m = 0; m < 4; ++m) dst##8[m] = PG8_LD8(PG8_SA(b, h) + aoff + m * 2048); } else { \
        _Pragma("unroll") for (int m = 0; m < 4; ++m) _Pragma("unroll") for (int k = 0; k < 2; ++k) dst[m][k] = *(const PG8_LAS bf16x8*)(lds + PG8_SA(b, h) + aoff + m * 2048 + k * 1024); } } while (0)
#define PG8_LDB(dst, b, h) do { if constexpr (FP8) { _Pragma("unroll") for (int n = 0; n < 2; ++n) dst##8[n] = PG8_LD8(PG8_SB(b, h) + boff + n * 2048); } else { \
        _Pragma("unroll") for (int n = 0; n < 2; ++n) _Pragma("unroll") for (int k = 0; k < 2; ++k) dst[n][k] = *(const PG8_LAS bf16x8*)(lds + PG8_SB(b, h) + boff + n * 2048 + k * 1024); } } while (0)
#define PG8_MMA(ai, bj, At, Bt) do { __builtin_amdgcn_s_setprio(1); if constexpr (FP8) { _Pragma("unroll") for (int m = 0; m < 4; ++m) _Pragma("unroll") for (int n = 0; n < 2; ++n) \
        asm volatile("v_mfma_scale_f32_16x16x128_f8f6f4 %0, %1, %2, %0, %3, %4 op_sel_hi:[0,0,0]" : "+v"(acc[ai][bj][m][n]) : "v"(Bt##8[n]), "v"(At##8[m]), "v"(scw_), "v"(sca_)); } else { \
        _Pragma("unroll") for (int m = 0; m < 4; ++m) _Pragma("unroll") for (int n = 0; n < 2; ++n) _Pragma("unroll") for (int k = 0; k < 2; ++k) \
        acc[ai][bj][m][n] = __builtin_amdgcn_mfma_f32_16x16x32_bf16(Bt[n][k], At[m][k], acc[ai][bj][m][n], 0, 0, 0); } __builtin_amdgcn_s_setprio(0); } while (0)
#define PG8_WAIT_V(n) asm volatile("s_waitcnt vmcnt(" #n ")" ::: "memory")
#define PG8_WAIT_L(n) asm volatile("s_waitcnt lgkmcnt(" #n ")" ::: "memory")
#define PG8_BAR __builtin_amdgcn_s_barrier()
#define PG8_SCHED __builtin_amdgcn_sched_barrier(0)
    Unit cur, nxt; int ui = 0;
    if (!S.next(0, cur)) return;
    f32x4 acc[2][2][4][2];
#pragma unroll
    for (int a = 0; a < 2; ++a)
#pragma unroll
        for (int b = 0; b < 2; ++b)
#pragma unroll
            for (int m = 0; m < 4; ++m)
#pragma unroll
                for (int n = 0; n < 2; ++n) acc[a][b][m][n] = (f32x4){0.f, 0.f, 0.f, 0.f};
    int scw_ = SCW, sca_ = SCA; asm volatile("" : "+v"(scw_), "+v"(sca_));
    bf16x8 At[4][2], B0[2][2], B1[2][2]; i32x8 At8[4], B08[2], B18[2];
    const char* cA = (const char*)g.A + (size_t)cur.pm * tstep; const char* cB = (const char*)g.Bt + (size_t)cur.pn * tstep;
    S.a_ready(cur);
    if constexpr (SP2) {
        PG8_STAGE(PG8_SB(0, 0), cB, voffB); PG8_STAGE(PG8_SB(0, 1), cB + hstep, voffB); PG8_STAGE(PG8_SA(0, 0), cA, voffA); PG8_STAGE(PG8_SA(0, 1), cA + hstep, voffA);
        if (wr == 1) PG8_BAR;
        PG8_WAIT_V(2); PG8_BAR;
        PG8_STAGE(PG8_SB(1, 0), cB + kstep, voffB); PG8_STAGE(PG8_SA(1, 0), cA + kstep, voffA); PG8_STAGE(PG8_SB(1, 1), cB + hstep + kstep, voffB);
        PG8_WAIT_V(6); PG8_BAR;
    } else {
        PG8_STAGE(PG8_SB(0, 0), cB, voffB); PG8_STAGE(PG8_SA(0, 0), cA, voffA); PG8_STAGE(PG8_SB(0, 1), cB + hstep, voffB); PG8_STAGE(PG8_SA(0, 1), cA + hstep, voffA);
        if (wr == 1) PG8_BAR;
        PG8_WAIT_V(4); PG8_BAR;
        PG8_STAGE(PG8_SB(1, 0), cB + kstep, voffB); PG8_STAGE(PG8_SA(1, 0), cA + kstep, voffA); PG8_STAGE(PG8_SB(1, 1), cB + hstep + kstep, voffB);
        PG8_WAIT_V(6); PG8_BAR;
    }
    for (;;) {
        const bool has_next = S.next(ui + 1, nxt);
        const char* nA = has_next ? (const char*)g.A + (size_t)nxt.pm * tstep : cA; const char* nB = has_next ? (const char*)g.Bt + (size_t)nxt.pn * tstep : cB;
        for (int t = 0; t < nt; t += 2) {
            const bool last = (t == nt - 2);
            const char* a1 = cA + (size_t)(t + 1) * kstep;
            const char* a2 = last ? nA : cA + (size_t)(t + 2) * kstep; const char* b2 = last ? nB : cB + (size_t)(t + 2) * kstep;
            const char* a3 = a2 + kstep; const char* b3 = b2 + kstep;
            if (last && has_next) S.a_ready(nxt);
            if constexpr (SP2) {
            PG8_LDB(B0, 0, 0); PG8_LDB(B1, 0, 1); PG8_SCHED; PG8_LDA(At, 0, 0); PG8_STAGE(PG8_SA(1, 1), a1 + hstep, voffA);
            PG8_WAIT_V(8); PG8_WAIT_L(0); PG8_BAR; PG8_MMA(0, 0, At, B0); PG8_MMA(0, 1, At, B1); PG8_BAR; PG8_SCHED;
            PG8_LDA(At, 0, 1); PG8_STAGE(PG8_SB(0, 0), b2, voffB); PG8_STAGE(PG8_SB(0, 1), b2 + hstep, voffB); PG8_STAGE(PG8_SA(0, 0), a2, voffA);
            PG8_WAIT_V(8); PG8_WAIT_L(0); PG8_BAR; PG8_MMA(1, 0, At, B0); PG8_MMA(1, 1, At, B1); PG8_BAR; PG8_SCHED;
            PG8_LDB(B0, 1, 0); PG8_LDB(B1, 1, 1); PG8_SCHED; PG8_LDA(At, 1, 0); PG8_STAGE(PG8_SA(0, 1), a2 + hstep, voffA);
            PG8_WAIT_V(8); PG8_WAIT_L(0); PG8_BAR; PG8_MMA(0, 0, At, B0); PG8_MMA(0, 1, At, B1); PG8_BAR; PG8_SCHED;
            PG8_LDA(At, 1, 1); PG8_STAGE(PG8_SB(1, 0), b3, voffB); PG8_STAGE(PG8_SB(1, 1), b3 + hstep, voffB); PG8_STAGE(PG8_SA(1, 0), a3, voffA);
            PG8_WAIT_V(8); PG8_WAIT_L(0); PG8_BAR; PG8_MMA(1, 0, At, B0); PG8_MMA(1, 1, At, B1); PG8_BAR; PG8_SCHED;
            } else {
            PG8_LDB(B0, 0, 0); PG8_SCHED; PG8_LDA(At, 0, 0); PG8_STAGE(PG8_SA(1, 1), a1 + hstep, voffA);
            PG8_WAIT_L(8); PG8_BAR; PG8_WAIT_L(0); PG8_MMA(0, 0, At, B0); PG8_BAR; PG8_SCHED;
            PG8_LDB(B1, 0, 1); PG8_STAGE(PG8_SB(0, 0), b2, voffB);
            PG8_BAR; PG8_WAIT_L(0); PG8_MMA(0, 1, At, B1); PG8_BAR;
            PG8_LDA(At, 0, 1); PG8_STAGE(PG8_SA(0, 0), a2, voffA);
            PG8_BAR; PG8_WAIT_L(0); PG8_MMA(1, 0, At, B0); PG8_BAR; PG8_SCHED;
            PG8_STAGE(PG8_SB(0, 1), b2 + hstep, voffB);
            PG8_WAIT_V(6); PG8_BAR; PG8_MMA(1, 1, At, B1); PG8_BAR;
            PG8_LDB(B0, 1, 0); PG8_SCHED; PG8_LDA(At, 1, 0); PG8_STAGE(PG8_SA(0, 1), a2 + hstep, voffA);
            PG8_WAIT_L(8); PG8_BAR; PG8_WAIT_L(0); PG8_MMA(0, 0, At, B0); PG8_BAR; PG8_SCHED;
            PG8_LDB(B1, 1, 1); PG8_STAGE(PG8_SB(1, 0), b3, voffB);
            PG8_BAR; PG8_WAIT_L(0); PG8_MMA(0, 1, At, B1); PG8_BAR;
            PG8_LDA(At, 1, 1); PG8_STAGE(PG8_SA(1, 0), a3, voffA);
            PG8_BAR; PG8_WAIT_L(0); PG8_MMA(1, 0, At, B0); PG8_BAR; PG8_SCHED;
            PG8_STAGE(PG8_SB(1, 1), b3 + hstep, voffB);
            PG8_WAIT_V(6); PG8_BAR; PG8_MMA(1, 1, At, B1); PG8_BAR;
            }
        }
        if constexpr (FP8) asm volatile("s_nop 15\n\ts_nop 15" ::: "memory");
        if constexpr (ALIGN_EPI) { if (wr == 0) PG8_BAR; }
        if constexpr (!Epi::AFTER_DRAIN) { E(acc, cur, wr, wc, fr, fq); S.done(cur); }
        if (!has_next) break;
#pragma unroll
        for (int a = 0; a < 2; ++a)
#pragma unroll
            for (int b = 0; b < 2; ++b)
#pragma unroll
                for (int m = 0; m < 4; ++m)
#pragma unroll
                    for (int n = 0; n < 2; ++n) acc[a][b][m][n] = (f32x4){0.f, 0.f, 0.f, 0.f};
        cur = nxt; cA = nA; cB = nB; ++ui;
        if constexpr (ALIGN_EPI) { if (wr == 1) PG8_BAR; }
    }
    PG8_WAIT_V(0);
    if constexpr (!ALIGN_EPI) { if (wr == 0) PG8_BAR; }
    PG8_BAR;
    if constexpr (Epi::AFTER_DRAIN) { E.fused(acc, cur, wr, wc, fr, fq, lds, wid, lane); S.done(cur); }
#undef PG8_SA
#undef PG8_SB
#undef PG8_STAGE
#undef PG8_LDA
#undef PG8_LDB
#undef PG8_MMA
#undef PG8_LD8
#undef PG8_WAIT_V
#undef PG8_WAIT_L
#undef PG8_BAR
#undef PG8_SCHED
}
}

#ifndef PROBE
#define PROBE 0
#endif
#define LAS __attribute__((address_space(3)))
typedef unsigned short bf16;
typedef unsigned short u16;
typedef _Float16 h2v __attribute__((ext_vector_type(2)));
typedef short s2v __attribute__((ext_vector_type(2)));
typedef unsigned v4u __attribute__((ext_vector_type(4)));
typedef unsigned v2u __attribute__((ext_vector_type(2)));
typedef float f32x4 __attribute__((ext_vector_type(4)));
typedef float f32x16 __attribute__((ext_vector_type(16)));
typedef short bf16x8 __attribute__((ext_vector_type(8)));

constexpr int NB = 4, SEQ = 8192, NMETA = 16, TT = 8208, DM = 1024, NL = 2;
constexpr int MAINR = 32768, RREAL = 32784, RPAD = 33024;
constexpr int ZC = 3072, LC = 2048, FF = 4096;
constexpr int C_Q = 0, C_CKV = 512, C_QI = 768, C_KI = 1024, C_WI = 1088, C_R = 1152, C_K = 1664, C_V = 2176, C_XW = 2688, C_XA = 2752, C_XG = 2816, C_XV = 2976;
constexpr int TPAD = 8320;
constexpr float NORM_EPS = 1e-6f, GN_EPS = 64e-5f;
constexpr int NT = 512, NWAVES = 8;
constexpr int LDS_BYTES = 155648;

constexpr size_t MiB = 1u << 20;
constexpr size_t WS_CTL = 0, CTL_BYTES = 65536;
constexpr size_t WS_ROPE = 1 * MiB;
constexpr size_t WS_HX = 2 * MiB;
constexpr size_t WS_WIN = 4 * MiB, WS_WO = 16 * MiB, WS_WUP = 20 * MiB, WS_WDN = 36 * MiB;
constexpr size_t WS_KATT = 52 * MiB, WS_VATT = 57 * MiB, WS_KI = 62 * MiB;
constexpr size_t WS_VF = 67 * MiB;
constexpr size_t WS_U = 100 * MiB;
constexpr size_t WS_Z = 165 * MiB;
constexpr size_t WS_L = WS_Z + (size_t)RPAD * ZC * 2;
constexpr size_t WS_HID = WS_Z;
constexpr size_t WS_TMP2 = WS_HID + (size_t)RPAD * FF * 2;
constexpr size_t WS_HMID = WS_HID + (size_t)RPAD * FF;
static_assert(WS_HMID + (size_t)MAINR * DM * 2 <= WS_TMP2 && WS_HMID >= WS_Z + (size_t)RPAD * DM * 2, "ws map");
constexpr size_t WS_ACT = WS_L + (size_t)RPAD * LC * 2;
constexpr int ACTC = 320, OPSB = 16384;
constexpr size_t WS_OPS = WS_L, WS_WLT = 3 * MiB, WS_WKV = 3 * MiB + 768 * 1024;
constexpr size_t WS_END = WS_ACT + (size_t)RPAD * ACTC * 2;
static_assert((size_t)16 * 513 * OPSB <= (size_t)RPAD * LC * 2, "ops fits");
static_assert(WS_END <= 512 * MiB, "ws total");
static_assert(WS_TMP2 + (size_t)RPAD * DM * 2 <= WS_ACT, "ws map");
static_assert(WS_U + (size_t)RPAD * DM * 2 <= WS_Z, "ws map");
static_assert(WS_VF + (size_t)RPAD * 512 * 2 <= WS_U, "ws map");

struct Args { const float* in[30]; float* out; unsigned char* ws; int ph_lo, ph_hi; };

enum { I_X = 0, I_META, I_NMPRE, I_NMPOST, I_NFPRE, I_NFPOST, I_WIN, I_MU, I_KVN, I_WUK, I_WUV, I_IDXG, I_IDXB, I_W0, I_W2, I_A0, I_A2, I_G2,
       I_KK, I_KA, I_RK, I_LNW, I_LNB, I_WINV, I_MUV, I_V0, I_V2, I_WO, I_WUP, I_WDN };

__device__ __forceinline__ float bf2f(bf16 b) { return __uint_as_float((unsigned)b << 16); }
typedef float f32x2h __attribute__((ext_vector_type(2)));
typedef __bf16 bf16x2h __attribute__((ext_vector_type(2)));
__device__ __forceinline__ unsigned pk2(float lo, float hi) { const bf16x2h v = __builtin_convertvector((f32x2h){lo, hi}, bf16x2h); return __builtin_bit_cast(unsigned, v); }
constexpr float S8_X = 16.f, S8_WU = 256.f, S8_H = 4.f, S8_WD = 512.f;
constexpr int E8_X = 0x7b7b7b7b, E8_WU = 0x77777777, E8_H = 0x7d7d7d7d, E8_WD = 0x76767676;
__device__ __forceinline__ float sat8(float x) { return __builtin_amdgcn_fmed3f(x, -448.f, 448.f); }
__device__ __forceinline__ unsigned pk4_fp8(float a, float b, float c, float d) { int p = __builtin_amdgcn_cvt_pk_fp8_f32(sat8(a), sat8(b), 0, false); p = __builtin_amdgcn_cvt_pk_fp8_f32(sat8(c), sat8(d), p, true); return (unsigned)p; }
__device__ __forceinline__ unsigned f2bf(float f) { return (unsigned)__builtin_bit_cast(unsigned short, (__bf16)f); }
template <int CTRL> __device__ __forceinline__ float dpp_f(float v) { return __int_as_float(__builtin_amdgcn_update_dpp(0, __float_as_int(v), CTRL, 0xf, 0xf, true)); }
__device__ __forceinline__ float row16_sum(float v) { v += dpp_f<0xB1>(v); v += dpp_f<0x4E>(v); v += dpp_f<0x141>(v); v += dpp_f<0x140>(v); return v; }
__device__ __forceinline__ float quad_sum(float v) { v += dpp_f<0xB1>(v); v += dpp_f<0x4E>(v); return v; }
template <int CTRL, int RM> __device__ __forceinline__ unsigned dpp_u(unsigned v) { return (unsigned)__builtin_amdgcn_update_dpp(0, (int)v, CTRL, RM, 0xf, false); }
__device__ __forceinline__ unsigned wave_scan_incl(unsigned x) {
    x += dpp_u<0x111, 0xf>(x); x += dpp_u<0x112, 0xf>(x); x += dpp_u<0x114, 0xf>(x); x += dpp_u<0x118, 0xf>(x);
    x += dpp_u<0x142, 0xa>(x); x += dpp_u<0x143, 0xc>(x); return x; }
__device__ __forceinline__ unsigned lane_bcast(unsigned v, int srclane) { return (unsigned)__builtin_amdgcn_readlane((int)v, srclane); }
typedef unsigned u2v __attribute__((ext_vector_type(2)));
__device__ __forceinline__ float xor16_sum(float v) { const u2v r = __builtin_amdgcn_permlane16_swap(__float_as_uint(v), __float_as_uint(v), false, false); return __uint_as_float(r.x) + __uint_as_float(r.y); }
__device__ __forceinline__ float xor32_sum(float v) { const u2v r = __builtin_amdgcn_permlane32_swap(__float_as_uint(v), __float_as_uint(v), false, false); return __uint_as_float(r.x) + __uint_as_float(r.y); }
__device__ __forceinline__ float xor16_max(float v) { const u2v r = __builtin_amdgcn_permlane16_swap(__float_as_uint(v), __float_as_uint(v), false, false); return fmaxf(__uint_as_float(r.x), __uint_as_float(r.y)); }
__device__ __forceinline__ float xor32_max(float v) { const u2v r = __builtin_amdgcn_permlane32_swap(__float_as_uint(v), __float_as_uint(v), false, false); return fmaxf(__uint_as_float(r.x), __uint_as_float(r.y)); }
__device__ __forceinline__ float wave_sum(float v) { v = row16_sum(v); v = xor16_sum(v); v = xor32_sum(v); return v; }
__device__ __forceinline__ float wave_max(float v) {
#pragma unroll
    for (int o = 1; o < 64; o <<= 1) v = fmaxf(v, __shfl_xor(v, o));
    return v;
}
__device__ __forceinline__ int row_of(int b, int p) { return p < NMETA ? MAINR + p : b * SEQ + (p - NMETA); }
__device__ __forceinline__ float relu_i(float x) { const int xi = __float_as_int(x); return __int_as_float(xi > 0 ? xi : 0); }
__device__ __forceinline__ float sigmoidf_(float x) { return __builtin_amdgcn_rcpf(1.f + __expf(-x)); }

__device__ __forceinline__ int lane_now() { int l; asm volatile("v_mbcnt_lo_u32_b32 %0, -1, 0\n\tv_mbcnt_hi_u32_b32 %0, -1, %0" : "=v"(l)); return l; }
__device__ __forceinline__ int launder2() { int n = 2; asm volatile("" : "+s"(n)); return n; }
struct Ctx {
    const float* const* in; float* out; unsigned char* ws;
    LAS unsigned char* lds; int tid, lane, wid, G, bid; int ppass;
    __device__ __forceinline__ const float* I(int i) const { return in[i]; }
    __device__ __forceinline__ bf16* Z() const { return (bf16*)(ws + WS_Z); }
    __device__ __forceinline__ bf16* ACT() const { return (bf16*)(ws + WS_ACT); }
    __device__ __forceinline__ bf16* WLT() const { return (bf16*)(ws + WS_WLT); }
    __device__ __forceinline__ bf16* U() const { return (bf16*)(ws + WS_U); }
    __device__ __forceinline__ bf16* VF() const { return (bf16*)(ws + WS_VF); }
    __device__ __forceinline__ bf16* KATT() const { return (bf16*)(ws + WS_KATT); }
    __device__ __forceinline__ bf16* VATT() const { return (bf16*)(ws + WS_VATT); }
    __device__ __forceinline__ bf16* KI() const { return (bf16*)(ws + WS_KI); }
    __device__ __forceinline__ float* HX() const { return (float*)(ws + WS_HX); }
    __device__ __forceinline__ float* COS() const { return (float*)(ws + WS_ROPE); }
    __device__ __forceinline__ float* SIN() const { return (float*)(ws + WS_ROPE) + TT * 8; }
    __device__ __forceinline__ unsigned* CTL() const { return (unsigned*)(ws + WS_CTL); }
};

template <class Src, bool FRAG = false>
__device__ __forceinline__ void transpose_item(const Src& src, bf16* WT, int K, int k0, int n0, LAS float* scr, int lane) {
#pragma unroll
    for (int i = 0; i < 8; ++i) { const int kk = 8 * i + (lane >> 3), nn = 4 * (lane & 7); const f32x4 v = src.v4(k0 + kk, n0 + nn);
        scr[kk * 33 + nn] = v.x; scr[kk * 33 + nn + 1] = v.y; scr[kk * 33 + nn + 2] = v.z; scr[kk * 33 + nn + 3] = v.w; }
    asm volatile("s_waitcnt lgkmcnt(0)" ::: "memory");
    const int c = lane & 7;
#pragma unroll
    for (int j = 0; j < 4; ++j) { const int n = (lane >> 3) + 8 * j; const LAS float* s = scr + (8 * c) * 33 + n;
        v4u o; o.x = pk2(s[0 * 33], s[1 * 33]); o.y = pk2(s[2 * 33], s[3 * 33]); o.z = pk2(s[4 * 33], s[5 * 33]); o.w = pk2(s[6 * 33], s[7 * 33]);
        if (FRAG) { const int ch = n0 + n, kq = (k0 >> 3) + c; *(v4u*)(WT + (size_t)((((ch >> 6) * 4 + (ch & 3)) * 10 + (kq >> 2)) * 64 + (kq & 3) * 16 + ((ch & 63) >> 2)) * 8) = o; }
        else *(v4u*)(WT + (size_t)(n0 + n) * K + k0 + 8 * c) = o; }
    asm volatile("s_waitcnt lgkmcnt(0)" ::: "memory");
}
template <class Src>
__device__ __forceinline__ void transpose_item8(const Src& src, unsigned char* WT, int K, int k0, int n0, LAS float* scr, int lane, float mul) {
#pragma unroll
    for (int i = 0; i < 8; ++i) { const int kk = 8 * i + (lane >> 3), nn = 4 * (lane & 7); const f32x4 v = src.v4(k0 + kk, n0 + nn);
        scr[kk * 33 + nn] = v.x; scr[kk * 33 + nn + 1] = v.y; scr[kk * 33 + nn + 2] = v.z; scr[kk * 33 + nn + 3] = v.w; }
    asm volatile("s_waitcnt lgkmcnt(0)" ::: "memory");
    const int c = lane & 7;
#pragma unroll
    for (int j = 0; j < 4; ++j) { const int n = (lane >> 3) + 8 * j; const LAS float* s = scr + (8 * c) * 33 + n;
        v2u o; o.x = pk4_fp8(s[0 * 33] * mul, s[1 * 33] * mul, s[2 * 33] * mul, s[3 * 33] * mul); o.y = pk4_fp8(s[4 * 33] * mul, s[5 * 33] * mul, s[6 * 33] * mul, s[7 * 33] * mul);
        *(v2u*)(WT + (size_t)(n0 + n) * K + k0 + 8 * c) = o; }
    asm volatile("s_waitcnt lgkmcnt(0)" ::: "memory");
}
struct SrcKV { const float* wk; const float* wv;
    __device__ __forceinline__ f32x4 v4(int k, int n) const { return n < 64 ? *(const f32x4*)(wk + (size_t)k * 64 + n) : *(const f32x4*)(wv + (size_t)k * 64 + n - 64); } };
struct SrcLora { const float* w2; const float* a2; const float* g2; const float* v2; int has_v;
    __device__ __forceinline__ f32x4 v4(int k, int n) const {
        if (k < 64) return *(const f32x4*)(w2 + (size_t)k * 512 + n);
        if (k < 128) return *(const f32x4*)(a2 + (size_t)(k - 64) * 512 + n);
        if (k < 288) return *(const f32x4*)(g2 + (size_t)(k - 128) * 512 + n);
        return has_v ? *(const f32x4*)(v2 + (size_t)(k - 288) * 512 + n) : (f32x4){0.f, 0.f, 0.f, 0.f}; } };
struct SrcPlain { const float* W; int ldw; __device__ __forceinline__ f32x4 v4(int k, int n) const { return *(const f32x4*)(W + (size_t)k * ldw + n); } };
struct SrcWin { const float* W; const float* Wv; int has_v;
    __device__ __forceinline__ f32x4 v4(int k, int n) const {
        if (n < 1092) return *(const f32x4*)(W + (size_t)k * 2916 + n);
        if (n >= C_R && n < C_XV) return *(const f32x4*)(W + (size_t)k * 2916 + 1092 + (n - C_R));
        if (n >= C_XV && n < C_XV + 32 && has_v) return *(const f32x4*)(Wv + (size_t)k * 32 + (n - C_XV));
        return (f32x4){0.f, 0.f, 0.f, 0.f}; } };

__device__ __forceinline__ void phase_prologue(const Ctx& C) {
    LAS float* scr = (LAS float*)(C.lds + C.wid * 16384);
    const int gw = C.bid * NWAVES + C.wid, NGW = C.G * NWAVES;
    constexpr int IT_WIN = 16 * 96, IT_WO = 16 * 32, IT_WUP = 16 * 128, IT_WDN = 64 * 32, IT_L = IT_WIN + IT_WO + IT_WUP + IT_WDN;
    for (int it = gw; it < 2 * IT_L; it += NGW) {
        const int l = it / IT_L; int r = it % IT_L;
        if (r < IT_WIN) { SrcWin s{C.I(I_WIN) + (size_t)l * 1024 * 2916, C.I(I_WINV), l == 1}; const int kb = r / 96, nb = r % 96;
            transpose_item(s, (bf16*)(C.ws + WS_WIN) + (size_t)l * ZC * 1024, 1024, 64 * kb, 32 * nb, scr, C.lane); continue; } r -= IT_WIN;
        if (r < IT_WO) { SrcPlain s{C.I(I_WO) + (size_t)l * 1024 * 1024, 1024}; const int kb = r / 32, nb = r % 32;
            transpose_item(s, (bf16*)(C.ws + WS_WO) + (size_t)l * 1024 * 1024, 1024, 64 * kb, 32 * nb, scr, C.lane); continue; } r -= IT_WO;
        if (r < IT_WUP) { SrcPlain s{C.I(I_WUP) + (size_t)l * 1024 * 4096, 4096}; const int kb = r / 128, nb = r % 128;
            transpose_item8(s, C.ws + WS_WUP + (size_t)l * 4096 * 1024, 1024, 64 * kb, 32 * nb, scr, C.lane, S8_WU); continue; } r -= IT_WUP;
        { SrcPlain s{C.I(I_WDN) + (size_t)l * 4096 * 1024, 1024}; const int kb = r / 32, nb = r % 32;
            transpose_item8(s, C.ws + WS_WDN + (size_t)l * 1024 * 4096, 4096, 64 * kb, 32 * nb, scr, C.lane, S8_WD); }
    }
    for (int it = gw; it < 2 * 16; it += NGW) { const int l = it / 16, r = it % 16, kb = r / 4, nb = r % 4;
        SrcKV s{C.I(I_WUK) + (size_t)l * 256 * 64, C.I(I_WUV) + (size_t)l * 256 * 64};
        transpose_item(s, (bf16*)(C.ws + WS_WKV) + (size_t)l * 128 * 256, 256, 64 * kb, 32 * nb, scr, C.lane); }
    for (int it = gw; it < 2 * 80; it += NGW) { const int l = it / 80, r = it % 80, kb = r / 16, nb = r % 16;
        SrcLora s{C.I(I_W2) + (size_t)l * 64 * 512, C.I(I_A2) + (size_t)l * 64 * 512, C.I(I_G2) + (size_t)l * 160 * 512, C.I(I_V2), l == 1};
        transpose_item<SrcLora, true>(s, C.WLT() + (size_t)l * 512 * ACTC, ACTC, 64 * kb, 32 * nb, scr, C.lane); }
    const int gt = C.bid * NT + C.tid, NGT = C.G * NT;
    for (int i = gt; i < TT * 8; i += NGT) {
        const int p = i >> 3, f = i & 7;
        const float invf = powf(500000.0f, -(float)(2 * f) / 16.0f);
        const float ang = (float)p * invf;
        const double ad = (double)ang; const double n = rint(ad * 0.15915494309189535); const float rr = (float)(ad - n * 6.283185307179586);
        C.COS()[i] = cosf(rr); C.SIN()[i] = sinf(rr);
    }
    for (int i = gt; i < 256 * DM; i += NGT) C.HX()[i] = (i < NMETA * DM) ? C.I(I_META)[i] : 0.f;
}

template <bool HIN16, bool HOUT16>
__device__ __forceinline__ void phase_norm(const Ctx& C, const void* hin_main, void* hout_main, const bf16* tmp, const float* g_post, const float* g_next, const float* hx_in = nullptr, const bool out8 = false) {
    const int gw = C.bid * NWAVES + C.wid, NGW = C.G * NWAVES; const int lane = C.lane;
    constexpr int NR = 2;
    for (int row0 = gw; row0 < RPAD; row0 += NR * NGW) {
        f32x4 h[NR][4]; v2u tw[NR][4];
#pragma unroll
        for (int u = 0; u < NR; ++u) { const int row = row0 + u * NGW; if (row >= RREAL) continue;
            const bool mainrow = row < MAINR;
            if (HIN16 && mainrow) {
#pragma unroll
                for (int j = 0; j < 4; ++j) { const v2u w = *(const v2u*)((const bf16*)hin_main + (size_t)row * DM + lane * 4 + 256 * j);
                    h[u][j] = (f32x4){__uint_as_float(w.x << 16), __uint_as_float(w.x & 0xffff0000u), __uint_as_float(w.y << 16), __uint_as_float(w.y & 0xffff0000u)}; }
            } else {
                const float* hp = mainrow ? (const float*)hin_main + (size_t)row * DM : (hx_in ? hx_in : (const float*)C.HX()) + (size_t)(row - MAINR) * DM;
#pragma unroll
                for (int j = 0; j < 4; ++j) h[u][j] = *(const f32x4*)(hp + lane * 4 + 256 * j);
            }
            if (tmp) {
#pragma unroll
                for (int j = 0; j < 4; ++j) tw[u][j] = *(const v2u*)(tmp + (size_t)row * DM + lane * 4 + 256 * j); }
        }
#pragma unroll
        for (int u = 0; u < NR; ++u) { const int row = row0 + u * NGW; if (row >= RPAD) continue;
            bf16* urow = C.U() + (size_t)row * DM;
            if (row >= RREAL) { if (g_next && !out8) {
#pragma unroll
                    for (int j = 0; j < 4; ++j) *(v2u*)(urow + lane * 4 + 256 * j) = (v2u){0u, 0u}; }
                continue; }
            const bool mainrow = row < MAINR;
            if (tmp) {
                f32x4 t[4]; float ss = 0.f;
#pragma unroll
                for (int j = 0; j < 4; ++j) { const v2u w = tw[u][j];
                    t[j] = (f32x4){__uint_as_float(w.x << 16), __uint_as_float(w.x & 0xffff0000u), __uint_as_float(w.y << 16), __uint_as_float(w.y & 0xffff0000u)};
                    ss += (t[j].x * t[j].x + t[j].y * t[j].y) + (t[j].z * t[j].z + t[j].w * t[j].w); }
                const float rstd = __builtin_amdgcn_rsqf(wave_sum(ss) * (1.f / DM) + NORM_EPS);
#pragma unroll
                for (int j = 0; j < 4; ++j) { const f32x4 g = *(const f32x4*)(g_post + lane * 4 + 256 * j); h[u][j] = h[u][j] + t[j] * rstd * g;
                    if (HOUT16 && mainrow) *(v2u*)((bf16*)hout_main + (size_t)row * DM + lane * 4 + 256 * j) = (v2u){pk2(h[u][j].x, h[u][j].y), pk2(h[u][j].z, h[u][j].w)};
                    else { float* ho = mainrow ? (float*)hout_main + (size_t)row * DM : C.HX() + (size_t)(row - MAINR) * DM; *(f32x4*)(ho + lane * 4 + 256 * j) = h[u][j]; } }
            }
            if (g_next) {
                float ss = 0.f;
#pragma unroll
                for (int j = 0; j < 4; ++j) ss += (h[u][j].x * h[u][j].x + h[u][j].y * h[u][j].y) + (h[u][j].z * h[u][j].z + h[u][j].w * h[u][j].w);
                const float rstd = __builtin_amdgcn_rsqf(wave_sum(ss) * (1.f / DM) + NORM_EPS);
#pragma unroll
                for (int j = 0; j < 4; ++j) { const f32x4 g = *(const f32x4*)(g_next + lane * 4 + 256 * j); const f32x4 y = h[u][j] * rstd * g;
                    if (out8) *(unsigned*)((unsigned char*)C.U() + (size_t)row * DM + lane * 4 + 256 * j) = pk4_fp8(y.x * S8_X, y.y * S8_X, y.z * S8_X, y.w * S8_X);
                    else *(v2u*)(urow + lane * 4 + 256 * j) = (v2u){pk2(y.x, y.y), pk2(y.z, y.w)}; }
            }
        }
    }
}

typedef short s16x4 __attribute__((ext_vector_type(4)));
constexpr int SLOT = 18432;
constexpr int O_W = 0, O_R = 2048, O_BK = 4096, O_ARK = 8192, O_TA = 9216, O_GAM = 9728, O_VT = 10240, O_TMP = 12288, O_B = 12288, O_K = 14336, O_AT = 16384;
constexpr int OPS_SH = 10240, OPS_VT = 10240, OPS_G = 12288, OPS_BG = 14336;
constexpr int NCHUNK = TT / 16;
__device__ __forceinline__ bf16x8 cat8(s16x4 a, s16x4 b) { return __builtin_shufflevector(a, b, 0, 1, 2, 3, 4, 5, 6, 7); }
__device__ __forceinline__ s16x4 pack4(f32x4 v) { v2u w = (v2u){pk2(v.x, v.y), pk2(v.z, v.w)}; return __builtin_bit_cast(s16x4, w); }
__device__ __forceinline__ s16x4 pack4f(float a, float b, float c, float d) { v2u w = (v2u){pk2(a, b), pk2(c, d)}; return __builtin_bit_cast(s16x4, w); }
__device__ __forceinline__ f32x4 mfma16(bf16x8 a, bf16x8 b, f32x4 c) { return __builtin_amdgcn_mfma_f32_16x16x32_bf16(a, b, c, 0, 0, 0); }
__device__ __forceinline__ void unpack4(v2u w, float (&o)[4]) { o[0] = __uint_as_float(w.x << 16); o[1] = __uint_as_float(w.x & 0xffff0000u); o[2] = __uint_as_float(w.y << 16); o[3] = __uint_as_float(w.y & 0xffff0000u); }


struct PostLd { unsigned short q1, q2, qi1, qi2, ki, a0, a1, a2, a3, a4; v2u ckv; float cs, sn; };
__device__ __forceinline__ void post_load(const Ctx& C, int l, int row, int lane, PostLd& o) {
    const int p = row < MAINR ? NMETA + (row & 8191) : row - MAINR;
    const bf16* z = C.Z() + (size_t)row * ZC;
    const int hh = lane >> 3, i = lane & 7;
    o.cs = C.COS()[p * 8 + i]; o.sn = C.SIN()[p * 8 + i];
    o.q1 = z[C_Q + hh * 64 + i]; o.q2 = z[C_Q + hh * 64 + 8 + i];
    o.qi1 = z[C_QI + (hh & 3) * 64 + i]; o.qi2 = z[C_QI + (hh & 3) * 64 + 8 + i];
    o.ki = z[C_KI + lane];
    o.ckv = *(const v2u*)(z + C_CKV + lane * 4);
    o.a0 = z[C_XW + lane]; o.a1 = z[C_XA + lane]; o.a2 = z[C_XG + lane]; o.a3 = z[C_XG + 64 + lane];
    o.a4 = lane < 32 ? z[C_XG + 128 + lane] : (l == 1 ? z[C_XV + lane - 32] : (unsigned short)0);
}
__device__ __forceinline__ float shiftf(unsigned short a_, unsigned short p_, float mu) { const float a = bf2f(a_), pr = bf2f(p_); return a + (pr - a) * mu; }
__device__ __forceinline__ void post_compute(const Ctx& C, int l, int row, int lane, const PostLd& d, const unsigned short (&pv)[5], const float (&mu)[5], const f32x4 kvg, const float ig, const float ib, LAS unsigned char* cl) {
    int b, p; if (row < MAINR) { b = row >> 13; p = NMETA + (row & 8191); } else { b = -1; p = row - MAINR; }
    bf16* z = C.Z() + (size_t)row * ZC;
    const int hh = lane >> 3, i = lane & 7; const float c = d.cs, s = d.sn;
    { const float t1 = bf2f(d.q1), t2 = bf2f(d.q2);
      z[C_Q + hh * 64 + i] = (bf16)f2bf(t1 * c - t2 * s); z[C_Q + hh * 64 + 8 + i] = (bf16)f2bf(t2 * c + t1 * s); }
    if (lane < 32) { const float t1 = bf2f(d.qi1), t2 = bf2f(d.qi2);
      z[C_QI + hh * 64 + i] = (bf16)f2bf(t1 * c - t2 * s); z[C_QI + hh * 64 + 8 + i] = (bf16)f2bf(t2 * c + t1 * s); }
    {
        const float x = bf2f(d.ki);
        const float mu_ = wave_sum(x) * (1.f / 64.f); const float dd = x - mu_; const float var = wave_sum(dd * dd) * (1.f / 64.f);
        float y = dd * __builtin_amdgcn_rsqf(var + NORM_EPS) * ig + ib;
        const float o = dpp_f<0x128>(y);
        if (lane < 8) y = y * c - o * s; else if (lane < 16) y = y * c + o * s;
        const bf16 yb = (bf16)f2bf(y);
        const size_t ko = ((size_t)((p >> 5) * 4 + (lane >> 4)) * 64 + ((lane >> 3) & 1) * 32 + (p & 31)) * 8 + (lane & 7);
        if (b >= 0) C.KI()[(size_t)b * TPAD * 64 + ko] = yb;
        else {
#pragma unroll
            for (int bb = 0; bb < NB; ++bb) C.KI()[(size_t)bb * TPAD * 64 + ko] = yb; }
    }
    {
        const v2u w = d.ckv;
        f32x4 x = (f32x4){__uint_as_float(w.x << 16), __uint_as_float(w.x & 0xffff0000u), __uint_as_float(w.y << 16), __uint_as_float(w.y & 0xffff0000u)};
        const float ms = wave_sum((x.x * x.x + x.y * x.y) + (x.z * x.z + x.w * x.w)) * (1.f / 256.f);
        const float rstd = __builtin_amdgcn_rsqf(ms + NORM_EPS);
        x = x * rstd * kvg;
        *(LAS v2u*)((LAS unsigned char*)cl + lane * 8) = (v2u){pk2(x.x, x.y), pk2(x.z, x.w)};
    }
    bf16* ar = C.ACT() + (size_t)(row >> 4) * (16 * ACTC) + ((lane >> 3) * 16 + (row & 15)) * 8 + (lane & 7);
    const float x0 = shiftf(d.a0, pv[0], mu[0]); ar[0] = (bf16)f2bf(2.f * sigmoidf_(2.f * x0) - 1.f);
    ar[1024] = (bf16)f2bf(shiftf(d.a1, pv[1], mu[1]));
    ar[2048] = (bf16)f2bf(sigmoidf_(shiftf(d.a2, pv[2], mu[2])));
    ar[3072] = (bf16)f2bf(sigmoidf_(shiftf(d.a3, pv[3], mu[3])));
    float x4;
    if (lane < 32) x4 = sigmoidf_(shiftf(d.a4, pv[4], mu[4])); else x4 = l == 1 ? shiftf(d.a4, pv[4], mu[4]) : 0.f;
    ar[4096] = (bf16)f2bf(x4);
}
constexpr int CLP = 528;
constexpr int PW_ACT = 16 * CLP, PW_KI = PW_ACT + 5120, PW_BYTES = PW_KI + 2048;
__device__ __forceinline__ void post_compute_f(const Ctx& C, int l, int row, int rr, int lane, const PostLd& d, const unsigned short (&pv)[5], const float (&mu)[5], const f32x4 kvg, const float ig, const float ib, LAS unsigned char* W) {
    bf16* z = C.Z() + (size_t)row * ZC;
    const int hh = lane >> 3, i = lane & 7; const float c = d.cs, s = d.sn; const bool odd = lane & 1;
    { const float t1 = bf2f(d.q1), t2 = bf2f(d.q2); const float a1 = t1 * c - t2 * s, a2 = t2 * c + t1 * s;
      const float x1 = dpp_f<0xB1>(a1), x2 = dpp_f<0xB1>(a2);
      *(unsigned*)(z + C_Q + hh * 64 + (odd ? 8 + i - 1 : i)) = odd ? pk2(x2, a2) : pk2(a1, x1); }
    { const float t1 = bf2f(d.qi1), t2 = bf2f(d.qi2); const float a1 = t1 * c - t2 * s, a2 = t2 * c + t1 * s;
      const float x1 = dpp_f<0xB1>(a1), x2 = dpp_f<0xB1>(a2);
      if (lane < 32) *(unsigned*)(z + C_QI + hh * 64 + (odd ? 8 + i - 1 : i)) = odd ? pk2(x2, a2) : pk2(a1, x1); }
    {
        const float x = bf2f(d.ki);
        const float mu_ = wave_sum(x) * (1.f / 64.f); const float dd = x - mu_; const float var = wave_sum(dd * dd) * (1.f / 64.f);
        float y = dd * __builtin_amdgcn_rsqf(var + NORM_EPS) * ig + ib;
        const float o = dpp_f<0x128>(y);
        if (lane < 8) y = y * c - o * s; else if (lane < 16) y = y * c + o * s;
        *(LAS bf16*)(W + PW_KI + (((lane >> 3) * 16 + rr) * 8 + (lane & 7)) * 2) = (bf16)f2bf(y);
    }
    {
        const v2u w = d.ckv;
        f32x4 x = (f32x4){__uint_as_float(w.x << 16), __uint_as_float(w.x & 0xffff0000u), __uint_as_float(w.y << 16), __uint_as_float(w.y & 0xffff0000u)};
        const float ms = wave_sum((x.x * x.x + x.y * x.y) + (x.z * x.z + x.w * x.w)) * (1.f / 256.f);
        const float rstd = __builtin_amdgcn_rsqf(ms + NORM_EPS);
        x = x * rstd * kvg;
        *(LAS v2u*)(W + rr * CLP + lane * 8) = (v2u){pk2(x.x, x.y), pk2(x.z, x.w)};
    }
    LAS bf16* ar = (LAS bf16*)(W + PW_ACT) + ((lane >> 3) * 8 + (rr & 7)) * 8 + (lane & 7);
    const float x0 = shiftf(d.a0, pv[0], mu[0]); ar[0] = (bf16)f2bf(2.f * sigmoidf_(2.f * x0) - 1.f);
    ar[512] = (bf16)f2bf(shiftf(d.a1, pv[1], mu[1]));
    ar[1024] = (bf16)f2bf(sigmoidf_(shiftf(d.a2, pv[2], mu[2])));
    ar[1536] = (bf16)f2bf(sigmoidf_(shiftf(d.a3, pv[3], mu[3])));
    float x4;
    if (lane < 32) x4 = sigmoidf_(shiftf(d.a4, pv[4], mu[4])); else x4 = l == 1 ? shiftf(d.a4, pv[4], mu[4]) : 0.f;
    ar[2048] = (bf16)f2bf(x4);
}
__device__ __forceinline__ void phase_post(const Ctx& C, int l, bool doA) {
    int lane_ = lane_now(); const int lane = lane_, g = lane >> 4, cc = lane & 15;
    const int gw = C.bid * NWAVES + C.wid, NGW = C.G * NWAVES;
    const float* mup = C.I(I_MU) + l * 1824;
    const float mu[5] = {mup[1536 + lane], mup[1600 + lane], mup[1664 + lane], mup[1728 + lane], lane < 32 ? mup[1792 + lane] : (l == 1 ? C.I(I_MUV)[lane - 32] : 0.f)};
    const f32x4 kvg = *(const f32x4*)(C.I(I_KVN) + l * 256 + lane * 4); const float ig = C.I(I_IDXG)[l * 64 + lane], ib = C.I(I_IDXB)[l * 64 + lane];
    const bf16* wkv = (const bf16*)(C.ws + WS_WKV) + (size_t)l * 128 * 256 + (size_t)cc * 256 + 8 * g;
#define POST_PREV(prow_, has_, pv_) do { const bf16* zp_ = C.Z() + (size_t)(prow_) * ZC; \
        pv_[0] = zp_[C_XW + lane]; pv_[1] = zp_[C_XA + lane]; pv_[2] = zp_[C_XG + lane]; pv_[3] = zp_[C_XG + 64 + lane]; pv_[4] = lane < 32 ? zp_[C_XG + 128 + lane] : (l == 1 ? zp_[C_XV + lane - 32] : (unsigned short)0); \
        if (!(has_)) { pv_[0] = 0; pv_[1] = 0; pv_[2] = 0; pv_[3] = 0; pv_[4] = 0; } } while (0)
#define POST_NEXT(pv_, d_) do { pv_[0] = d_.a0; pv_[1] = d_.a1; pv_[2] = d_.a2; pv_[3] = d_.a3; pv_[4] = d_.a4; } while (0)
#define POST_KV(row0_, cl_) do { const int kvrow0 = (row0_); \
        bf16x8 Af[8]; \
        _Pragma("unroll") for (int ks = 0; ks < 8; ++ks) Af[ks] = *(const LAS bf16x8*)((cl_) + cc * CLP + (32 * ks + 8 * g) * 2); \
        const bool ismeta = kvrow0 >= MAINR; const int bq = ismeta ? 0 : kvrow0 >> 13; const int pb = ismeta ? kvrow0 - MAINR : NMETA + (kvrow0 & 8191); \
        _Pragma("unroll 2") for (int nt = 0; nt < 8; ++nt) { \
            bf16x8 Bf[8]; \
            _Pragma("unroll") for (int ks = 0; ks < 8; ++ks) Bf[ks] = *(const bf16x8*)(wkv + (size_t)nt * 16 * 256 + 32 * ks); \
            f32x4 acc = (f32x4){0.f, 0.f, 0.f, 0.f}; \
            _Pragma("unroll") for (int ks = 0; ks < 8; ++ks) acc = mfma16(Af[ks], Bf[ks], acc); \
            bf16* dst = (nt < 4 ? C.KATT() : C.VATT()) + (nt & 3) * 16 + cc; \
            _Pragma("unroll") for (int r = 0; r < 4; ++r) { const int p = pb + 4 * g + r; float v = acc[r]; \
                if (nt == 0) { const float o = dpp_f<0x128>(v); const float cs = C.COS()[p * 8 + (cc & 7)], sn = C.SIN()[p * 8 + (cc & 7)]; v = cc < 8 ? v * cs - o * sn : v * cs + o * sn; } \
                const bf16 vb = (bf16)f2bf(v); \
                if (!ismeta) dst[((size_t)bq * TPAD + p) * 64] = vb; \
                else { _Pragma("unroll") for (int bb = 0; bb < NB; ++bb) dst[((size_t)bb * TPAD + p) * 64] = vb; } } } } while (0)
    LAS unsigned char* W = C.lds + C.wid * PW_BYTES;
    for (int grp = gw; grp < MAINR / 16; grp += NGW) {
        const int row0 = grp * 16, bq = row0 >> 13, pb = NMETA + (row0 & 8191);
        unsigned short pv[5];
        { const int s0 = row0 & 8191; POST_PREV(s0 == 0 ? MAINR + 15 : row0 - 1, true, pv); }
        PostLd d0, d1; post_load(C, l, row0, lane, d0);
#pragma unroll 1
        for (int rr = 0; rr < 16; rr += 2) {
            post_load(C, l, row0 + rr + 1, lane, d1);
            post_compute_f(C, l, row0 + rr, rr, lane, d0, pv, mu, kvg, ig, ib, W); POST_NEXT(pv, d0);
            if (rr + 2 < 16) post_load(C, l, row0 + rr + 2, lane, d0);
            post_compute_f(C, l, row0 + rr + 1, rr + 1, lane, d1, pv, mu, kvg, ig, ib, W); POST_NEXT(pv, d1);
            if ((rr & 7) == 6) {
                asm volatile("s_waitcnt lgkmcnt(0)" ::: "memory");
                bf16* ag = C.ACT() + (size_t)grp * (16 * ACTC) + (rr & 8) * 8;
#pragma unroll
                for (int it = 0; it < 5; ++it) { const int q = it * 64 + lane; *(v4u*)(ag + ((q >> 3) * 16 + (q & 7)) * 8) = *(const LAS v4u*)(W + PW_ACT + q * 16); }
                asm volatile("s_waitcnt lgkmcnt(0)" ::: "memory");
            }
        }
        {
            bf16* kg = C.KI() + (size_t)bq * TPAD * 64;
#pragma unroll
            for (int it = 0; it < 2; ++it) { const int q = it * 64 + lane, d8 = q >> 4, r = q & 15;
                *(v4u*)(kg + ((size_t)((pb >> 5) * 4 + (d8 >> 1)) * 64 + (d8 & 1) * 32 + (pb & 31) + r) * 8) = *(const LAS v4u*)(W + PW_KI + q * 16); }
        }
        {
            bf16x8 Af[8];
#pragma unroll
            for (int ks = 0; ks < 8; ++ks) Af[ks] = *(const LAS bf16x8*)(W + cc * CLP + (32 * ks + 8 * g) * 2);
            _Pragma("unroll 2") for (int nt = 0; nt < 8; ++nt) {
                bf16x8 Bf[8];
#pragma unroll
                for (int ks = 0; ks < 8; ++ks) Bf[ks] = *(const bf16x8*)(wkv + (size_t)nt * 16 * 256 + 32 * ks);
                f32x4 acc = (f32x4){0.f, 0.f, 0.f, 0.f};
#pragma unroll
                for (int ks = 0; ks < 8; ++ks) acc = mfma16(Af[ks], Bf[ks], acc);
#pragma unroll
                for (int r = 0; r < 4; ++r) { const int p = pb + 4 * g + r; float v = acc[r];
                    if (nt == 0) { const float o = dpp_f<0x128>(v); const float cs = C.COS()[p * 8 + (cc & 7)], sn = C.SIN()[p * 8 + (cc & 7)]; v = cc < 8 ? v * cs - o * sn : v * cs + o * sn; }
                    *(LAS bf16*)(W + PW_ACT + (nt < 4 ? 0 : 2048) + ((4 * g + r) * 64 + (nt & 3) * 16 + cc) * 2) = (bf16)f2bf(v); } }
            asm volatile("s_waitcnt lgkmcnt(0)" ::: "memory");
#pragma unroll
            for (int it = 0; it < 4; ++it) { const int q = it * 64 + lane;
                bf16* dst = (q < 128 ? C.KATT() : C.VATT()) + ((size_t)bq * TPAD + pb) * 64 + (q & 127) * 8;
                *(v4u*)dst = *(const LAS v4u*)(W + PW_ACT + q * 16); }
            asm volatile("s_waitcnt lgkmcnt(0)" ::: "memory");
        }
    }
    if (C.bid == C.G - 1) {
        LAS unsigned char* clm = C.lds + NWAVES * PW_BYTES;
        const int r0 = MAINR + 2 * C.wid;
        unsigned short pv[5]; POST_PREV(r0 == MAINR ? r0 : r0 - 1, r0 != MAINR, pv);
        PostLd d0, d1; post_load(C, l, r0, lane, d0); post_load(C, l, r0 + 1, lane, d1);
        post_compute(C, l, r0, lane, d0, pv, mu, kvg, ig, ib, clm + (2 * C.wid) * CLP); POST_NEXT(pv, d0);
        post_compute(C, l, r0 + 1, lane, d1, pv, mu, kvg, ig, ib, clm + (2 * C.wid + 1) * CLP);
        asm volatile("s_waitcnt lgkmcnt(0)" ::: "memory");
        __syncthreads();
        if (C.wid == 0) POST_KV(MAINR, clm);
    }
#undef POST_PREV
#undef POST_NEXT
#undef POST_KV
}

__device__ __forceinline__ void prep_copy(LAS unsigned char* sl, unsigned char* ops, int lane) {
#pragma unroll
    for (int i = 0; i < 12; ++i) *(v4u*)(ops + (i * 64 + lane) * 16) = *(const LAS v4u*)(sl + (i * 64 + lane) * 16);
    asm volatile("s_waitcnt lgkmcnt(0)" ::: "memory");
}
template <bool SHARED>
__device__ __forceinline__ unsigned char* prep_unit(const Ctx& C, int l, int bh, int bhl, int cidx, LAS unsigned char* sl, unsigned char* prev_ops) {
    int lane_ = lane_now(); const int lane = lane_, g = lane >> 4, c = lane & 15;
    const int b = bh >> 3, h = bh & 7;
    const int row0 = cidx == 0 ? MAINR : b * SEQ + 16 * (cidx - 1);
    const bf16x8 zero8 = (bf16x8){0, 0, 0, 0, 0, 0, 0, 0};
    const f32x4 z4 = (f32x4){0.f, 0.f, 0.f, 0.f};
    f32x4 aw[4], aa[4], ag[4], av[4];
    const int ch0 = h * 64 + 4 * c;
    const bf16* zb = C.Z() + C_R + ch0;
    v2u wr[4], wk[4], wv[4], wf[4], pwr, pwk, pwv;
    const bf16* act = C.ACT() + (size_t)(row0 >> 4) * (16 * ACTC) + lane * 8;
    const bf16* wl = C.WLT() + (size_t)l * 512 * ACTC + (size_t)(h * 4) * (10 * 512) + lane * 8;
    bf16x8 Af[10], BfA[10], BfB[10];
#define PREP_LDB(Bf, n) do { if (SHARED) { _Pragma("unroll") for (int ks = 0; ks < 10; ++ks) Bf[ks] = *(const LAS bf16x8*)(C.lds + (((n) * 10 + ks) * 64 + lane) * 16); } \
        else { _Pragma("unroll") for (int ks = 0; ks < 10; ++ks) Bf[ks] = *(const bf16x8*)(wl + ((n) * 10 + ks) * 512); } } while (0)
#define PREP_MM(Bf, n) do { aw[n] = mfma16(Af[1], Bf[1], mfma16(Af[0], Bf[0], z4)); aa[n] = mfma16(Af[3], Bf[3], mfma16(Af[2], Bf[2], z4)); \
        { f32x4 t = z4; _Pragma("unroll") for (int ks = 4; ks < 9; ++ks) t = mfma16(Af[ks], Bf[ks], t); ag[n] = t; } av[n] = mfma16(Af[9], Bf[9], z4); } while (0)
    if (SHARED) {
        __syncthreads();
#pragma unroll
        for (int i = 0; i < 5; ++i) { const int blk = C.wid + 8 * i;
            __builtin_amdgcn_global_load_lds((const unsigned*)(wl - lane * 8 + blk * 512 + lane * 8), (LAS unsigned*)(C.lds + blk * 1024), 16, 0, 0); }
    }
#pragma unroll
    for (int ks = 0; ks < 10; ++ks) Af[ks] = *(const bf16x8*)(act + 512 * ks);
    if (!SHARED) { PREP_LDB(BfA, 0); PREP_LDB(BfB, 1); }
#pragma unroll
    for (int r = 0; r < 4; ++r) { const size_t row = row0 + 4 * g + r;
        wr[r] = *(const v2u*)(zb + row * ZC); wk[r] = *(const v2u*)(zb + row * ZC + 512); wv[r] = *(const v2u*)(zb + row * ZC + 1024);
        wf[r] = l == 1 ? *(const v2u*)(C.VF() + row * 512 + ch0) : (v2u){0u, 0u}; }
    {
        bool hasprev = true; int prow;
        if (g > 0) prow = row0 + 4 * g - 1; else if (cidx == 0) { hasprev = false; prow = row0; } else prow = cidx == 1 ? MAINR + 15 : row0 - 1;
        pwr = *(const v2u*)(zb + (size_t)prow * ZC); pwk = *(const v2u*)(zb + (size_t)prow * ZC + 512); pwv = *(const v2u*)(zb + (size_t)prow * ZC + 1024);
        if (!hasprev) { pwr = (v2u){0u, 0u}; pwk = pwr; pwv = pwr; }
    }
    asm volatile("" ::: "memory");
    if (prev_ops) prep_copy(sl, prev_ops, lane);
    asm volatile("" ::: "memory");
    if (SHARED) { asm volatile("s_waitcnt vmcnt(0)" ::: "memory"); __syncthreads(); PREP_LDB(BfA, 0); PREP_LDB(BfB, 1); }
    PREP_MM(BfA, 0);
    asm volatile("" ::: "memory");
    PREP_LDB(BfA, 2);
    asm volatile("" ::: "memory");
    PREP_MM(BfB, 1);
    asm volatile("" ::: "memory");
    PREP_LDB(BfB, 3);
    const f32x4 w0v = *(const f32x4*)(C.I(I_W0) + l * 512 + ch0), a0v = *(const f32x4*)(C.I(I_A0) + l * 512 + ch0);
    const f32x4 v0v = l == 1 ? *(const f32x4*)(C.I(I_V0) + ch0) : z4;
    const f32x4 mur = *(const f32x4*)(C.I(I_MU) + l * 1824 + ch0), muk = *(const f32x4*)(C.I(I_MU) + l * 1824 + 512 + ch0), muv = *(const f32x4*)(C.I(I_MU) + l * 1824 + 1024 + ch0);
    const f32x4 kkc = *(const f32x4*)(C.I(I_KK) + l * 512 + ch0), kac = *(const f32x4*)(C.I(I_KA) + l * 512 + ch0), rkc = *(const f32x4*)(C.I(I_RK) + l * 512 + ch0);
    const f32x4 lnw = *(const f32x4*)(C.I(I_LNW) + l * 512 + ch0), lnb = *(const f32x4*)(C.I(I_LNB) + l * 512 + ch0);
    asm volatile("" ::: "memory");
    PREP_MM(BfA, 2);
    PREP_MM(BfB, 3);
    asm volatile("" ::: "memory");
    if (SHARED) { asm volatile("s_waitcnt lgkmcnt(0)" ::: "memory"); __syncthreads(); }
#undef PREP_LDB
#undef PREP_MM
    float At[4][4], Bt[4][4], Kt[4][4], Vv[4][4], gam[4];
    unsigned char* ops = C.ws + WS_OPS + ((size_t)bhl * NCHUNK + cidx) * OPSB;
    {
        float lw[4][4], cum[4][4];
#pragma unroll
        for (int r = 0; r < 4; ++r)
#pragma unroll
            for (int n = 0; n < 4; ++n) lw[r][n] = -0.6065306597126334f * sigmoidf_(w0v[n] + aw[n][r]);
#pragma unroll
        for (int n = 0; n < 4; ++n) { cum[0][n] = lw[0][n]; cum[1][n] = cum[0][n] + lw[1][n]; cum[2][n] = cum[1][n] + lw[2][n]; cum[3][n] = cum[2][n] + lw[3][n];
            const float tot = cum[3][n];
            const u2v r16 = __builtin_amdgcn_permlane16_swap(__float_as_uint(tot), __float_as_uint(tot), false, false);
            const float x16 = __uint_as_float((g & 1) ? r16.x : r16.y), pr2 = tot + x16;
            const u2v r32 = __builtin_amdgcn_permlane32_swap(__float_as_uint(pr2), __float_as_uint(pr2), false, false);
            const float off = ((g & 1) ? x16 : 0.f) + ((g & 2) ? __uint_as_float(r32.x) : 0.f);
#pragma unroll
            for (int r = 0; r < 4; ++r) cum[r][n] += off;
            gam[n] = 0.f; }
        float pr[4], pk[4], pv[4]; unpack4(pwr, pr); unpack4(pwk, pk); unpack4(pwv, pv);
        float ecp[4];
#pragma unroll
        for (int n = 0; n < 4; ++n) ecp[n] = __expf(cum[0][n] - lw[0][n]);
#pragma unroll
        for (int r = 0; r < 4; ++r) {
            float rr[4], kr[4], vr[4], vf[4]; unpack4(wr[r], rr); unpack4(wk[r], kr); unpack4(wv[r], vr); unpack4(wf[r], vf);
            float rs[4], ks[4], vs[4], kk[4], ss = 0.f;
#pragma unroll
            for (int n = 0; n < 4; ++n) { rs[n] = rr[n] + (pr[n] - rr[n]) * mur[n]; ks[n] = kr[n] + (pk[n] - kr[n]) * muk[n]; vs[n] = vr[n] + (pv[n] - vr[n]) * muv[n];
                pr[n] = rr[n]; pk[n] = kr[n]; pv[n] = vr[n]; kk[n] = ks[n] * kkc[n]; ss += kk[n] * kk[n]; }
            ss = row16_sum(ss);
            const float inv = __builtin_amdgcn_rcpf(fmaxf(__builtin_amdgcn_sqrtf(ss), 1e-12f));
            float k2[4], v2[4], Rt[4], Gp[4], BGp[4], rks = 0.f;
#pragma unroll
            for (int n = 0; n < 4; ++n) { const float a = sigmoidf_(a0v[n] + aa[n][r]); kk[n] *= inv; k2[n] = ks[n] * (1.f + (a - 1.f) * kac[n]);
                const float bb = kk[n] * a; v2[n] = l == 0 ? vs[n] : vs[n] + (vf[n] - vs[n]) * sigmoidf_(v0v[n] + av[n][r]);
                rks += rs[n] * k2[n] * rkc[n];
                const float ec = __expf(cum[r][n]), en = __builtin_amdgcn_rcpf(ec), ep = ecp[n]; ecp[n] = ec; if (r == 3) gam[n] = ec;
                At[r][n] = -kk[n] * ep; Bt[r][n] = bb * en; Kt[r][n] = k2[n] * en; Rt[n] = rs[n] * ec; Vv[r][n] = v2[n]; }
            rks = row16_sum(rks);
#pragma unroll
            for (int n = 0; n < 4; ++n) { const float gg = ag[n][r]; Gp[n] = lnw[n] * gg; BGp[n] = (lnb[n] + rks * v2[n]) * gg; }
            { const int t = 4 * g + r;
              *(LAS s16x4*)(sl + O_W + (t * 64 + 4 * c) * 2) = pack4f(At[r][0], At[r][1], At[r][2], At[r][3]);
              *(LAS s16x4*)(sl + O_B + (t * 64 + 4 * c) * 2) = pack4f(Bt[r][0], Bt[r][1], Bt[r][2], Bt[r][3]);
              *(LAS s16x4*)(sl + O_K + (t * 64 + 4 * c) * 2) = pack4f(Kt[r][0], Kt[r][1], Kt[r][2], Kt[r][3]);
              *(LAS s16x4*)(sl + O_R + (t * 64 + 4 * c) * 2) = pack4f(Rt[0], Rt[1], Rt[2], Rt[3]);
              *(s16x4*)(ops + OPS_G + (t * 64 + 4 * c) * 2) = pack4f(Gp[0], Gp[1], Gp[2], Gp[3]);
              *(s16x4*)(ops + OPS_BG + (t * 64 + 4 * c) * 2) = pack4f(BGp[0], BGp[1], BGp[2], BGp[3]); }
            if (l == 0) *(v2u*)(C.VF() + (size_t)(row0 + 4 * g + r) * 512 + ch0) = (v2u){pk2(vs[0], vs[1]), pk2(vs[2], vs[3])};
        }
    }
#pragma unroll
    for (int n = 0; n < 4; ++n) { const int j = 4 * c + n;
        *(LAS s16x4*)(sl + O_AT + (j * 16 + 4 * g) * 2) = pack4f(At[0][n], At[1][n], At[2][n], At[3][n]);
        *(LAS s16x4*)(sl + O_BK + (j * 32 + 4 * g) * 2) = pack4f(Bt[0][n], Bt[1][n], Bt[2][n], Bt[3][n]);
        *(LAS s16x4*)(sl + O_BK + (j * 32 + 16 + 4 * g) * 2) = pack4f(Kt[0][n], Kt[1][n], Kt[2][n], Kt[3][n]);
        *(LAS s16x4*)(sl + O_VT + (j * 16 + 4 * g) * 2) = pack4f(Vv[0][n], Vv[1][n], Vv[2][n], Vv[3][n]); }
    if (g == 3) *(LAS f32x4*)(sl + O_GAM + 4 * c * 4) = (f32x4){gam[0], gam[1], gam[2], gam[3]};
    asm volatile("s_waitcnt lgkmcnt(0)" ::: "memory");
    {
        f32x4 aab = z4, aak = z4, arb = z4, ark = z4;
#pragma unroll
        for (int ks = 0; ks < 2; ++ks) {
            const bf16x8 Aa = *(const LAS bf16x8*)(sl + O_W + (c * 64 + 32 * ks + 8 * g) * 2), Ar = *(const LAS bf16x8*)(sl + O_R + (c * 64 + 32 * ks + 8 * g) * 2);
            const bf16x8 Bb = *(const LAS bf16x8*)(sl + O_B + (c * 64 + 32 * ks + 8 * g) * 2), Bk = *(const LAS bf16x8*)(sl + O_K + (c * 64 + 32 * ks + 8 * g) * 2);
            aab = mfma16(Aa, Bb, aab); aak = mfma16(Aa, Bk, aak); arb = mfma16(Ar, Bb, arb); ark = mfma16(Ar, Bk, ark);
        }
        asm volatile("" ::: "memory");
        f32x4 mk;
#pragma unroll
        for (int r = 0; r < 4; ++r) { const int t = 4 * g + r; const bool lo = c < t, li = c <= t;
            *(LAS float*)(sl + O_B + (t * 16 + c) * 4) = lo ? aab[r] : 0.f;
            mk[r] = lo ? aak[r] : 0.f;
            *(LAS bf16*)(sl + O_ARK + (t * 32 + c) * 2) = (bf16)f2bf(li ? arb[r] : 0.f);
            *(LAS bf16*)(sl + O_ARK + (t * 32 + 16 + c) * 2) = (bf16)f2bf(li ? ark[r] : 0.f); }
        *(LAS s16x4*)(sl + O_K + (c * 16 + 4 * g) * 2) = pack4(mk);
    }
    asm volatile("s_waitcnt lgkmcnt(0)" ::: "memory");
    {
        float X[16];
#pragma unroll
        for (int t = 0; t < 16; ++t) { float acc = (t == c) ? 1.f : 0.f;
#pragma unroll
            for (int s4 = 0; s4 < (t + 3) / 4; ++s4) { const f32x4 a4 = *(const LAS f32x4*)(sl + O_B + (t * 16 + 4 * s4) * 4);
#pragma unroll
                for (int e = 0; e < 4; ++e) if (4 * s4 + e < t) acc += a4[e] * X[4 * s4 + e]; }
            X[t] = acc; }
#pragma unroll
        for (int t = 0; t < 16; ++t) *(LAS bf16*)(sl + O_K + 512 + (t * 16 + c) * 2) = (bf16)f2bf(X[t]);
    }
    asm volatile("s_waitcnt lgkmcnt(0)" ::: "memory");
    {
        const bf16x8 Top = g < 2 ? *(const LAS bf16x8*)(sl + O_K + 512 + (c * 16 + 8 * g) * 2) : zero8;
#pragma unroll
        for (int n = 0; n < 4; ++n) { const bf16x8 Bop = g < 2 ? *(const LAS bf16x8*)(sl + O_AT + ((16 * n + c) * 16 + 8 * g) * 2) : zero8;
            const f32x4 wacc = mfma16(Top, Bop, z4);
#pragma unroll
            for (int r = 0; r < 4; ++r) *(LAS bf16*)(sl + O_W + ((4 * g + r) * 64 + 16 * n + c) * 2) = (bf16)f2bf(wacc[r]); }
        const bf16x8 Bop = g < 2 ? *(const LAS bf16x8*)(sl + O_K + (c * 16 + 8 * g) * 2) : zero8;
        const f32x4 ta = mfma16(Top, Bop, z4);
#pragma unroll
        for (int r = 0; r < 4; ++r) *(LAS bf16*)(sl + O_TA + ((4 * g + r) * 16 + c) * 2) = (bf16)f2bf(ta[r]);
    }
    asm volatile("s_waitcnt lgkmcnt(0)" ::: "memory");
    return ops;
}

__device__ __forceinline__ void phase_prep(const Ctx& C, int l, int half) {
    const int gw = C.bid * NWAVES + C.wid, NGW = C.G * NWAVES;
    LAS unsigned char* sl = C.lds + C.wid * SLOT;
    unsigned char* pops = nullptr;
    for (int u = gw; u < 16 * 512; u += NGW) { const int bhl = u >> 9, cidx = u & 511; pops = prep_unit<false>(C, l, 16 * half + bhl, bhl, cidx, sl, pops); }
    if (pops) prep_copy(sl, pops, lane_now());
}

struct OpsSet { v4u d[10]; };
struct GbSet { v4u d[4]; };
struct VtSet { v2u v4[4]; };
constexpr int RING_SLOT = 11520, YB_OFF = 8 * RING_SLOT, YB_SLOT = 4096;
__device__ __forceinline__ int swz(int x) { return x + ((x >> 7) << 4); }

__device__ __forceinline__ void ld_ops(OpsSet& s, const unsigned char* ops, int c, int lane) {
    const unsigned char* p = ops + (size_t)(c < NCHUNK ? c : NCHUNK - 1) * OPSB + lane * 16;
#pragma unroll
    for (int i = 0; i < 10; ++i) s.d[i] = *(const v4u*)(p + i * 1024);
}
__device__ __forceinline__ void st_ops(const OpsSet& s, LAS unsigned char* ring, int c, int lane) {
    LAS unsigned char* p = ring + (c & 7) * RING_SLOT + lane * 16 + (lane >> 3) * 16;
#pragma unroll
    for (int i = 0; i < 10; ++i) *(LAS v4u*)(p + i * 1152) = s.d[i];
}
__device__ __forceinline__ void ld_gb(GbSet& s, const unsigned char* ops, int c, int lane) {
    const int t = lane >> 2, cg = lane & 3;
    const unsigned char* p = ops + (size_t)(c < NCHUNK ? c : NCHUNK - 1) * OPSB + (t * 64 + 16 * cg) * 2;
    s.d[0] = *(const v4u*)(p + OPS_G); s.d[1] = *(const v4u*)(p + OPS_G + 16); s.d[2] = *(const v4u*)(p + OPS_BG); s.d[3] = *(const v4u*)(p + OPS_BG + 16);
}
__device__ __forceinline__ void ld_vt(VtSet& s, const unsigned char* ops, int j, int wid, int lane) {
    const int g = lane >> 4, c = lane & 15;
#pragma unroll
    for (int u = 0; u < 4; ++u) { const int ch = 4 * j + u; const unsigned char* p = ops + (size_t)(ch < NCHUNK ? ch : NCHUNK - 1) * OPSB + OPS_VT + (16 * wid + c) * 32;
        s.v4[u] = *(const v2u*)(p + g * 8); }
}
__device__ __forceinline__ void out_stage(const Ctx& C, const GbSet& s, LAS unsigned char* ybuf, int b, int hh, int c, int lane) {
    const int t = lane >> 2, cg = lane & 3;
    const int row = (c == 0 ? MAINR : b * SEQ + 16 * (c - 1)) + t;
    const LAS float* yp = (const LAS float*)(ybuf + (c & 7) * YB_SLOT) + t * 64 + 16 * cg;
    f32x4 y[4];
#pragma unroll
    for (int i = 0; i < 4; ++i) y[i] = *(const LAS f32x4*)(yp + 4 * i);
    float s1 = 0.f;
#pragma unroll
    for (int i = 0; i < 4; ++i) s1 += (y[i].x + y[i].y) + (y[i].z + y[i].w);
    s1 = quad_sum(s1);
    const float mean = s1 * (1.f / 64.f); float s2 = 0.f;
#pragma unroll
    for (int i = 0; i < 4; ++i) { y[i] = y[i] - mean; s2 += (y[i].x * y[i].x + y[i].y * y[i].y) + (y[i].z * y[i].z + y[i].w * y[i].w); }
    s2 = quad_sum(s2);
    const float rstd = __builtin_amdgcn_rsqf(s2 * (1.f / 64.f) + GN_EPS);
    v4u o[2];
#pragma unroll
    for (int k = 0; k < 2; ++k) {
        const v4u gw = s.d[k], bw = s.d[2 + k]; unsigned ow[4];
#pragma unroll
        for (int e = 0; e < 4; ++e) { const f32x4 yy = y[2 * k + (e >> 1)]; const float ya = (e & 1) ? yy.z : yy.x, yb = (e & 1) ? yy.w : yy.y;
            const float g0 = __uint_as_float(gw[e] << 16), g1 = __uint_as_float(gw[e] & 0xffff0000u), b0 = __uint_as_float(bw[e] << 16), b1 = __uint_as_float(bw[e] & 0xffff0000u);
            ow[e] = pk2(ya * rstd * g0 + b0, yb * rstd * g1 + b1); }
        o[k] = (v4u){ow[0], ow[1], ow[2], ow[3]};
    }
    bf16* dst = C.U() + (size_t)row * DM + 512 + hh * 64 + 16 * cg;
    *(v4u*)dst = o[0]; *(v4u*)(dst + 8) = o[1];
}

struct ChEarly { bf16x8 Wp[2], Rp[2]; s16x4 TAop; };
struct ChLate { bf16x8 ARKp, BKp[4]; f32x4 gam[4]; };
__device__ __forceinline__ void chain_load_e(ChEarly& o, const LAS unsigned char* p1, const LAS unsigned char* p2, const int so) {
#pragma unroll
    for (int ks = 0; ks < 2; ++ks) {
        o.Wp[ks] = cat8(*(const LAS s16x4*)(p1 + so + 64 * ks), *(const LAS s16x4*)(p1 + so + 64 * ks + 32));
        o.Rp[ks] = cat8(*(const LAS s16x4*)(p1 + so + 2304 + 64 * ks), *(const LAS s16x4*)(p1 + so + 2304 + 64 * ks + 32)); }
    o.TAop = *(const LAS s16x4*)(p2 + so + 10368);
}
__device__ __forceinline__ void chain_load_l(ChLate& o, const LAS unsigned char* p3, const LAS unsigned char* p4, const int so) {
    o.ARKp = cat8(*(const LAS s16x4*)(p3 + so + 9216), *(const LAS s16x4*)(p3 + so + 9216 + 32));
#pragma unroll
    for (int q = 0; q < 4; ++q) { o.BKp[q] = cat8(*(const LAS s16x4*)(p3 + so + 4608 + 1152 * q), *(const LAS s16x4*)(p3 + so + 4608 + 1152 * q + 32));
        o.gam[q] = *(const LAS f32x4*)(p4 + so + 9728 + 76 * 16 + 64 * q + (q >= 2 ? 16 : 0)); }
}
__device__ __forceinline__ f32x4 chain_compute(const ChEarly& e, const ChLate& o, const v2u v4w, f32x4 (&ST)[4]) {
    const s16x4 V4 = __builtin_bit_cast(s16x4, v4w); const s16x4 zero4 = (s16x4){0, 0, 0, 0};
    const bf16x8 TAop = cat8(e.TAop, zero4), Vb = cat8(V4, zero4);
    const f32x4 z4 = (f32x4){0.f, 0.f, 0.f, 0.f};
    const bf16x8 Bk0 = cat8(pack4(ST[0]), pack4(ST[1])), Bk1 = cat8(pack4(ST[2]), pack4(ST[3]));
    f32x4 U = mfma16(e.Wp[0], Bk0, z4); U = mfma16(e.Wp[1], Bk1, U); U = mfma16(TAop, Vb, U);
    f32x4 Y = mfma16(e.Rp[0], Bk0, z4); Y = mfma16(e.Rp[1], Bk1, Y);
    const bf16x8 UV = cat8(pack4(U), V4);
    Y = mfma16(o.ARKp, UV, Y);
#pragma unroll
    for (int q = 0; q < 4; ++q) { ST[q] = mfma16(o.BKp[q], UV, ST[q]); ST[q] = ST[q] * o.gam[q]; }
    return Y;
}

#define WAIT_LAST() do { unsigned sp_ = 0; while (__hip_atomic_load(flagw, __ATOMIC_RELAXED, __HIP_MEMORY_SCOPE_AGENT) < 2u && ++sp_ < (1u << 20)) __builtin_amdgcn_s_sleep(8); \
    __builtin_amdgcn_fence(__ATOMIC_ACQUIRE, "agent"); asm volatile("s_waitcnt vmcnt(0)" ::: "memory"); } while (0)
#define WG_BAR() do { asm volatile("s_waitcnt lgkmcnt(0)" ::: "memory"); __builtin_amdgcn_s_barrier(); asm volatile("" ::: "memory"); } while (0)
#define YSTORE(ch, Yv) do { _Pragma("unroll") for (int r = 0; r < 4; ++r) *(LAS float*)(ybuf + ((ch) & 7) * YB_SLOT + ((4 * (lane >> 4) + r) * 64 + 16 * wid + (lane & 15)) * 4) = (Yv)[r]; } while (0)
#define CHAIN_IT(j, VTU, HB) do { \
    ChEarly ea, eb; ChLate la; f32x4 Yv; \
    chain_load_e(ea, p1 + HB, p2 + HB, 0); \
    chain_load_l(la, p3 + HB, p4 + HB, 0); chain_load_e(eb, p1 + HB, p2 + HB, RING_SLOT); \
    Yv = chain_compute(ea, la, VTU.v4[0], ST); YSTORE(4 * (j) + 0, Yv); \
    chain_load_l(la, p3 + HB, p4 + HB, RING_SLOT); chain_load_e(ea, p1 + HB, p2 + HB, 2 * RING_SLOT); \
    Yv = chain_compute(eb, la, VTU.v4[1], ST); YSTORE(4 * (j) + 1, Yv); \
    chain_load_l(la, p3 + HB, p4 + HB, 2 * RING_SLOT); chain_load_e(eb, p1 + HB, p2 + HB, 3 * RING_SLOT); \
    Yv = chain_compute(ea, la, VTU.v4[2], ST); YSTORE(4 * (j) + 2, Yv); \
    chain_load_l(la, p3 + HB, p4 + HB, 3 * RING_SLOT); \
    Yv = chain_compute(eb, la, VTU.v4[3], ST); YSTORE(4 * (j) + 3, Yv); \
    ld_vt(VTU, ops, (j) + 2, wid, lane); WG_BAR(); } while (0)
#define LOAD_IT(j, OSW, OSI, GBO, GBI) do { \
    const int co = 4 * ((j) - 1) + lw; if ((j) >= 1 && co < NCHUNK) out_stage(C, GBO, ybuf, b, hh, co, lane); \
    const int cn = 4 * ((j) + 1) + lw; if (cn < NCHUNK) st_ops(OSW, ring, cn, lane); \
    ld_ops(OSI, ops, 4 * ((j) + 3) + lw, lane); ld_gb(GBI, ops, cn, lane); WG_BAR(); } while (0)

__device__ __forceinline__ void chain_phase(const Ctx& C, int bh, int bhl, unsigned* flagw) {
    int lane_ = lane_now(); const int lane = lane_, wid = C.wid;
    const int b = bh >> 3, hh = bh & 7;
    LAS unsigned char* ring = C.lds; LAS unsigned char* ybuf = C.lds + YB_OFF;
    const unsigned char* ops = C.ws + WS_OPS + (size_t)bhl * NCHUNK * OPSB;
    constexpr int NIT = 132;
    if (wid < 4) {
        f32x4 ST[4];
#pragma unroll
        for (int q = 0; q < 4; ++q) ST[q] = (f32x4){0.f, 0.f, 0.f, 0.f};
        VtSet vt0, vt1;
        ld_vt(vt0, ops, 0, wid, lane); ld_vt(vt1, ops, 1, wid, lane);
        WG_BAR();
        __builtin_amdgcn_s_setprio(3);
        const int g_ = lane >> 4, c_ = lane & 15;
        const LAS unsigned char* p1 = ring + c_ * 144 + 8 * g_;
        const LAS unsigned char* p2 = ring + c_ * 32 + 8 * g_ + (c_ >> 2) * 16;
        const LAS unsigned char* p3 = ring + c_ * 64 + 8 * g_ + (c_ >> 1) * 16;
        const LAS unsigned char* p4 = ring + 16 * g_;
#pragma unroll 1
        for (int j = 0; j < NIT; j += 2) {
            if (j == 96) WAIT_LAST();
#ifndef NOCHAIN
            CHAIN_IT(j, vt0, 0); CHAIN_IT(j + 1, vt1, 4 * RING_SLOT);
#endif
        }
        __builtin_amdgcn_s_setprio(0);
    } else {
        const int lw = wid - 4;
        OpsSet os0, os1, os2; GbSet gb0, gb1, gb2;
        ld_ops(os0, ops, lw, lane); ld_ops(os1, ops, 4 + lw, lane); ld_ops(os2, ops, 8 + lw, lane); ld_gb(gb0, ops, lw, lane); st_ops(os0, ring, lw, lane);
        gb1 = gb0; gb2 = gb0;
        WG_BAR();
#pragma unroll 1
        for (int j = 0; j < NIT; j += 3) {
            if (j == 96) WAIT_LAST();
#ifndef NOLOADER
            LOAD_IT(j, os1, os0, gb2, gb1); LOAD_IT(j + 1, os2, os1, gb0, gb2); LOAD_IT(j + 2, os0, os2, gb1, gb0);
#endif
        }
    }
}

constexpr int SCW = 8224;
constexpr int LDS_HIST = 8 * SCW * 2;
constexpr int LDS_IDX = LDS_HIST + 8 * 256 * 4;
constexpr int LDS_MISC = LDS_IDX + 8 * 256 * 2;
static_assert(LDS_MISC + 64 <= LDS_BYTES && 8 * 18432 <= LDS_BYTES && 8 * 10240 + 8 * 4096 <= LDS_MISC, "lds map");

__device__ __forceinline__ unsigned mbcnt64(unsigned long long m) { return __builtin_amdgcn_mbcnt_hi((unsigned)(m >> 32), __builtin_amdgcn_mbcnt_lo((unsigned)m, 0u)); }

__device__ __forceinline__ void find_bin(LAS unsigned* hist, unsigned target, int lane, unsigned& bin, unsigned& above) {
    const v4u c = *(LAS v4u*)(hist + 4 * lane);
    const unsigned t = c.x + c.y + c.z + c.w;
    const unsigned inc = wave_scan_incl(t);
    const unsigned total = lane_bcast(inc, 63);
    const unsigned sufx = total - inc;
    const bool found = (sufx < target) && (target <= sufx + t);
    unsigned mybin = 0, myab = 0;
    if (found) { unsigned a = sufx;
        if (a + c.w >= target) { mybin = 4 * lane + 3; myab = a; } else { a += c.w;
        if (a + c.z >= target) { mybin = 4 * lane + 2; myab = a; } else { a += c.z;
        if (a + c.y >= target) { mybin = 4 * lane + 1; myab = a; } else { a += c.y; mybin = 4 * lane; myab = a; } } } }
    const unsigned long long m = __ballot(found);
    const int src = m ? (int)__builtin_ctzll(m) : 0;
    bin = lane_bcast(mybin, src); above = lane_bcast(myab, src);
}

__device__ __forceinline__ void attn_unit(const Ctx& C, int l, int b, int qt) {
    const int lane = lane_now(), wid = C.wid, tid = wid * 64 + lane;
    const int p0 = 8 * qt, nk = p0 + 8, ntile = (nk + 31) >> 5, nkp = ntile * 32;
    LAS u16* SC = (LAS u16*)C.lds; LAS unsigned* HIST = (LAS unsigned*)(C.lds + LDS_HIST); LAS u16* IDX = (LAS u16*)(C.lds + LDS_IDX);
    for (int i = tid; i < 8 * 256; i += NT) HIST[i] = 0u;
    __syncthreads();
    const bf16* Z = C.Z();
    {
        const int r = lane & 31, half = lane >> 5;
        const int rowq = row_of(b, p0 + (r >> 2));
        bf16x8 Af[4];
#pragma unroll
        for (int s = 0; s < 4; ++s) Af[s] = *(const bf16x8*)(Z + (size_t)rowq * ZC + C_QI + (r & 3) * 64 + 16 * s + 8 * half);
        float wi[4][4];
#pragma unroll
        for (int g = 0; g < 4; ++g) { const int rg = row_of(b, p0 + 2 * g + half);
#pragma unroll
            for (int hh = 0; hh < 4; ++hh) wi[g][hh] = bf2f(Z[(size_t)rg * ZC + C_WI + hh]) * 0.0625f; }
        const unsigned char* kib = (const unsigned char*)(C.KI() + (size_t)b * TPAD * 64); const unsigned klane = (unsigned)lane * 16u;
        const unsigned char* kib2 = (const unsigned char*)(C.KI() + (size_t)((b + 1) & 3) * TPAD * 64);
#define SC_LOAD2(P, ka_, kb_) do { const int ka__ = (ka_), kb__ = (kb_); _Pragma("unroll") for (int s = 0; s < 4; ++s) { P[0][s] = *(const bf16x8*)(kib + ((unsigned)ka__ * 4096u + 1024u * s + klane)); P[1][s] = *(const bf16x8*)(kib + ((unsigned)kb__ * 4096u + 1024u * s + klane)); } } while (0)
#define SC_LOAD(P, kt_) do { _Pragma("unroll") for (int s = 0; s < 4; ++s) { P[0][s] = *(const bf16x8*)(kib + ((unsigned)(kt_) * 4096u + 1024u * s + klane)); P[1][s] = *(const bf16x8*)(kib + ((unsigned)((kt_) + 8) * 4096u + 1024u * s + klane)); \
    if (PROBE == 6) { bf16x8 d0 = *(const bf16x8*)(kib2 + ((unsigned)(kt_) * 4096u + 1024u * s + klane)), d1 = *(const bf16x8*)(kib2 + ((unsigned)((kt_) + 8) * 4096u + 1024u * s + klane)); asm volatile("" :: "v"(d0), "v"(d1)); } } } while (0)
#define SC_MFMA(acc, Bq) do { _Pragma("unroll") for (int e = 0; e < 16; ++e) acc[e] = 0.f; \
            _Pragma("unroll") for (int s = 0; s < 4; ++s) acc = __builtin_amdgcn_mfma_f32_32x32x16_bf16(Af[s], Bq[s], acc, 0, 0, 0); } while (0)
#define SC_KEY2(a_, b_) ({ const h2v hh_ = __builtin_convertvector((f32x2h){(a_), (b_)}, h2v); const unsigned w_ = __builtin_bit_cast(unsigned, hh_); \
            const s2v m_ = __builtin_bit_cast(s2v, w_) >> 15; w_ ^ (__builtin_bit_cast(unsigned, m_) | 0x80008000u); })
#define SC_SCORES(acc) float scv[4]; \
            _Pragma("unroll") for (int g = 0; g < 4; ++g) { \
                const float r0 = relu_i(acc[4 * g + 0]), r1 = relu_i(acc[4 * g + 1]), r2 = relu_i(acc[4 * g + 2]), r3 = relu_i(acc[4 * g + 3]); \
                scv[g] = __builtin_fmaf(wi[g][3], r3, __builtin_fmaf(wi[g][2], r2, __builtin_fmaf(wi[g][1], r1, wi[g][0] * r0))); } \
            const unsigned w01 = SC_KEY2(scv[0], scv[1]), w23 = SC_KEY2(scv[2], scv[3]);
#define SC_EMIT_FULL() do { \
                SC[(0 + half) * SCW + key] = (u16)w01; SC[(2 + half) * SCW + key] = (u16)(w01 >> 16); SC[(4 + half) * SCW + key] = (u16)w23; SC[(6 + half) * SCW + key] = (u16)(w23 >> 16); \
                atomicAdd((unsigned*)(HIST + (0 + half) * 256 + ((w01 >> 8) & 0xffu)), 1u); atomicAdd((unsigned*)(HIST + (2 + half) * 256 + (w01 >> 24)), 1u); \
                atomicAdd((unsigned*)(HIST + (4 + half) * 256 + ((w23 >> 8) & 0xffu)), 1u); atomicAdd((unsigned*)(HIST + (6 + half) * 256 + (w23 >> 24)), 1u); } while (0)
#define SC_VALU_FAST(acc, kt_) do { const int key = (kt_) * 32 + r; SC_SCORES(acc) SC_EMIT_FULL(); } while (0)
#define SC_VALU(acc, kt_) do { const int kt__ = (kt_); if (kt__ < ntile) { const int key = kt__ * 32 + r; SC_SCORES(acc) \
            if (kt__ * 32 + 31 <= p0) SC_EMIT_FULL(); \
            else { \
                _Pragma("unroll") for (int g = 0; g < 4; ++g) { const unsigned wp = g < 2 ? w01 : w23; unsigned k16 = (g & 1) ? (wp >> 16) : (wp & 0xffffu); \
                    const int qq = 2 * g + half; const bool valid = key <= p0 + qq; \
                    if (!valid) k16 = 0u; \
                    SC[qq * SCW + key] = (u16)k16; \
                    if (valid) atomicAdd((unsigned*)(HIST + qq * 256 + (k16 >> 8)), 1u); } } } } while (0)
        bf16x8 P0[2][4], P1[2][4], P2[2][4];
        _Pragma("unroll 1") for (int rep7 = 0, n7 = (PROBE == 7 ? launder2() : 1); rep7 < n7; ++rep7) {
        LAS unsigned* HISTsave = HIST; if (rep7) HIST = (LAS unsigned*)(C.lds + 144384);
        const int nst = (ntile + 7) >> 3, nfull = (p0 + 1) >> 5, jfull = nfull > wid ? (nfull - wid + 7) >> 3 : 0;
#define TIDX(j) (wid + 8 * (j))
#define TSAFE(j) ((j) < nst ? TIDX(j) : wid)
        SC_LOAD2(P0, TSAFE(0), TSAFE(1)); SC_LOAD2(P1, TSAFE(2), TSAFE(3));
        int j = 0;
        for (; j + 6 <= jfull; j += 6) {
            f32x16 acc0, acc1;
            SC_LOAD2(P2, TSAFE(j + 4), TSAFE(j + 5));
            SC_MFMA(acc0, P0[0]); SC_MFMA(acc1, P0[1]); SC_VALU_FAST(acc0, TIDX(j)); SC_VALU_FAST(acc1, TIDX(j + 1));
            SC_LOAD2(P0, TSAFE(j + 6), TSAFE(j + 7));
            SC_MFMA(acc0, P1[0]); SC_MFMA(acc1, P1[1]); SC_VALU_FAST(acc0, TIDX(j + 2)); SC_VALU_FAST(acc1, TIDX(j + 3));
            SC_LOAD2(P1, TSAFE(j + 8), TSAFE(j + 9));
            SC_MFMA(acc0, P2[0]); SC_MFMA(acc1, P2[1]); SC_VALU_FAST(acc0, TIDX(j + 4)); SC_VALU_FAST(acc1, TIDX(j + 5));
        }
        for (; j < nst; j += 6) {
            f32x16 acc0, acc1;
            SC_LOAD2(P2, TSAFE(j + 4), TSAFE(j + 5));
            SC_MFMA(acc0, P0[0]); SC_MFMA(acc1, P0[1]); SC_VALU(acc0, TSAFE(j)); if (j + 1 < nst) SC_VALU(acc1, TIDX(j + 1));
            SC_LOAD2(P0, TSAFE(j + 6), TSAFE(j + 7));
            SC_MFMA(acc0, P1[0]); SC_MFMA(acc1, P1[1]); if (j + 2 < nst) SC_VALU(acc0, TIDX(j + 2)); if (j + 3 < nst) SC_VALU(acc1, TIDX(j + 3));
            SC_LOAD2(P1, TSAFE(j + 8), TSAFE(j + 9));
            SC_MFMA(acc0, P2[0]); SC_MFMA(acc1, P2[1]); if (j + 4 < nst) SC_VALU(acc0, TIDX(j + 4)); if (j + 5 < nst) SC_VALU(acc1, TIDX(j + 5));
        }
#undef TIDX
#undef TSAFE
        HIST = HISTsave; }
#undef SC_LOAD
#undef SC_LOAD2
#undef SC_MFMA
#undef SC_VALU
#undef SC_VALU_FAST
#undef SC_SCORES
#undef SC_EMIT_FULL
#undef SC_KEY2
    }
    __syncthreads();
    const int q = wid, p = p0 + q, nvalid = p + 1, nsel = nvalid < 256 ? nvalid : 256;
    LAS u16* sc = SC + q * SCW; LAS unsigned* hist = HIST + q * 256; LAS u16* idx = IDX + q * 256;
    if (nvalid <= 256) { for (int i = lane; i < nvalid; i += 64) idx[i] = (u16)i; }
    else {
        unsigned b1, ab1; find_bin(hist, 256u, lane, b1, ab1);
        _Pragma("unroll 1") for (int rep8 = 0, n8 = (PROBE == 8 ? launder2() : 1); rep8 < n8; ++rep8) {
        asm volatile("s_waitcnt lgkmcnt(0)" ::: "memory");
        { unsigned z_ = 0u; asm volatile("" : "+v"(z_)); *(LAS v4u*)(hist + 4 * lane) = (v4u){z_, z_, z_, z_}; }
        asm volatile("s_waitcnt lgkmcnt(0)" ::: "memory");
        const int niter = (nkp + 255) >> 8;
        {   v2u cur = 4 * lane < nkp ? *(LAS v2u*)(sc + 4 * lane) : (v2u){0u, 0u};
            for (int it = 0; it < niter; ++it) { const int in = (it + 1) * 256 + 4 * lane; const v2u nxt = in < nkp ? *(LAS v2u*)(sc + in) : (v2u){0u, 0u};
                const unsigned k0 = cur.x & 0xffffu, k1 = cur.x >> 16, k2 = cur.y & 0xffffu, k3 = cur.y >> 16;
                if ((k0 >> 8) == b1) atomicAdd((unsigned*)(hist + (k0 & 255u)), 1u);
                if ((k1 >> 8) == b1) atomicAdd((unsigned*)(hist + (k1 & 255u)), 1u);
                if ((k2 >> 8) == b1) atomicAdd((unsigned*)(hist + (k2 & 255u)), 1u);
                if ((k3 >> 8) == b1) atomicAdd((unsigned*)(hist + (k3 & 255u)), 1u);
                cur = nxt; } }
        asm volatile("s_waitcnt lgkmcnt(0)" ::: "memory");
        unsigned b2, ab2; find_bin(hist, 256u - ab1, lane, b2, ab2);
        const unsigned T16 = (b1 << 8) | b2; const unsigned need_eq = 256u - ab1 - ab2;
        unsigned eq_base = 0u;
        LAS unsigned* bmp = (LAS unsigned*)sc;
        unsigned c0 = lane < nkp ? sc[lane] : 0u, c1 = 64 + lane < nkp ? sc[64 + lane] : 0u, c2 = 128 + lane < nkp ? sc[128 + lane] : 0u, c3 = 192 + lane < nkp ? sc[192 + lane] : 0u;
        for (int it = 0; it < niter; ++it) { const int nb = (it + 1) * 256 + lane;
            const unsigned n0 = nb < nkp ? sc[nb] : 0u, n1 = nb + 64 < nkp ? sc[nb + 64] : 0u, n2 = nb + 128 < nkp ? sc[nb + 128] : 0u, n3 = nb + 192 < nkp ? sc[nb + 192] : 0u;
            const unsigned k[4] = {c0, c1, c2, c3};
            unsigned long long mt[4];
#pragma unroll
            for (int j = 0; j < 4; ++j) mt[j] = __ballot(k[j] > T16);
            if (__ballot(k[0] == T16 || k[1] == T16 || k[2] == T16 || k[3] == T16)) {
#pragma unroll
                for (int j = 0; j < 4; ++j) { const bool eq = k[j] == T16; const unsigned long long me = __ballot(eq);
                    mt[j] |= __ballot(eq && (eq_base + mbcnt64(me)) < need_eq); eq_base += (unsigned)__popcll(me); }
            }
            if (lane == 0) { *(LAS v4u*)(bmp + it * 8) = (v4u){(unsigned)mt[0], (unsigned)(mt[0] >> 32), (unsigned)mt[1], (unsigned)(mt[1] >> 32)};
                             *(LAS v4u*)(bmp + it * 8 + 4) = (v4u){(unsigned)mt[2], (unsigned)(mt[2] >> 32), (unsigned)mt[3], (unsigned)(mt[3] >> 32)}; }
            c0 = n0; c1 = n1; c2 = n2; c3 = n3; }
        asm volatile("s_waitcnt lgkmcnt(0)" ::: "memory");
        {
            const int ndw = niter * 8;
            v4u d4 = (v4u){0u, 0u, 0u, 0u};
            if (4 * lane < ndw) d4 = *(const LAS v4u*)(bmp + 4 * lane);
            const unsigned cnt = (unsigned)(__builtin_popcount(d4.x) + __builtin_popcount(d4.y) + __builtin_popcount(d4.z) + __builtin_popcount(d4.w));
            const unsigned inc = wave_scan_incl(cnt);
            unsigned pos = inc - cnt; const unsigned tot = lane_bcast(inc, 63);
            const unsigned dt = ndw > 256 ? bmp[256] : 0u;
#pragma unroll
            for (int w = 0; w < 4; ++w) { unsigned d = d4[w]; while (d) { const unsigned bit = (unsigned)__builtin_ctz(d); if (pos < 256u) idx[pos] = (u16)((4 * lane + w) * 32 + bit); ++pos; d &= d - 1u; } }
            if (lane == 0) { unsigned d = dt, ps = tot; while (d) { const unsigned bit = (unsigned)__builtin_ctz(d); if (ps < 256u) idx[ps] = (u16)(8192u + bit); ++ps; d &= d - 1u; } }
        }
        }
    }
    asm volatile("s_waitcnt lgkmcnt(0)" ::: "memory");
    if (p < NMETA && b != 0) return;
    const int row = row_of(b, p);
    if (nsel < 256) { for (int i = nsel + lane; i < 256; i += 64) idx[i] = (u16)0; asm volatile("s_waitcnt lgkmcnt(0)" ::: "memory"); }
    _Pragma("unroll 1") for (int rep9 = 0, n9 = (PROBE == 9 ? launder2() : 1); rep9 < n9; ++rep9)
    {
        const int g = lane >> 4, c = lane & 15;
        const bf16x8 zero8 = (bf16x8){0, 0, 0, 0, 0, 0, 0, 0};
        bf16x8 qB[2];
#pragma unroll
        for (int ks = 0; ks < 2; ++ks) qB[ks] = c < 8 ? *(const bf16x8*)(Z + (size_t)row * ZC + C_Q + c * 64 + 32 * ks + 8 * g) : zero8;
        const unsigned char* kbase = (const unsigned char*)(C.KATT() + (size_t)b * TPAD * 64);
        f32x4 S[16];
        {
            bf16x8 Kf0[8][2], Kf1[8][2];
#pragma unroll
            for (int t4 = 0; t4 < 8; ++t4) { const int slot = 16 * t4 + c; const int kix = (int)idx[slot];
                const unsigned ko = (unsigned)kix * 128u + 16u * (unsigned)g; Kf0[t4][0] = *(const bf16x8*)(kbase + ko); Kf0[t4][1] = *(const bf16x8*)(kbase + ko + 64u); }
#pragma unroll
            for (int t4 = 0; t4 < 8; ++t4) { const int slot = 16 * (8 + t4) + c; const int kix = (int)idx[slot];
                const unsigned ko = (unsigned)kix * 128u + 16u * (unsigned)g; Kf1[t4][0] = *(const bf16x8*)(kbase + ko); Kf1[t4][1] = *(const bf16x8*)(kbase + ko + 64u); }
#pragma unroll
            for (int t4 = 0; t4 < 8; ++t4) { f32x4 a = mfma16(Kf0[t4][0], qB[0], (f32x4){0.f, 0.f, 0.f, 0.f}); S[t4] = mfma16(Kf0[t4][1], qB[1], a); }
#pragma unroll
            for (int t4 = 0; t4 < 8; ++t4) { f32x4 a = mfma16(Kf1[t4][0], qB[0], (f32x4){0.f, 0.f, 0.f, 0.f}); S[8 + t4] = mfma16(Kf1[t4][1], qB[1], a); }
            asm volatile("" ::: "memory");
        }
        LAS unsigned char* VL = (LAS unsigned char*)sc;
        const unsigned char* vbase = (const unsigned char*)(C.VATT() + (size_t)b * TPAD * 64);
        const unsigned tr_base = (unsigned)(size_t)VL + (unsigned)(((4 * g + ((lane & 15) >> 2)) * 64 + 4 * (lane & 3)) * 2);
        v4u vv0[16], vv1[16];
#define V_GATHER(vv, hf, i0, i1) do { _Pragma("unroll") for (int i = (i0); i < (i1); ++i) { const int e = i * 64 + lane; const int sl = (hf) * 128 + (e >> 3); const int kix = (int)idx[sl]; \
            vv[i] = *(const v4u*)(vbase + ((unsigned)kix * 128u + (unsigned)(e & 7) * 16u)); } } while (0)
        V_GATHER(vv0, 0, 0, 16);
        asm volatile("" ::: "memory");
        if (nsel < 256) {
#pragma unroll
            for (int kt = 0; kt < 16; ++kt)
#pragma unroll
                for (int r = 0; r < 4; ++r) { const int slot = 16 * kt + 4 * g + r; if (slot >= nsel) S[kt][r] = -INFINITY; }
        }
        float mx = -INFINITY;
#pragma unroll
        for (int kt = 0; kt < 16; ++kt)
#pragma unroll
            for (int r = 0; r < 4; ++r) mx = fmaxf(mx, S[kt][r]);
        mx = xor16_max(mx); mx = xor32_max(mx);
        const float sl2 = 0.125f * 1.4426950408889634f, m2 = mx * sl2;
        float sum = 0.f;
#pragma unroll
        for (int kt = 0; kt < 16; ++kt)
#pragma unroll
            for (int r = 0; r < 4; ++r) { const float e = __builtin_amdgcn_exp2f(__builtin_fmaf(S[kt][r], sl2, -m2)); S[kt][r] = e; sum += e; }
        sum = xor16_sum(sum); sum = xor32_sum(sum);
        const float inv = __builtin_amdgcn_rcpf(sum);
        f32x4 O[4];
#pragma unroll
        for (int dt = 0; dt < 4; ++dt) O[dt] = (f32x4){0.f, 0.f, 0.f, 0.f};
        asm volatile("" ::: "memory");
        V_GATHER(vv1, 1, 0, 8);
        asm volatile("" ::: "memory");
#define PV_HALF(vv, hf) do { \
            _Pragma("unroll") for (int i = 0; i < 16; ++i) *(LAS v4u*)(VL + (i * 64 + lane) * 16) = vv[i]; \
            if ((hf) == 0) { asm volatile("" ::: "memory"); V_GATHER(vv1, 1, 8, 16); } \
            asm volatile("s_waitcnt lgkmcnt(0)" ::: "memory"); \
            _Pragma("unroll") for (int kk = 0; kk < 4; ++kk) { \
                const bf16x8 Bp = cat8(pack4(S[(hf) * 8 + 2 * kk]), pack4(S[(hf) * 8 + 2 * kk + 1])); \
                s16x4 lo0, hi0, lo1, hi1, lo2, hi2, lo3, hi3; \
                asm volatile("ds_read_b64_tr_b16 %0, %8 offset:%c9\n\tds_read_b64_tr_b16 %1, %8 offset:%c10\n\tds_read_b64_tr_b16 %2, %8 offset:%c11\n\tds_read_b64_tr_b16 %3, %8 offset:%c12\n\t" \
                             "ds_read_b64_tr_b16 %4, %8 offset:%c13\n\tds_read_b64_tr_b16 %5, %8 offset:%c14\n\tds_read_b64_tr_b16 %6, %8 offset:%c15\n\tds_read_b64_tr_b16 %7, %8 offset:%c16\n\ts_waitcnt lgkmcnt(0)" \
                             : "=&v"(lo0), "=&v"(hi0), "=&v"(lo1), "=&v"(hi1), "=&v"(lo2), "=&v"(hi2), "=&v"(lo3), "=&v"(hi3) \
                             : "v"(tr_base), "i"(kk * 4096), "i"(kk * 4096 + 2048), "i"(kk * 4096 + 32), "i"(kk * 4096 + 32 + 2048), "i"(kk * 4096 + 64), "i"(kk * 4096 + 64 + 2048), "i"(kk * 4096 + 96), "i"(kk * 4096 + 96 + 2048) : "memory"); \
                O[0] = mfma16(cat8(lo0, hi0), Bp, O[0]); O[1] = mfma16(cat8(lo1, hi1), Bp, O[1]); O[2] = mfma16(cat8(lo2, hi2), Bp, O[2]); O[3] = mfma16(cat8(lo3, hi3), Bp, O[3]); } \
            asm volatile("" ::: "memory"); } while (0)
        PV_HALF(vv0, 0);
        PV_HALF(vv1, 1);
#undef V_GATHER
#undef PV_HALF
        if (c < 8) {
#pragma unroll
            for (int dt = 0; dt < 4; ++dt) { const f32x4 o = O[dt] * inv; *(v2u*)(C.U() + (size_t)row * DM + c * 64 + 16 * dt + 4 * g) = (v2u){pk2(o.x, o.y), pk2(o.z, o.w)}; }
        }
    }
}

constexpr int NUNITS = 1026 * NB;
__device__ __forceinline__ void phase_seq(const Ctx& C, int l, int half) {
    unsigned* ctr = C.CTL() + 64 + 64 * l;
    unsigned* done = C.CTL() + 64 * 8 + 64 * (2 * l + half);
    unsigned* flagw = C.CTL() + 64 * (40 + 2 * l + half);
    if (C.bid == 16 || C.bid == 17) {
        const int bhl = (C.bid - 16) * 8 + C.wid;
        { unsigned char* po = prep_unit<false>(C, l, 16 * half + bhl, bhl, 512, C.lds + C.wid * SLOT, nullptr); prep_copy(C.lds + C.wid * SLOT, po, lane_now()); }
        asm volatile("s_waitcnt vmcnt(0)" ::: "memory"); __syncthreads();
        if (C.wid == 0 && lane_now() == 0) { __builtin_amdgcn_fence(__ATOMIC_RELEASE, "agent"); asm volatile("s_waitcnt vmcnt(0)" ::: "memory"); __hip_atomic_fetch_add(flagw, 1u, __ATOMIC_RELAXED, __HIP_MEMORY_SCOPE_AGENT); }
        __syncthreads();
    }
    if (C.bid < 16) { _Pragma("unroll 1") for (int rep4 = 0, n4 = (PROBE == 4 ? launder2() : 1); rep4 < n4; ++rep4) { chain_phase(C, 16 * half + C.bid, C.bid, flagw); __syncthreads(); }
        if (C.wid == 0 && lane_now() == 0) __hip_atomic_fetch_add(done, 1u, __ATOMIC_RELAXED, __HIP_MEMORY_SCOPE_AGENT); }
    LAS unsigned* shu = (LAS unsigned*)(C.lds + LDS_MISC);
    _Pragma("unroll 1") for (int rep5 = 0, n5 = ((PROBE == 5 && half == 1) ? launder2() : 1); rep5 < n5; ++rep5) {
    int bpref = (int)(((unsigned)__builtin_amdgcn_s_getreg((3 << 11) | 20) & 7u) >> 1);
    unsigned* cb = C.CTL() + 64 * (16 + 8 * l + 4 * rep5);
    auto fetch = [&](int& bp) -> unsigned {
        if (half == 0 && __hip_atomic_load(done, __ATOMIC_RELAXED, __HIP_MEMORY_SCOPE_AGENT) >= 16u) return 0xffffffffu;
        for (int t = 0; t < 4; ++t) { const unsigned u = atomicAdd(cb + bp, 1u); if (u < 1026u) return u | ((unsigned)bp << 16); bp = (bp + 1) & 3; }
        return 0xffffffffu; };
    unsigned nxt = 0xffffffffu;
    if (C.wid == 0 && lane_now() == 0) shu[0] = fetch(bpref);
    __syncthreads();
    for (;;) {
        const unsigned u = shu[0];
        __syncthreads();
        if (u == 0xffffffffu) break;
        if (C.wid == 0 && lane_now() == 0) nxt = fetch(bpref);
        const int qt = 1025 - (int)(u & 0xffffu), b = (int)(u >> 16);
        if (!(qt < 2 && b != 0)) attn_unit(C, l, b, qt);
        __syncthreads();
        if (C.wid == 0 && lane_now() == 0) shu[0] = nxt;
        __syncthreads();
    }
    }
}

template <int ACT>
__device__ __forceinline__ void meta_gemm(const Ctx& C, const bf16* A, const bf16* Bt, int K, int N, bf16* O, int ldc) {
    int lane_ = lane_now(); const int lane = lane_, g = lane >> 4, c = lane & 15, wid = C.wid;
    LAS float* red = (LAS float*)C.lds;
    const int kw = K / NWAVES;
    for (int unit = C.bid; unit < N / 16; unit += C.G) {
        const bf16* ap = A + (size_t)(MAINR + c) * K + wid * kw + 8 * g; const bf16* bp = Bt + (size_t)(unit * 16 + c) * K + wid * kw + 8 * g;
        f32x4 acc = (f32x4){0.f, 0.f, 0.f, 0.f};
        for (int k0 = 0; k0 < kw; k0 += 128) {
            bf16x8 af[4], bfr[4];
#pragma unroll
            for (int s = 0; s < 4; ++s) { af[s] = *(const bf16x8*)(ap + k0 + 32 * s); bfr[s] = *(const bf16x8*)(bp + k0 + 32 * s); }
#pragma unroll
            for (int s = 0; s < 4; ++s) acc = mfma16(af[s], bfr[s], acc);
        }
        *(LAS f32x4*)(red + (wid * 64 + lane) * 4) = acc;
        __syncthreads();
        if (wid == 0) {
            f32x4 t = acc;
#pragma unroll
            for (int w = 1; w < NWAVES; ++w) t = t + *(const LAS f32x4*)(red + (w * 64 + lane) * 4);
#pragma unroll
            for (int r = 0; r < 4; ++r) { float v = t[r]; if (ACT == 2) { v = fmaxf(v, 0.f); v = v * v; }
                O[(size_t)(MAINR + 4 * g + r) * ldc + unit * 16 + c] = (bf16)f2bf(v); }
        }
        __syncthreads();
    }
}

template <int ACT, bool OUT8>
__device__ __forceinline__ void meta_gemm8(const Ctx& C, const unsigned char* A, const unsigned char* Bt, int K, int N, void* Ov, int ldc, float omul, float hmul) {
    int lane_ = lane_now(); const int lane = lane_, g = lane >> 4, c = lane & 15, wid = C.wid;
    LAS float* red = (LAS float*)C.lds;
    const int kw = K / NWAVES;
    for (int unit = C.bid; unit < N / 16; unit += C.G) {
        const unsigned char* ap = A + (size_t)(MAINR + c) * K + wid * kw + 8 * g; const unsigned char* bp = Bt + (size_t)(unit * 16 + c) * K + wid * kw + 8 * g;
        f32x4 acc = (f32x4){0.f, 0.f, 0.f, 0.f};
        for (int k0 = 0; k0 < kw; k0 += 128) {
            long af[4], bfr[4];
#pragma unroll
            for (int s = 0; s < 4; ++s) { af[s] = *(const long*)(ap + k0 + 32 * s); bfr[s] = *(const long*)(bp + k0 + 32 * s); }
#pragma unroll
            for (int s = 0; s < 4; ++s) acc = __builtin_amdgcn_mfma_f32_16x16x32_fp8_fp8(af[s], bfr[s], acc, 0, 0, 0);
        }
        *(LAS f32x4*)(red + (wid * 64 + lane) * 4) = acc;
        __syncthreads();
        if (wid == 0) {
            f32x4 t = acc;
#pragma unroll
            for (int w = 1; w < NWAVES; ++w) t = t + *(const LAS f32x4*)(red + (w * 64 + lane) * 4);
#pragma unroll
            for (int r = 0; r < 4; ++r) { float v = t[r] * omul; if (ACT == 2) { v = fmaxf(v, 0.f); v = v * v; }
                if (OUT8) ((unsigned char*)Ov)[(size_t)(MAINR + 4 * g + r) * ldc + unit * 16 + c] = (unsigned char)(pk4_fp8(v * hmul, 0.f, 0.f, 0.f) & 0xffu);
                else ((bf16*)Ov)[(size_t)(MAINR + 4 * g + r) * ldc + unit * 16 + c] = (bf16)f2bf(v); }
        }
        __syncthreads();
    }
}

#define XLAS __attribute__((address_space(3)))
#define XB_TMO      128
#define XB_XCNT(j)  (256  + 64 * (j))
#define XB_XSUB(j)  (1280 + 64 * (j))
#define XB_XGEN(j)  (2304 + 64 * (j))
#define XB_TOP      3328
#define XB_TOPGEN   3392
#define XCD_BAR_WORDS 3456
#define XB_SPIN_CAP (1u << 18)

__device__ __forceinline__ unsigned xb_ld(unsigned* p)              { return __hip_atomic_load(p, __ATOMIC_RELAXED, __HIP_MEMORY_SCOPE_AGENT); }
__device__ __forceinline__ unsigned xb_add(unsigned* p, unsigned v) { return __hip_atomic_fetch_add(p, v, __ATOMIC_RELAXED, __HIP_MEMORY_SCOPE_AGENT); }
__device__ __forceinline__ unsigned xb_xcc_id() { return (unsigned)__builtin_amdgcn_s_getreg((3 << 11) | 20) & 0xFu; }
#define XB_SPIN(cond, bar) do { unsigned _sp = 0; while (cond) { __builtin_amdgcn_s_sleep(1); \
    if ((++_sp & 255u) == 0u) { if (xb_ld(&(bar)[XB_TMO])) break; if (_sp > XB_SPIN_CAP) { atomicAdd(&(bar)[XB_TMO], 1u); break; } } } } while (0)

struct XcdBarrier {
    unsigned* bar; unsigned x;
    int w; bool first;
    volatile XLAS unsigned* st;
};

__device__ __forceinline__ XcdBarrier xcd_barrier_post(unsigned* bar, volatile XLAS unsigned* st, int wid0) {
    XcdBarrier b; b.bar = bar; b.x = xb_xcc_id(); b.st = st; b.w = wid0; b.first = wid0 == 0 && lane_now() == 0;
    if (b.first) (void)xb_add(&bar[XB_XCNT(b.x)], 1u);
    return b;
}
__device__ __forceinline__ void xcd_barrier_complete(unsigned* bar, unsigned x, unsigned& nloc, unsigned& nx) {
    const unsigned G = gridDim.x * gridDim.y * gridDim.z;
    unsigned sum, cnt, mine, sp = 0u;
    for (;;) {
        sum = 0u; cnt = 0u; mine = 0u;
#pragma unroll
        for (unsigned j = 0; j < 16; ++j) { const unsigned c = xb_ld(&bar[XB_XCNT(j)]); sum += c; cnt += (c > 0u) ? 1u : 0u; mine = (j == x) ? c : mine; }
        if (sum == G) break;
        __builtin_amdgcn_s_sleep(1);
        if ((++sp & 255u) == 0u) { if (xb_ld(&bar[XB_TMO])) break; if (sp > XB_SPIN_CAP) { atomicAdd(&bar[XB_TMO], 1u); break; } }
    }
    nloc = mine > 0u ? mine : 1u; nx = cnt > 0u ? cnt : 1u;
}

__device__ __forceinline__ void xcd_barrier(const XcdBarrier& b) {
    asm volatile("s_waitcnt vmcnt(0)" ::: "memory");
    __syncthreads();
    if (b.w == 0 && lane_now() == 0) {
        unsigned* bar = b.bar;
        __builtin_amdgcn_s_waitcnt(0);
        unsigned nloc = b.st[0], nx = b.st[1];
        if (nloc == 0u) { xcd_barrier_complete(bar, b.x, nloc, nx); b.st[0] = nloc; b.st[1] = nx; }
        const unsigned old = xb_add(&bar[XB_XSUB(b.x)], 1u);
        const unsigned gen = old / nloc;
        if (old + 1u == (gen + 1u) * nloc) {
            __builtin_amdgcn_fence(__ATOMIC_RELEASE, "agent");
            asm volatile("s_waitcnt vmcnt(0)" ::: "memory");
            const unsigned og = xb_add(&bar[XB_TOP], 1u);
            const unsigned tg = og / nx;
            if (og + 1u == (tg + 1u) * nx) xb_add(&bar[XB_TOPGEN], 1u);
            else XB_SPIN(xb_ld(&bar[XB_TOPGEN]) == tg, bar);
            __builtin_amdgcn_fence(__ATOMIC_ACQUIRE, "agent");
            xb_add(&bar[XB_XGEN(b.x)], 1u);
            asm volatile("s_waitcnt vmcnt(0)" ::: "memory");
        } else {
            XB_SPIN(xb_ld(&bar[XB_XGEN(b.x)]) == gen, bar);
            __builtin_amdgcn_fence(__ATOMIC_ACQUIRE, "agent");
            asm volatile("s_waitcnt vmcnt(0)" ::: "memory");
        }
    }
    __syncthreads();
}

__global__ void __launch_bounds__(NT, 2) fwd_kernel(Args args) {
    extern __shared__ __attribute__((aligned(16))) unsigned char lds_raw[];
    Ctx C; C.ppass = 0; C.in = args.in; C.out = args.out; C.ws = args.ws; C.lds = (LAS unsigned char*)lds_raw;
    int wid0 = __builtin_amdgcn_readfirstlane(threadIdx.x >> 6); asm volatile("" : "+s"(wid0));
    C.wid = wid0; C.lane = lane_now(); C.tid = wid0 * 64 + C.lane; C.G = gridDim.x; C.bid = blockIdx.x;
    const int lo = args.ph_lo, hi = args.ph_hi;
    int ph = 0;
    volatile XLAS unsigned* bst = (volatile XLAS unsigned*)(C.lds + LDS_BYTES - 64);
    if (C.tid < 2) bst[C.tid] = 0u;
    __syncthreads();
    const XcdBarrier bar = xcd_barrier_post(C.CTL() + 4096, bst, wid0);
#define REPLOOP _Pragma("unroll 1") for (int rep = 0, nrep_ = launder2(); rep < nrep_; ++rep)
#define NOREP for (int rep = 0; rep < 1; ++rep)
#if PROBE == 1 || PROBE == 11 || PROBE == 12
#define REP1 REPLOOP
#else
#define REP1 NOREP
#endif
#if PROBE == 2
#define REP2 REPLOOP
#else
#define REP2 NOREP
#endif
#if PROBE == 3
#define REP3 REPLOOP
#else
#define REP3 NOREP
#endif
#ifndef PHSEL
#define PHSEL 0xffff
#endif
#define PHASE_BEGIN if (ph >= lo && ph < hi) { { const int l_ = lane_now(); C.lane = l_; C.wid = wid0; C.tid = wid0 * 64 + l_; }
#define PHASE_END(last) if (ph + 1 < hi && !(last)) xcd_barrier(bar); } ++ph;

    PHASE_BEGIN if (PHSEL & (1 << 0)) { phase_prologue(C); phase_norm<false, false>(C, C.I(I_X), nullptr, nullptr, nullptr, C.I(I_NMPRE), C.I(I_META)); } PHASE_END(false)
    for (int l = 0; l < NL; ++l) {
        PHASE_BEGIN if (PHSEL & (1 << 2)) { REP3 { pg8::Gemm g{C.U(), (const bf16*)(C.ws + WS_WIN) + (size_t)l * ZC * 1024, MAINR, ZC, 1024}; pg8::StaticOrder S; S.init(MAINR, ZC, C.G, C.bid);
            pg8::EpiBf16<0> E{C.Z(), ZC}; pg8::gemm_phase<pg8::EpiBf16<0>, pg8::StaticOrder, true, true>(C.lds, g, S, E, C.tid); __syncthreads(); } meta_gemm<0>(C, C.U(), (const bf16*)(C.ws + WS_WIN) + (size_t)l * ZC * 1024, 1024, ZC, C.Z(), ZC); } PHASE_END(false)
        PHASE_BEGIN if (PHSEL & (1 << 3)) { REP2 phase_post(C, l, rep == 0); } PHASE_END(false)
        PHASE_BEGIN if (PHSEL & (1 << 4)) { REP1 { C.ppass = rep; phase_prep(C, l, 0); C.ppass = 0; } } PHASE_END(false)
        PHASE_BEGIN if (PHSEL & (1 << 10)) phase_seq(C, l, 0); PHASE_END(false)
        PHASE_BEGIN if (PHSEL & (1 << 4)) { REP1 { C.ppass = rep; phase_prep(C, l, 1); C.ppass = 0; } } PHASE_END(false)
        PHASE_BEGIN if (PHSEL & (1 << 10)) phase_seq(C, l, 1); PHASE_END(false)
        PHASE_BEGIN if (PHSEL & (1 << 5)) { REP3 { pg8::Gemm g{C.U(), (const bf16*)(C.ws + WS_WO) + (size_t)l * 1024 * 1024, MAINR, DM, 1024}; pg8::StaticOrder S; S.init(MAINR, DM, C.G, C.bid);
            pg8::EpiBf16<0> E{C.Z(), DM}; pg8::gemm_phase<pg8::EpiBf16<0>, pg8::StaticOrder, true, true>(C.lds, g, S, E, C.tid); __syncthreads(); } meta_gemm<0>(C, C.U(), (const bf16*)(C.ws + WS_WO) + (size_t)l * 1024 * 1024, 1024, DM, C.Z(), DM); } PHASE_END(false)
        PHASE_BEGIN if (PHSEL & (1 << 6)) { void* hmid = (l + 1 == NL) ? (void*)(C.ws + WS_HMID) : (void*)C.out;
            if (l == 0) phase_norm<false, true>(C, C.I(I_X), hmid, C.Z(), C.I(I_NMPOST) + l * DM, C.I(I_NFPRE) + l * DM, nullptr, true);
            else phase_norm<true, true>(C, C.out, hmid, C.Z(), C.I(I_NMPOST) + l * DM, C.I(I_NFPRE) + l * DM, nullptr, true); } PHASE_END(false)
        PHASE_BEGIN if (PHSEL & (1 << 7)) { REP3 { pg8::Gemm g{(const bf16*)C.U(), (const bf16*)(C.ws + WS_WUP + (size_t)l * FF * 1024), MAINR, FF, 512}; pg8::StaticOrder S; S.init(MAINR, FF, C.G, C.bid);
            pg8::EpiFp8<2> E{C.ws + WS_HID, FF, S8_H}; pg8::gemm_phase<pg8::EpiFp8<2>, pg8::StaticOrder, true, true, true, E8_WU, E8_X>(C.lds, g, S, E, C.tid); __syncthreads(); }
            meta_gemm8<2, true>(C, (const unsigned char*)C.U(), C.ws + WS_WUP + (size_t)l * FF * 1024, 1024, FF, C.ws + WS_HID, FF, 1.f / (S8_X * S8_WU), S8_H); } PHASE_END(false)
        PHASE_BEGIN if (PHSEL & (1 << 8)) { REP3 { pg8::Gemm g{(const bf16*)(C.ws + WS_HID), (const bf16*)(C.ws + WS_WDN + (size_t)l * DM * FF), MAINR, DM, FF / 2}; pg8::StaticOrder S; S.init(MAINR, DM, C.G, C.bid);
            pg8::EpiBf16<0> E{(bf16*)(C.ws + WS_TMP2), DM}; pg8::gemm_phase<pg8::EpiBf16<0>, pg8::StaticOrder, true, true, true, E8_WD, E8_H>(C.lds, g, S, E, C.tid); __syncthreads(); }
            meta_gemm8<0, false>(C, C.ws + WS_HID, C.ws + WS_WDN + (size_t)l * DM * FF, FF, DM, C.ws + WS_TMP2, DM, 1.f / (S8_H * S8_WD), 1.f); } PHASE_END(false)
        PHASE_BEGIN if (PHSEL & (1 << 9)) { if (l + 1 < NL) phase_norm<true, true>(C, C.out, C.out, (const bf16*)(C.ws + WS_TMP2), C.I(I_NFPOST) + l * DM, C.I(I_NMPRE) + (l + 1) * DM);
            else phase_norm<true, false>(C, C.ws + WS_HMID, C.out, (const bf16*)(C.ws + WS_TMP2), C.I(I_NFPOST) + l * DM, nullptr); } PHASE_END(l + 1 == NL)
    }
}

extern "C" void kernel_launch(void* const* d_in, const int* in_sizes, int n_in, void* d_out, int out_size, void* d_ws, size_t ws_size, hipStream_t stream) {
    static int grid = 0;
    if (grid == 0) {
        if (n_in != 30 || out_size != NB * SEQ * DM || ws_size < WS_END) { fprintf(stderr, "kernel_launch: unexpected shapes (n_in %d out %d ws %zu need %zu)\n", n_in, out_size, ws_size, (size_t)WS_END); grid = -1; return; }
        int dev = 0, cus = 0, per_cu = 0;
        (void)hipGetDevice(&dev); (void)hipDeviceGetAttribute(&cus, hipDeviceAttributeMultiprocessorCount, dev);
        (void)hipFuncSetAttribute((const void*)fwd_kernel, hipFuncAttributeMaxDynamicSharedMemorySize, LDS_BYTES);
        (void)hipOccupancyMaxActiveBlocksPerMultiprocessor(&per_cu, (const void*)fwd_kernel, NT, LDS_BYTES);
        (void)hipGetLastError();
        grid = cus;
        fprintf(stderr, "kernel_launch: cus %d per_cu %d ws %zu\n", cus, per_cu, ws_size);
    }
    if (grid < 0) return;
    (void)hipMemsetAsync((char*)d_ws + WS_CTL, 0, CTL_BYTES, stream);
    Args a{};
    for (int i = 0; i < 30; ++i) a.in[i] = (const float*)d_in[i];
    a.out = (float*)d_out; a.ws = (unsigned char*)d_ws;
    a.ph_lo = 0; a.ph_hi = 1000;
    void* kargs[] = {&a};
    hipError_t e = hipLaunchCooperativeKernel((const void*)fwd_kernel, dim3(grid), dim3(NT), kargs, LDS_BYTES, stream);
    if (e != hipSuccess) fprintf(stderr, "kernel_launch: cooperative launch failed: %s\n", hipGetErrorString(e));
}
```

```cpp
#include <hip/hip_runtime.h>
#include <hip/hip_cooperative_groups.h>
#include <cstdio>
#include <cstdint>
namespace cg = cooperative_groups;
namespace pg8 {
#define PG8_LAS __attribute__((address_space(3)))
typedef unsigned short bf16_t;
typedef short bf16x8 __attribute__((ext_vector_type(8)));
typedef float f32x4 __attribute__((ext_vector_type(4)));
typedef unsigned u32x4 __attribute__((ext_vector_type(4)));
typedef int i32x8 __attribute__((ext_vector_type(8)));
typedef int i32x4 __attribute__((ext_vector_type(4)));
constexpr int BM = 256, BK = 64, HALF = 128, HTB = HALF * BK * 2  , STAGE_BYTES = 8 * HTB, NXCD = 8, WGM = 4;

__host__ __device__ __forceinline__ int lds_byte(int r, int c) { const int st = (r >> 4) * 2 + (c >> 5), rr = r & 15, cc = c & 31, ob = rr * 64 + cc * 2; return st * 1024 + (ob ^ (((ob >> 9) & 1) << 5)); }
__host__ __device__ __forceinline__ void stage_rc(int b, int& R, int& C) { const int st = b / 1024, sb = b % 1024, swz = sb ^ (((sb >> 9) & 1) << 5); R = (st >> 1) * 16 + swz / 64; C = (st & 1) * 32 + (swz % 64) / 2; }
__host__ __device__ __forceinline__ int perm32(int rho) { const int n = rho >> 4, i = rho & 15; return 8 * (i >> 2) + 4 * n + (i & 3); }

struct Unit { int pm, pn; };
struct Gemm { const bf16_t* A; const bf16_t* Bt; int M, N, K; };

struct StaticOrder {
    int nM, nN, nwg, G, c;
    __host__ __device__ void init(int M, int N, int G_, int c_) { nM = M / BM; nN = N / BM; nwg = nM * nN; G = G_; c = c_; }
    __host__ __device__ bool next(int i, Unit& u) const {
        const long L = (long)i * G + c; if (L >= nwg) return false;
        int wgid = (int)L; { const int q = nwg / NXCD, r = nwg % NXCD, xcd = wgid % NXCD, off = wgid / NXCD; wgid = (xcd < r ? xcd * (q + 1) : r * (q + 1) + (xcd - r) * q) + off; }
        const int nig = WGM * nN, gid = wgid / nig, fm = gid * WGM, gsz = (nM - fm) < WGM ? (nM - fm) : WGM;
        u.pm = fm + ((wgid % nig) % gsz); u.pn = (wgid % nig) / gsz; return true;
    }
    __device__ __forceinline__ void a_ready(const Unit&) const {}
    __device__ __forceinline__ void done(const Unit&) const {}
};

__device__ __forceinline__ unsigned cvt_pk_bf16(float lo, float hi) { unsigned r; asm volatile("v_cvt_pk_bf16_f32 %0, %1, %2" : "=v"(r) : "v"(lo), "v"(hi)); return r; }
typedef float f32x2 __attribute__((ext_vector_type(2)));
template <int ACT> struct EpiBf16 {
    static constexpr bool PERM = true, AFTER_DRAIN = false;
    bf16_t* O; int ldc;
    __device__ __forceinline__ void operator()(const f32x4 (&acc)[2][2][4][2], const Unit& u, int wr, int wc, int fr, int fq) const {
        const int row0 = u.pm * BM + wr * 64 + fr; const int col0 = u.pn * BM + wc * 32 + 8 * fq;
#pragma unroll
        for (int ai = 0; ai < 2; ++ai)
#pragma unroll
            for (int m = 0; m < 4; ++m) { bf16_t* rowp = O + (size_t)(row0 + ai * HALF + m * 16) * ldc + col0;
#pragma unroll
                for (int bj = 0; bj < 2; ++bj) { f32x4 v0 = acc[ai][bj][m][0], v1 = acc[ai][bj][m][1];
                    if (ACT == 2) {
#pragma unroll
                        for (int e = 0; e < 4; ++e) { float a = fmaxf(v0[e], 0.f), b = fmaxf(v1[e], 0.f); v0[e] = a * a; v1[e] = b * b; } }
                    u32x4 w; w.x = cvt_pk_bf16(v0[0], v0[1]); w.y = cvt_pk_bf16(v0[2], v0[3]); w.z = cvt_pk_bf16(v1[0], v1[1]); w.w = cvt_pk_bf16(v1[2], v1[3]);
                    *(u32x4*)(rowp + bj * HALF) = w; } }
    }
};
typedef unsigned u32x2 __attribute__((ext_vector_type(2)));
template <int ACT> struct EpiFp8 {
    static constexpr bool PERM = true, AFTER_DRAIN = false;
    unsigned char* O; int ldc; float mul;
    __device__ __forceinline__ void operator()(const f32x4 (&acc)[2][2][4][2], const Unit& u, int wr, int wc, int fr, int fq) const {
        const int row0 = u.pm * BM + wr * 64 + fr; const int col0 = u.pn * BM + wc * 32 + 8 * (fq & ~1);
        const float sm = __builtin_amdgcn_sqrtf(mul), cap = __builtin_amdgcn_sqrtf(448.f);
#pragma unroll
        for (int ai = 0; ai < 2; ++ai)
#pragma unroll
            for (int mp = 0; mp < 2; ++mp) {
                unsigned char* rowp = O + (size_t)(row0 + ai * HALF + (2 * mp + (fq & 1)) * 16) * ldc + col0;
#pragma unroll
                for (int bj = 0; bj < 2; ++bj) {
                    unsigned w[2][2];
#pragma unroll
                    for (int mq = 0; mq < 2; ++mq) { f32x4 v0 = acc[ai][bj][2 * mp + mq][0], v1 = acc[ai][bj][2 * mp + mq][1];
#pragma unroll
                        for (int e = 0; e < 4; ++e) {
                            if (ACT == 2) { const float a = __builtin_amdgcn_fmed3f(v0[e] * sm, 0.f, cap), b = __builtin_amdgcn_fmed3f(v1[e] * sm, 0.f, cap); v0[e] = a * a; v1[e] = b * b; }
                            else { v0[e] = __builtin_amdgcn_fmed3f(v0[e] * mul, -448.f, 448.f); v1[e] = __builtin_amdgcn_fmed3f(v1[e] * mul, -448.f, 448.f); } }
                        int lo = __builtin_amdgcn_cvt_pk_fp8_f32(v0[0], v0[1], 0, false); lo = __builtin_amdgcn_cvt_pk_fp8_f32(v0[2], v0[3], lo, true);
                        int hi = __builtin_amdgcn_cvt_pk_fp8_f32(v1[0], v1[1], 0, false); hi = __builtin_amdgcn_cvt_pk_fp8_f32(v1[2], v1[3], hi, true);
                        w[mq][0] = (unsigned)lo; w[mq][1] = (unsigned)hi; }
                    const u32x2 sl = __builtin_amdgcn_permlane16_swap(w[0][0], w[1][0], false, false), sh = __builtin_amdgcn_permlane16_swap(w[0][1], w[1][1], false, false);
                    *(u32x4*)(rowp + bj * HALF) = (u32x4){sl.x, sh.x, sl.y, sh.y}; } }
    }
};
template <class Epi, class Sched, bool ALIGN_EPI = false, bool SP2 = false, bool FP8 = false, int SCW = 0x7f7f7f7f, int SCA = 0x7f7f7f7f>
__device__ __forceinline__ void gemm_phase(PG8_LAS unsigned char* lds, const Gemm g, const Sched& S, const Epi& E, const int tid_in) {
    int tid_l_ = tid_in; asm volatile("" : "+v"(tid_l_));
    const int tid = tid_l_, wid = __builtin_amdgcn_readfirstlane(tid >> 6), lane = tid & 63, wr = wid >> 2, wc = wid & 3, fr = lane & 15, fq = lane >> 4;
    const int K = g.K, nt = K / BK;
    unsigned voffA[2], voffB[2];
#pragma unroll
    for (int i = 0; i < 2; ++i) { int R, C; stage_rc(tid * 16 + i * 8192, R, C); const int Rb = Epi::PERM ? ((R & ~31) + perm32(R & 31)) : R;
        voffA[i] = (unsigned)(R * K + C) * 2u; voffB[i] = (unsigned)(Rb * K + C) * 2u; }
    const size_t kstep = (size_t)(BK * 2);
    const size_t hstep = (size_t)HALF * K * 2;
    const size_t tstep = 2 * hstep;
    const unsigned ldsw = (unsigned)wid * 1024u;
    const int aoff = lds_byte(wr * 64 + fr, fq * 8), boff = lds_byte(wc * 32 + fr, fq * 8);
#define PG8_SA(b, h) (((b) * 2 + (h)) * HTB)
#define PG8_SB(b, h) ((4 + (b) * 2 + (h)) * HTB)
#define PG8_STAGE(bufoff, gbase, voff) do { _Pragma("unroll") for (int _i = 0; _i < 2; ++_i) \
        __builtin_amdgcn_global_load_lds((const unsigned*)((const char*)(gbase) + (voff)[_i]), (PG8_LAS unsigned*)(lds + (bufoff) + ldsw + _i * 8192), 16, 0, 0); } while (0)
#define PG8_LD8(off) __builtin_shufflevector(*(const PG8_LAS i32x4*)(lds + (off)), *(const PG8_LAS i32x4*)(lds + (off) + 1024), 0, 1, 2, 3, 4, 5, 6, 7)
#define PG8_LDA(dst, b, h) do { if constexpr (FP8) { _Pragma("unroll") for (int m = 0; m < 4; ++m) dst##8[m] = PG8_LD8(PG8_SA(b, h) + aoff + m * 2048); } else { \
        _Pragma("unroll") for (int m = 0; m < 4; ++m) _Pragma("unroll") for (int k = 0; k < 2; ++k) dst[m][k] = *(const PG8_LAS bf16x8*)(lds + PG8_SA(b, h) + aoff + m * 2048 + k * 1024); } } while (0)
#define PG8_LDB(dst, b, h) do { if constexpr (FP8) { _Pragma("unroll") for (int n = 0; n < 2; ++n) dst##8[n] = PG8_LD8(PG8_SB(b, h) + boff + n * 2048); } else { \
        _Pragma("unroll") for (int n = 0; n < 2; ++n) _Pragma("unroll") for (int k = 0; k < 2; ++k) dst[n][k] = *(const PG8_LAS bf16x8*)(lds + PG8_SB(b, h) + boff + n * 2048 + k * 1024); } } while (0)
#define PG8_MMA(ai, bj, At, Bt) do { __builtin_amdgcn_s_setprio(1); if constexpr (FP8) { _Pragma("unroll") for (int m = 0; m < 4; ++m) _Pragma("unroll") for (int n = 0; n < 2; ++n) \
        asm volatile("v_mfma_scale_f32_16x16x128_f8f6f4 %0, %1, %2, %0, %3, %4 op_sel_hi:[0,0,0]" : "+v"(acc[ai][bj][m][n]) : "v"(Bt##8[n]), "v"(At##8[m]), "v"(scw_), "v"(sca_)); } else { \
        _Pragma("unroll") for (int m = 0; m < 4; ++m) _Pragma("unroll") for (int n = 0; n < 2; ++n) _Pragma("unroll") for (int k = 0; k < 2; ++k) \
        acc[ai][bj][m][n] = __builtin_amdgcn_mfma_f32_16x16x32_bf16(Bt[n][k], At[m][k], acc[ai][bj][m][n], 0, 0, 0); } __builtin_amdgcn_s_setprio(0); } while (0)
#define PG8_WAIT_V(n) asm volatile("s_waitcnt vmcnt(" #n ")" ::: "memory")
#define PG8_WAIT_L(n) asm volatile("s_waitcnt lgkmcnt(" #n ")" ::: "memory")
#define PG8_BAR __builtin_amdgcn_s_barrier()
#define PG8_SCHED __builtin_amdgcn_sched_barrier(0)
    Unit cur, nxt; int ui = 0;
    if (!S.next(0, cur)) return;
    f32x4 acc[2][2][4][2];
#pragma unroll
    for (int a = 0; a < 2; ++a)
#pragma unroll
        for (int b = 0; b < 2; ++b)
#pragma unroll
            for (int m = 0; m < 4; ++m)
#pragma unroll
                for (int n = 0; n < 2; ++n) acc[a][b][m][n] = (f32x4){0.f, 0.f, 0.f, 0.f};
    int scw_ = SCW, sca_ = SCA; asm volatile("" : "+v"(scw_), "+v"(sca_));
    bf16x8 At[4][2], B0[2][2], B1[2][2]; i32x8 At8[4], B08[2], B18[2];
    const char* cA = (const char*)g.A + (size_t)cur.pm * tstep; const char* cB = (const char*)g.Bt + (size_t)cur.pn * tstep;
    S.a_ready(cur);
    if constexpr (SP2) {
        PG8_STAGE(PG8_SB(0, 0), cB, voffB); PG8_STAGE(PG8_SB(0, 1), cB + hstep, voffB); PG8_STAGE(PG8_SA(0, 0), cA, voffA); PG8_STAGE(PG8_SA(0, 1), cA + hstep, voffA);
        if (wr == 1) PG8_BAR;
        PG8_WAIT_V(2); PG8_BAR;
        PG8_STAGE(PG8_SB(1, 0), cB + kstep, voffB); PG8_STAGE(PG8_SA(1, 0), cA + kstep, voffA); PG8_STAGE(PG8_SB(1, 1), cB + hstep + kstep, voffB);
        PG8_WAIT_V(6); PG8_BAR;
    } else {
        PG8_STAGE(PG8_SB(0, 0), cB, voffB); PG8_STAGE(PG8_SA(0, 0), cA, voffA); PG8_STAGE(PG8_SB(0, 1), cB + hstep, voffB); PG8_STAGE(PG8_SA(0, 1), cA + hstep, voffA);
        if (wr == 1) PG8_BAR;
        PG8_WAIT_V(4); PG8_BAR;
        PG8_STAGE(PG8_SB(1, 0), cB + kstep, voffB); PG8_STAGE(PG8_SA(1, 0), cA + kstep, voffA); PG8_STAGE(PG8_SB(1, 1), cB + hstep + kstep, voffB);
        PG8_WAIT_V(6); PG8_BAR;
    }
    for (;;) {
        const bool has_next = S.next(ui + 1, nxt);
        const char* nA = has_next ? (const char*)g.A + (size_t)nxt.pm * tstep : cA; const char* nB = has_next ? (const char*)g.Bt + (size_t)nxt.pn * tstep : cB;
        for (int t = 0; t < nt; t += 2) {
            const bool last = (t == nt - 2);
            const char* a1 = cA + (size_t)(t + 1) * kstep;
            const char* a2 = last ? nA : cA + (size_t)(t + 2) * kstep; const char* b2 = last ? nB : cB + (size_t)(t + 2) * kstep;
            const char* a3 = a2 + kstep; const char* b3 = b2 + kstep;
            if (last && has_next) S.a_ready(nxt);
            if constexpr (SP2) {
            PG8_LDB(B0, 0, 0); PG8_LDB(B1, 0, 1); PG8_SCHED; PG8_LDA(At, 0, 0); PG8_STAGE(PG8_SA(1, 1), a1 + hstep, voffA);
            PG8_WAIT_V(8); PG8_WAIT_L(0); PG8_BAR; PG8_MMA(0, 0, At, B0); PG8_MMA(0, 1, At, B1); PG8_BAR; PG8_SCHED;
            PG8_LDA(At, 0, 1); PG8_STAGE(PG8_SB(0, 0), b2, voffB); PG8_STAGE(PG8_SB(0, 1), b2 + hstep, voffB); PG8_STAGE(PG8_SA(0, 0), a2, voffA);
            PG8_WAIT_V(8); PG8_WAIT_L(0); PG8_BAR; PG8_MMA(1, 0, At, B0); PG8_MMA(1, 1, At, B1); PG8_BAR; PG8_SCHED;
            PG8_LDB(B0, 1, 0); PG8_LDB(B1, 1, 1); PG8_SCHED; PG8_LDA(At, 1, 0); PG8_STAGE(PG8_SA(0, 1), a2 + hstep, voffA);
            PG8_WAIT_V(8); PG8_WAIT_L(0); PG8_BAR; PG8_MMA(0, 0, At, B0); PG8_MMA(0, 1, At, B1); PG8_BAR; PG8_SCHED;
            PG8_LDA(At, 1, 1); PG8_STAGE(PG8_SB(1, 0), b3, voffB); PG8_STAGE(PG8_SB(1, 1), b3 + hstep, voffB); PG8_STAGE(PG8_SA(1, 0), a3, voffA);
            PG8_WAIT_V(8); PG8_WAIT_L(0); PG8_BAR; PG8_MMA(1, 0, At, B0); PG8_MMA(1, 1, At, B1); PG8_BAR; PG8_SCHED;
            } else {
            PG8_LDB(B0, 0, 0); PG8_SCHED; PG8_LDA(At, 0, 0); PG8_STAGE(PG8_SA(1, 1), a1 + hstep, voffA);
            PG8_WAIT_L(8); PG8_BAR; PG8_WAIT_L(0); PG8_MMA(0, 0, At, B0); PG8_BAR; PG8_SCHED;
            PG8_LDB(B1, 0, 1); PG8_STAGE(PG8_SB(0, 0), b2, voffB);
            PG8_BAR; PG8_WAIT_L(0); PG8_MMA(0, 1, At, B1); PG8_BAR;
            PG8_LDA(At, 0, 1); PG8_STAGE(PG8_SA(0, 0), a2, voffA);
            PG8_BAR; PG8_WAIT_L(0); PG8_MMA(1, 0, At, B0); PG8_BAR; PG8_SCHED;
            PG8_STAGE(PG8_SB(0, 1), b2 + hstep, voffB);
            PG8_WAIT_V(6); PG8_BAR; PG8_MMA(1, 1, At, B1); PG8_BAR;
            PG8_LDB(B0, 1, 0); PG8_SCHED; PG8_LDA(At, 1, 0); PG8_STAGE(PG8_SA(0, 1), a2 + hstep, voffA);
            PG8_WAIT_L(8); PG8_BAR; PG8_WAIT_L(0); PG8_MMA(0, 0, At, B0); PG8_BAR; PG8_SCHED;
            PG8_LDB(B1, 1, 1); PG8_STAGE(PG8_SB(1, 0), b3, voffB);
            PG8_BAR; PG8_WAIT_L(0); PG8_MMA(0, 1, At, B1); PG8_BAR;
            PG8_LDA(At, 1, 1); PG8_STAGE(PG8_SA(1, 0), a3, voffA);
            PG8_BAR; PG8_WAIT_L(0); PG8_MMA(1, 0, At, B0); PG8_BAR; PG8_SCHED;
            PG8_STAGE(PG8_SB(1, 1), b3 + hstep, voffB);
            PG8_WAIT_V(6); PG8_BAR; PG8_MMA(1, 1, At, B1); PG8_BAR;
            }
        }
        if constexpr (FP8) asm volatile("s_nop 15\n\ts_nop 15" ::: "memory");
        if constexpr (ALIGN_EPI) { if (wr == 0) PG8_BAR; }
        if constexpr (!Epi::AFTER_DRAIN) { E(acc, cur, wr, wc, fr, fq); S.done(cur); }
        if (!has_next) break;
#pragma unroll
        for (int a = 0; a < 2; ++a)
#pragma unroll
            for (int b = 0; b < 2; ++b)
#pragma unroll
                for (int m = 0; m < 4; ++m)
#pragma unroll
                    for (int n = 0; n < 2; ++n) acc[a][b][m][n] = (f32x4){0.f, 0.f, 0.f, 0.f};
        cur = nxt; cA = nA; cB = nB; ++ui;
        if constexpr (ALIGN_EPI) { if (wr == 1) PG8_BAR; }
    }
    PG8_WAIT_V(0);
    if constexpr (!ALIGN_EPI) { if (wr == 0) PG8_BAR; }
    PG8_BAR;
    if constexpr (Epi::AFTER_DRAIN) { E.fused(acc, cur, wr, wc, fr, fq, lds, wid, lane); S.done(cur); }
#undef PG8_SA
#undef PG8_SB
#undef PG8_STAGE
#undef PG8_LDA
#undef PG8_LDB
#undef PG8_MMA
#undef PG8_LD8
#undef PG8_WAIT_V
#undef PG8_WAIT_L
#undef PG8_BAR
#undef PG8_SCHED
}
}

#ifndef PROBE
#define PROBE 0
#endif
#define LAS __attribute__((address_space(3)))
typedef unsigned short bf16;
typedef unsigned short u16;
typedef _Float16 h2v __attribute__((ext_vector_type(2)));
typedef short s2v __attribute__((ext_vector_type(2)));
typedef unsigned v4u __attribute__((ext_vector_type(4)));
typedef unsigned v2u __attribute__((ext_vector_type(2)));
typedef float f32x4 __attribute__((ext_vector_type(4)));
typedef float f32x16 __attribute__((ext_vector_type(16)));
typedef short bf16x8 __attribute__((ext_vector_type(8)));

constexpr int NB = 4, SEQ = 8192, NMETA = 16, TT = 8208, DM = 1024, NL = 2;
constexpr int MAINR = 32768, RREAL = 32784, RPAD = 33024;
constexpr int ZC = 3072, LC = 2048, FF = 4096;
constexpr int C_Q = 0, C_CKV = 512, C_QI = 768, C_KI = 1024, C_WI = 1088, C_R = 1152, C_K = 1664, C_V = 2176, C_XW = 2688, C_XA = 2752, C_XG = 2816, C_XV = 2976;
constexpr int TPAD = 8320;
constexpr float NORM_EPS = 1e-6f, GN_EPS = 64e-5f;
constexpr int NT = 512, NWAVES = 8;
constexpr int LDS_BYTES = 155648;

constexpr size_t MiB = 1u << 20;
constexpr size_t WS_CTL = 0, CTL_BYTES = 65536;
constexpr size_t WS_ROPE = 1 * MiB;
constexpr size_t WS_HX = 2 * MiB;
constexpr size_t WS_WIN = 4 * MiB, WS_WO = 16 * MiB, WS_WUP = 20 * MiB, WS_WDN = 36 * MiB;
constexpr size_t WS_KATT = 52 * MiB, WS_VATT = 57 * MiB, WS_KI = 62 * MiB;
constexpr size_t WS_VF = 67 * MiB;
constexpr size_t WS_U = 100 * MiB;
constexpr size_t WS_Z = 165 * MiB;
constexpr size_t WS_L = WS_Z + (size_t)RPAD * ZC * 2;
constexpr size_t WS_HID = WS_Z;
constexpr size_t WS_TMP2 = WS_HID + (size_t)RPAD * FF * 2;
constexpr size_t WS_HMID = WS_HID + (size_t)RPAD * FF;
static_assert(WS_HMID + (size_t)MAINR * DM * 2 <= WS_TMP2 && WS_HMID >= WS_Z + (size_t)RPAD * DM * 2, "ws map");
constexpr size_t WS_ACT = WS_L + (size_t)RPAD * LC * 2;
constexpr int ACTC = 320, OPSB = 16384;
constexpr size_t WS_OPS = WS_L, WS_WLT = 3 * MiB, WS_WKV = 3 * MiB + 768 * 1024;
constexpr size_t WS_END = WS_ACT + (size_t)RPAD * ACTC * 2;
static_assert((size_t)16 * 513 * OPSB <= (size_t)RPAD * LC * 2, "ops fits");
static_assert(WS_END <= 512 * MiB, "ws total");
static_assert(WS_TMP2 + (size_t)RPAD * DM * 2 <= WS_ACT, "ws map");
static_assert(WS_U + (size_t)RPAD * DM * 2 <= WS_Z, "ws map");
static_assert(WS_VF + (size_t)RPAD * 512 * 2 <= WS_U, "ws map");

struct Args { const float* in[30]; float* out; unsigned char* ws; int ph_lo, ph_hi; };

enum { I_X = 0, I_META, I_NMPRE, I_NMPOST, I_NFPRE, I_NFPOST, I_WIN, I_MU, I_KVN, I_WUK, I_WUV, I_IDXG, I_IDXB, I_W0, I_W2, I_A0, I_A2, I_G2,
       I_KK, I_KA, I_RK, I_LNW, I_LNB, I_WINV, I_MUV, I_V0, I_V2, I_WO, I_WUP, I_WDN };

__device__ __forceinline__ float bf2f(bf16 b) { return __uint_as_float((unsigned)b << 16); }
typedef float f32x2h __attribute__((ext_vector_type(2)));
typedef __bf16 bf16x2h __attribute__((ext_vector_type(2)));
__device__ __forceinline__ unsigned pk2(float lo, float hi) { const bf16x2h v = __builtin_convertvector((f32x2h){lo, hi}, bf16x2h); return __builtin_bit_cast(unsigned, v); }
constexpr float S8_X = 16.f, S8_WU = 256.f, S8_H = 4.f, S8_WD = 512.f;
constexpr int E8_X = 0x7b7b7b7b, E8_WU = 0x77777777, E8_H = 0x7d7d7d7d, E8_WD = 0x76767676;
__device__ __forceinline__ float sat8(float x) { return __builtin_amdgcn_fmed3f(x, -448.f, 448.f); }
__device__ __forceinline__ unsigned pk4_fp8(float a, float b, float c, float d) { int p = __builtin_amdgcn_cvt_pk_fp8_f32(sat8(a), sat8(b), 0, false); p = __builtin_amdgcn_cvt_pk_fp8_f32(sat8(c), sat8(d), p, true); return (unsigned)p; }
__device__ __forceinline__ unsigned f2bf(float f) { return (unsigned)__builtin_bit_cast(unsigned short, (__bf16)f); }
template <int CTRL> __device__ __forceinline__ float dpp_f(float v) { return __int_as_float(__builtin_amdgcn_update_dpp(0, __float_as_int(v), CTRL, 0xf, 0xf, true)); }
__device__ __forceinline__ float row16_sum(float v) { v += dpp_f<0xB1>(v); v += dpp_f<0x4E>(v); v += dpp_f<0x141>(v); v += dpp_f<0x140>(v); return v; }
__device__ __forceinline__ float quad_sum(float v) { v += dpp_f<0xB1>(v); v += dpp_f<0x4E>(v); return v; }
template <int CTRL, int RM> __device__ __forceinline__ unsigned dpp_u(unsigned v) { return (unsigned)__builtin_amdgcn_update_dpp(0, (int)v, CTRL, RM, 0xf, false); }
__device__ __forceinline__ unsigned wave_scan_incl(unsigned x) {
    x += dpp_u<0x111, 0xf>(x); x += dpp_u<0x112, 0xf>(x); x += dpp_u<0x114, 0xf>(x); x += dpp_u<0x118, 0xf>(x);
    x += dpp_u<0x142, 0xa>(x); x += dpp_u<0x143, 0xc>(x); return x; }
__device__ __forceinline__ unsigned lane_bcast(unsigned v, int srclane) { return (unsigned)__builtin_amdgcn_readlane((int)v, srclane); }
typedef unsigned u2v __attribute__((ext_vector_type(2)));
__device__ __forceinline__ float xor16_sum(float v) { const u2v r = __builtin_amdgcn_permlane16_swap(__float_as_uint(v), __float_as_uint(v), false, false); return __uint_as_float(r.x) + __uint_as_float(r.y); }
__device__ __forceinline__ float xor32_sum(float v) { const u2v r = __builtin_amdgcn_permlane32_swap(__float_as_uint(v), __float_as_uint(v), false, false); return __uint_as_float(r.x) + __uint_as_float(r.y); }
__device__ __forceinline__ float xor16_max(float v) { const u2v r = __builtin_amdgcn_permlane16_swap(__float_as_uint(v), __float_as_uint(v), false, false); return fmaxf(__uint_as_float(r.x), __uint_as_float(r.y)); }
__device__ __forceinline__ float xor32_max(float v) { const u2v r = __builtin_amdgcn_permlane32_swap(__float_as_uint(v), __float_as_uint(v), false, false); return fmaxf(__uint_as_float(r.x), __uint_as_float(r.y)); }
__device__ __forceinline__ float wave_sum(float v) { v = row16_sum(v); v = xor16_sum(v); v = xor32_sum(v); return v; }
__device__ __forceinline__ float wave_max(float v) {
#pragma unroll
    for (int o = 1; o < 64; o <<= 1) v = fmaxf(v, __shfl_xor(v, o));
    return v;
}
__device__ __forceinline__ int row_of(int b, int p) { return p < NMETA ? MAINR + p : b * SEQ + (p - NMETA); }
__device__ __forceinline__ float relu_i(float x) { const int xi = __float_as_int(x); return __int_as_float(xi > 0 ? xi : 0); }
__device__ __forceinline__ float sigmoidf_(float x) { return __builtin_amdgcn_rcpf(1.f + __expf(-x)); }

__device__ __forceinline__ int lane_now() { int l; asm volatile("v_mbcnt_lo_u32_b32 %0, -1, 0\n\tv_mbcnt_hi_u32_b32 %0, -1, %0" : "=v"(l)); return l; }
__device__ __forceinline__ int launder2() { int n = 2; asm volatile("" : "+s"(n)); return n; }
struct Ctx {
    const float* const* in; float* out; unsigned char* ws;
    LAS unsigned char* lds; int tid, lane, wid, G, bid; int ppass;
    __device__ __forceinline__ const float* I(int i) const { return in[i]; }
    __device__ __forceinline__ bf16* Z() const { return (bf16*)(ws + WS_Z); }
    __device__ __forceinline__ bf16* ACT() const { return (bf16*)(ws + WS_ACT); }
    __device__ __forceinline__ bf16* WLT() const { return (bf16*)(ws + WS_WLT); }
    __device__ __forceinline__ bf16* U() const { return (bf16*)(ws + WS_U); }
    __device__ __forceinline__ bf16* VF() const { return (bf16*)(ws + WS_VF); }
    __device__ __forceinline__ bf16* KATT() const { return (bf16*)(ws + WS_KATT); }
    __device__ __forceinline__ bf16* VATT() const { return (bf16*)(ws + WS_VATT); }
    __device__ __forceinline__ bf16* KI() const { return (bf16*)(ws + WS_KI); }
    __device__ __forceinline__ float* HX() const { return (float*)(ws + WS_HX); }
    __device__ __forceinline__ float* COS() const { return (float*)(ws + WS_ROPE); }
    __device__ __forceinline__ float* SIN() const { return (float*)(ws + WS_ROPE) + TT * 8; }
    __device__ __forceinline__ unsigned* CTL() const { return (unsigned*)(ws + WS_CTL); }
};

template <class Src, bool FRAG = false>
__device__ __forceinline__ void transpose_item(const Src& src, bf16* WT, int K, int k0, int n0, LAS float* scr, int lane) {
#pragma unroll
    for (int i = 0; i < 8; ++i) { const int kk = 8 * i + (lane >> 3), nn = 4 * (lane & 7); const f32x4 v = src.v4(k0 + kk, n0 + nn);
        scr[kk * 33 + nn] = v.x; scr[kk * 33 + nn + 1] = v.y; scr[kk * 33 + nn + 2] = v.z; scr[kk * 33 + nn + 3] = v.w; }
    asm volatile("s_waitcnt lgkmcnt(0)" ::: "memory");
    const int c = lane & 7;
#pragma unroll
    for (int j = 0; j < 4; ++j) { const int n = (lane >> 3) + 8 * j; const LAS float* s = scr + (8 * c) * 33 + n;
        v4u o; o.x = pk2(s[0 * 33], s[1 * 33]); o.y = pk2(s[2 * 33], s[3 * 33]); o.z = pk2(s[4 * 33], s[5 * 33]); o.w = pk2(s[6 * 33], s[7 * 33]);
        if (FRAG) { const int ch = n0 + n, kq = (k0 >> 3) + c; *(v4u*)(WT + (size_t)((((ch >> 6) * 4 + (ch & 3)) * 10 + (kq >> 2)) * 64 + (kq & 3) * 16 + ((ch & 63) >> 2)) * 8) = o; }
        else *(v4u*)(WT + (size_t)(n0 + n) * K + k0 + 8 * c) = o; }
    asm volatile("s_waitcnt lgkmcnt(0)" ::: "memory");
}
template <class Src>
__device__ __forceinline__ void transpose_item8(const Src& src, unsigned char* WT, int K, int k0, int n0, LAS float* scr, int lane, float mul) {
#pragma unroll
    for (int i = 0; i < 8; ++i) { const int kk = 8 * i + (lane >> 3), nn = 4 * (lane & 7); const f32x4 v = src.v4(k0 + kk, n0 + nn);
        scr[kk * 33 + nn] = v.x; scr[kk * 33 + nn + 1] = v.y; scr[kk * 33 + nn + 2] = v.z; scr[kk * 33 + nn + 3] = v.w; }
    asm volatile("s_waitcnt lgkmcnt(0)" ::: "memory");
    const int c = lane & 7;
#pragma unroll
    for (int j = 0; j < 4; ++j) { const int n = (lane >> 3) + 8 * j; const LAS float* s = scr + (8 * c) * 33 + n;
        v2u o; o.x = pk4_fp8(s[0 * 33] * mul, s[1 * 33] * mul, s[2 * 33] * mul, s[3 * 33] * mul); o.y = pk4_fp8(s[4 * 33] * mul, s[5 * 33] * mul, s[6 * 33] * mul, s[7 * 33] * mul);
        *(v2u*)(WT + (size_t)(n0 + n) * K + k0 + 8 * c) = o; }
    asm volatile("s_waitcnt lgkmcnt(0)" ::: "memory");
}
struct SrcKV { const float* wk; const float* wv;
    __device__ __forceinline__ f32x4 v4(int k, int n) const { return n < 64 ? *(const f32x4*)(wk + (size_t)k * 64 + n) : *(const f32x4*)(wv + (size_t)k * 64 + n - 64); } };
struct SrcLora { const float* w2; const float* a2; const float* g2; const float* v2; int has_v;
    __device__ __forceinline__ f32x4 v4(int k, int n) const {
        if (k < 64) return *(const f32x4*)(w2 + (size_t)k * 512 + n);
        if (k < 128) return *(const f32x4*)(a2 + (size_t)(k - 64) * 512 + n);
        if (k < 288) return *(const f32x4*)(g2 + (size_t)(k - 128) * 512 + n);
        return has_v ? *(const f32x4*)(v2 + (size_t)(k - 288) * 512 + n) : (f32x4){0.f, 0.f, 0.f, 0.f}; } };
struct SrcPlain { const float* W; int ldw; __device__ __forceinline__ f32x4 v4(int k, int n) const { return __builtin_nontemporal_load((const f32x4*)(W + (size_t)k * ldw + n)); } };
struct SrcWin { const float* W; const float* Wv; int has_v;
    __device__ __forceinline__ f32x4 v4(int k, int n) const {
        if (n < 1092) return __builtin_nontemporal_load((const f32x4*)(W + (size_t)k * 2916 + n));
        if (n >= C_R && n < C_XV) return __builtin_nontemporal_load((const f32x4*)(W + (size_t)k * 2916 + 1092 + (n - C_R)));
        if (n >= C_XV && n < C_XV + 32 && has_v) return *(const f32x4*)(Wv + (size_t)k * 32 + (n - C_XV));
        return (f32x4){0.f, 0.f, 0.f, 0.f}; } };

__device__ __forceinline__ void phase_prologue(const Ctx& C) {
    LAS float* scr = (LAS float*)(C.lds + C.wid * 16384);
    const int gw = C.bid * NWAVES + C.wid, NGW = C.G * NWAVES;
    constexpr int IT_WIN = 16 * 96, IT_WO = 16 * 32, IT_WUP = 16 * 128, IT_WDN = 64 * 32, IT_L = IT_WIN + IT_WO + IT_WUP + IT_WDN;
    for (int it = gw; it < 2 * IT_L; it += NGW) {
        const int l = it / IT_L; int r = it % IT_L;
        if (r < IT_WIN) { SrcWin s{C.I(I_WIN) + (size_t)l * 1024 * 2916, C.I(I_WINV), l == 1}; const int kb = r / 96, nb = r % 96;
            transpose_item(s, (bf16*)(C.ws + WS_WIN) + (size_t)l * ZC * 1024, 1024, 64 * kb, 32 * nb, scr, C.lane); continue; } r -= IT_WIN;
        if (r < IT_WO) { SrcPlain s{C.I(I_WO) + (size_t)l * 1024 * 1024, 1024}; const int kb = r / 32, nb = r % 32;
            transpose_item(s, (bf16*)(C.ws + WS_WO) + (size_t)l * 1024 * 1024, 1024, 64 * kb, 32 * nb, scr, C.lane); continue; } r -= IT_WO;
        if (r < IT_WUP) { SrcPlain s{C.I(I_WUP) + (size_t)l * 1024 * 4096, 4096}; const int kb = r / 128, nb = r % 128;
            transpose_item8(s, C.ws + WS_WUP + (size_t)l * 4096 * 1024, 1024, 64 * kb, 32 * nb, scr, C.lane, S8_WU); continue; } r -= IT_WUP;
        { SrcPlain s{C.I(I_WDN) + (size_t)l * 4096 * 1024, 1024}; const int kb = r / 32, nb = r % 32;
            transpose_item8(s, C.ws + WS_WDN + (size_t)l * 1024 * 4096, 4096, 64 * kb, 32 * nb, scr, C.lane, S8_WD); }
    }
    for (int it = gw; it < 2 * 16; it += NGW) { const int l = it / 16, r = it % 16, kb = r / 4, nb = r % 4;
        SrcKV s{C.I(I_WUK) + (size_t)l * 256 * 64, C.I(I_WUV) + (size_t)l * 256 * 64};
        transpose_item(s, (bf16*)(C.ws + WS_WKV) + (size_t)l * 128 * 256, 256, 64 * kb, 32 * nb, scr, C.lane); }
    for (int it = gw; it < 2 * 80; it += NGW) { const int l = it / 80, r = it % 80, kb = r / 16, nb = r % 16;
        SrcLora s{C.I(I_W2) + (size_t)l * 64 * 512, C.I(I_A2) + (size_t)l * 64 * 512, C.I(I_G2) + (size_t)l * 160 * 512, C.I(I_V2), l == 1};
        transpose_item<SrcLora, true>(s, C.WLT() + (size_t)l * 512 * ACTC, ACTC, 64 * kb, 32 * nb, scr, C.lane); }
    const int gt = C.bid * NT + C.tid, NGT = C.G * NT;
    for (int i = gt; i < TT * 8; i += NGT) {
        const int p = i >> 3, f = i & 7;
        const float invf = powf(500000.0f, -(float)(2 * f) / 16.0f);
        const float ang = (float)p * invf;
        const double ad = (double)ang; const double n = rint(ad * 0.15915494309189535); const float rr = (float)(ad - n * 6.283185307179586);
        C.COS()[i] = cosf(rr); C.SIN()[i] = sinf(rr);
    }
    for (int i = gt; i < 256 * DM; i += NGT) C.HX()[i] = (i < NMETA * DM) ? C.I(I_META)[i] : 0.f;
}

template <bool HIN16, bool HOUT16>
__device__ __forceinline__ void phase_norm(const Ctx& C, const void* hin_main, void* hout_main, const bf16* tmp, const float* g_post, const float* g_next, const float* hx_in = nullptr, const bool out8 = false) {
    const int gw = C.bid * NWAVES + C.wid, NGW = C.G * NWAVES; const int lane = C.lane;
    constexpr int NR = 4;
#define NEO(j) (lane * 8 + 512 * ((j) >> 1) + 4 * ((j) & 1))
#define NUP(w0_, w1_) (f32x4){__uint_as_float((w0_) << 16), __uint_as_float((w0_) & 0xffff0000u), __uint_as_float((w1_) << 16), __uint_as_float((w1_) & 0xffff0000u)}
    f32x4 gpo[4], gne[4];
#pragma unroll
    for (int j = 0; j < 4; ++j) { gpo[j] = g_post ? *(const f32x4*)(g_post + NEO(j)) : (f32x4){0.f, 0.f, 0.f, 0.f}; gne[j] = g_next ? *(const f32x4*)(g_next + NEO(j)) : (f32x4){0.f, 0.f, 0.f, 0.f}; }
    for (int row0 = gw; row0 < RPAD; row0 += NR * NGW) {
        f32x4 h[NR][4]; v4u tw[NR][2];
#pragma unroll
        for (int u = 0; u < NR; ++u) { const int row = row0 + u * NGW; if (row >= RREAL) continue;
            const bool mainrow = row < MAINR;
            if (HIN16 && mainrow) {
#pragma unroll
                for (int j2 = 0; j2 < 2; ++j2) { const v4u w = __builtin_nontemporal_load((const v4u*)((const bf16*)hin_main + (size_t)row * DM + lane * 8 + 512 * j2));
                    h[u][2 * j2] = NUP(w.x, w.y); h[u][2 * j2 + 1] = NUP(w.z, w.w); }
            } else {
                const float* hp = mainrow ? (const float*)hin_main + (size_t)row * DM : (hx_in ? hx_in : (const float*)C.HX()) + (size_t)(row - MAINR) * DM;
#pragma unroll
                for (int j = 0; j < 4; ++j) h[u][j] = __builtin_nontemporal_load((const f32x4*)(hp + NEO(j)));
            }
            if (tmp) {
#pragma unroll
                for (int j2 = 0; j2 < 2; ++j2) tw[u][j2] = __builtin_nontemporal_load((const v4u*)(tmp + (size_t)row * DM + lane * 8 + 512 * j2)); }
        }
#pragma unroll
        for (int u = 0; u < NR; ++u) { const int row = row0 + u * NGW; if (row >= RPAD) continue;
            bf16* urow = C.U() + (size_t)row * DM;
            if (row >= RREAL) { if (g_next && !out8) {
#pragma unroll
                    for (int j2 = 0; j2 < 2; ++j2) { unsigned z_ = 0u; asm volatile("" : "+v"(z_)); *(v4u*)(urow + lane * 8 + 512 * j2) = (v4u){z_, z_, z_, z_}; } }
                continue; }
            const bool mainrow = row < MAINR;
            if (tmp) {
                f32x4 t[4]; float ss = 0.f;
#pragma unroll
                for (int j2 = 0; j2 < 2; ++j2) { const v4u w = tw[u][j2]; t[2 * j2] = NUP(w.x, w.y); t[2 * j2 + 1] = NUP(w.z, w.w); }
#pragma unroll
                for (int j = 0; j < 4; ++j) ss += (t[j].x * t[j].x + t[j].y * t[j].y) + (t[j].z * t[j].z + t[j].w * t[j].w);
                const float rstd = __builtin_amdgcn_rsqf(wave_sum(ss) * (1.f / DM) + NORM_EPS);
#pragma unroll
                for (int j = 0; j < 4; ++j) h[u][j] = h[u][j] + t[j] * rstd * gpo[j];
                if (HOUT16 && mainrow) {
#pragma unroll
                    for (int j2 = 0; j2 < 2; ++j2) __builtin_nontemporal_store((v4u){pk2(h[u][2 * j2].x, h[u][2 * j2].y), pk2(h[u][2 * j2].z, h[u][2 * j2].w), pk2(h[u][2 * j2 + 1].x, h[u][2 * j2 + 1].y), pk2(h[u][2 * j2 + 1].z, h[u][2 * j2 + 1].w)},
                                                                                 (v4u*)((bf16*)hout_main + (size_t)row * DM + lane * 8 + 512 * j2));
                } else { float* ho = mainrow ? (float*)hout_main + (size_t)row * DM : C.HX() + (size_t)(row - MAINR) * DM;
#pragma unroll
                    for (int j = 0; j < 4; ++j) __builtin_nontemporal_store(h[u][j], (f32x4*)(ho + NEO(j))); }
            }
            if (g_next) {
                float ss = 0.f;
#pragma unroll
                for (int j = 0; j < 4; ++j) ss += (h[u][j].x * h[u][j].x + h[u][j].y * h[u][j].y) + (h[u][j].z * h[u][j].z + h[u][j].w * h[u][j].w);
                const float rstd = __builtin_amdgcn_rsqf(wave_sum(ss) * (1.f / DM) + NORM_EPS);
                f32x4 y[4];
#pragma unroll
                for (int j = 0; j < 4; ++j) y[j] = h[u][j] * rstd * gne[j];
#pragma unroll
                for (int j2 = 0; j2 < 2; ++j2) { const f32x4 ya = y[2 * j2], yb = y[2 * j2 + 1];
                    if (out8) *(v2u*)((unsigned char*)C.U() + (size_t)row * DM + lane * 8 + 512 * j2) = (v2u){pk4_fp8(ya.x * S8_X, ya.y * S8_X, ya.z * S8_X, ya.w * S8_X), pk4_fp8(yb.x * S8_X, yb.y * S8_X, yb.z * S8_X, yb.w * S8_X)};
                    else *(v4u*)(urow + lane * 8 + 512 * j2) = (v4u){pk2(ya.x, ya.y), pk2(ya.z, ya.w), pk2(yb.x, yb.y), pk2(yb.z, yb.w)}; }
            }
        }
    }
#undef NEO
#undef NUP
}

typedef short s16x4 __attribute__((ext_vector_type(4)));
constexpr int SLOT = 18432;
constexpr int O_W = 0, O_R = 2048, O_BK = 4096, O_ARK = 8192, O_TA = 9216, O_GAM = 9728, O_VT = 10240, O_TMP = 12288, O_B = 12288, O_K = 14336, O_AT = 16384;
constexpr int OPS_SH = 10240, OPS_VT = 10240, OPS_G = 12288, OPS_BG = 14336;
constexpr int NCHUNK = TT / 16;
__device__ __forceinline__ bf16x8 cat8(s16x4 a, s16x4 b) { return __builtin_shufflevector(a, b, 0, 1, 2, 3, 4, 5, 6, 7); }
__device__ __forceinline__ s16x4 pack4(f32x4 v) { v2u w = (v2u){pk2(v.x, v.y), pk2(v.z, v.w)}; return __builtin_bit_cast(s16x4, w); }
__device__ __forceinline__ s16x4 pack4f(float a, float b, float c, float d) { v2u w = (v2u){pk2(a, b), pk2(c, d)}; return __builtin_bit_cast(s16x4, w); }
__device__ __forceinline__ f32x4 mfma16(bf16x8 a, bf16x8 b, f32x4 c) { return __builtin_amdgcn_mfma_f32_16x16x32_bf16(a, b, c, 0, 0, 0); }
__device__ __forceinline__ void unpack4(v2u w, float (&o)[4]) { o[0] = __uint_as_float(w.x << 16); o[1] = __uint_as_float(w.x & 0xffff0000u); o[2] = __uint_as_float(w.y << 16); o[3] = __uint_as_float(w.y & 0xffff0000u); }


struct PostLd { unsigned short q1, q2, qi1, qi2, ki, a0, a1, a2, a3, a4; v2u ckv; float cs, sn; };
__device__ __forceinline__ void post_load(const Ctx& C, int l, int row, int lane, PostLd& o) {
    const int p = row < MAINR ? NMETA + (row & 8191) : row - MAINR;
    const bf16* z = C.Z() + (size_t)row * ZC;
    const int hh = lane >> 3, i = lane & 7;
    o.cs = C.COS()[p * 8 + i]; o.sn = C.SIN()[p * 8 + i];
    o.q1 = z[C_Q + hh * 64 + i]; o.q2 = z[C_Q + hh * 64 + 8 + i];
    o.qi1 = z[C_QI + (hh & 3) * 64 + i]; o.qi2 = z[C_QI + (hh & 3) * 64 + 8 + i];
    o.ki = z[C_KI + lane];
    o.ckv = *(const v2u*)(z + C_CKV + lane * 4);
    o.a0 = z[C_XW + lane]; o.a1 = z[C_XA + lane]; o.a2 = z[C_XG + lane]; o.a3 = z[C_XG + 64 + lane];
    o.a4 = lane < 32 ? z[C_XG + 128 + lane] : (l == 1 ? z[C_XV + lane - 32] : (unsigned short)0);
}
__device__ __forceinline__ float shiftf(unsigned short a_, unsigned short p_, float mu) { const float a = bf2f(a_), pr = bf2f(p_); return a + (pr - a) * mu; }
__device__ __forceinline__ void post_compute(const Ctx& C, int l, int row, int lane, const PostLd& d, const unsigned short (&pv)[5], const float (&mu)[5], const f32x4 kvg, const float ig, const float ib, LAS unsigned char* cl) {
    int b, p; if (row < MAINR) { b = row >> 13; p = NMETA + (row & 8191); } else { b = -1; p = row - MAINR; }
    bf16* z = C.Z() + (size_t)row * ZC;
    const int hh = lane >> 3, i = lane & 7; const float c = d.cs, s = d.sn;
    { const float t1 = bf2f(d.q1), t2 = bf2f(d.q2);
      z[C_Q + hh * 64 + i] = (bf16)f2bf(t1 * c - t2 * s); z[C_Q + hh * 64 + 8 + i] = (bf16)f2bf(t2 * c + t1 * s); }
    if (lane < 32) { const float t1 = bf2f(d.qi1), t2 = bf2f(d.qi2);
      z[C_QI + hh * 64 + i] = (bf16)f2bf(t1 * c - t2 * s); z[C_QI + hh * 64 + 8 + i] = (bf16)f2bf(t2 * c + t1 * s); }
    {
        const float x = bf2f(d.ki);
        const float mu_ = wave_sum(x) * (1.f / 64.f); const float dd = x - mu_; const float var = wave_sum(dd * dd) * (1.f / 64.f);
        float y = dd * __builtin_amdgcn_rsqf(var + NORM_EPS) * ig + ib;
        const float o = dpp_f<0x128>(y);
        if (lane < 8) y = y * c - o * s; else if (lane < 16) y = y * c + o * s;
        const bf16 yb = (bf16)f2bf(y);
        const size_t ko = ((size_t)((p >> 5) * 4 + (lane >> 4)) * 64 + ((lane >> 3) & 1) * 32 + (p & 31)) * 8 + (lane & 7);
        if (b >= 0) C.KI()[(size_t)b * TPAD * 64 + ko] = yb;
        else {
#pragma unroll
            for (int bb = 0; bb < NB; ++bb) C.KI()[(size_t)bb * TPAD * 64 + ko] = yb; }
    }
    {
        const v2u w = d.ckv;
        f32x4 x = (f32x4){__uint_as_float(w.x << 16), __uint_as_float(w.x & 0xffff0000u), __uint_as_float(w.y << 16), __uint_as_float(w.y & 0xffff0000u)};
        const float ms = wave_sum((x.x * x.x + x.y * x.y) + (x.z * x.z + x.w * x.w)) * (1.f / 256.f);
        const float rstd = __builtin_amdgcn_rsqf(ms + NORM_EPS);
        x = x * rstd * kvg;
        *(LAS v2u*)((LAS unsigned char*)cl + lane * 8) = (v2u){pk2(x.x, x.y), pk2(x.z, x.w)};
    }
    bf16* ar = C.ACT() + (size_t)(row >> 4) * (16 * ACTC) + ((lane >> 3) * 16 + (row & 15)) * 8 + (lane & 7);
    const float x0 = shiftf(d.a0, pv[0], mu[0]); ar[0] = (bf16)f2bf(2.f * sigmoidf_(2.f * x0) - 1.f);
    ar[1024] = (bf16)f2bf(shiftf(d.a1, pv[1], mu[1]));
    ar[2048] = (bf16)f2bf(sigmoidf_(shiftf(d.a2, pv[2], mu[2])));
    ar[3072] = (bf16)f2bf(sigmoidf_(shiftf(d.a3, pv[3], mu[3])));
    float x4;
    if (lane < 32) x4 = sigmoidf_(shiftf(d.a4, pv[4], mu[4])); else x4 = l == 1 ? shiftf(d.a4, pv[4], mu[4]) : 0.f;
    ar[4096] = (bf16)f2bf(x4);
}
constexpr int CLP = 528;
constexpr int PW_ACT = 16 * CLP, PW_KI = PW_ACT + 5120, PW_BYTES = PW_KI + 2048;
__device__ __forceinline__ void post_compute_f(const Ctx& C, int l, int row, int rr, int lane, const PostLd& d, const unsigned short (&pv)[5], const float (&mu)[5], const f32x4 kvg, const float ig, const float ib, LAS unsigned char* W) {
    bf16* z = C.Z() + (size_t)row * ZC;
    const int hh = lane >> 3, i = lane & 7; const float c = d.cs, s = d.sn; const bool odd = lane & 1;
    { const float t1 = bf2f(d.q1), t2 = bf2f(d.q2); const float a1 = t1 * c - t2 * s, a2 = t2 * c + t1 * s;
      const float x1 = dpp_f<0xB1>(a1), x2 = dpp_f<0xB1>(a2);
      *(unsigned*)(z + C_Q + hh * 64 + (odd ? 8 + i - 1 : i)) = odd ? pk2(x2, a2) : pk2(a1, x1); }
    { const float t1 = bf2f(d.qi1), t2 = bf2f(d.qi2); const float a1 = t1 * c - t2 * s, a2 = t2 * c + t1 * s;
      const float x1 = dpp_f<0xB1>(a1), x2 = dpp_f<0xB1>(a2);
      if (lane < 32) *(unsigned*)(z + C_QI + hh * 64 + (odd ? 8 + i - 1 : i)) = odd ? pk2(x2, a2) : pk2(a1, x1); }
    {
        const float x = bf2f(d.ki);
        const float mu_ = wave_sum(x) * (1.f / 64.f); const float dd = x - mu_; const float var = wave_sum(dd * dd) * (1.f / 64.f);
        float y = dd * __builtin_amdgcn_rsqf(var + NORM_EPS) * ig + ib;
        const float o = dpp_f<0x128>(y);
        if (lane < 8) y = y * c - o * s; else if (lane < 16) y = y * c + o * s;
        *(LAS bf16*)(W + PW_KI + (((lane >> 3) * 16 + rr) * 8 + (lane & 7)) * 2) = (bf16)f2bf(y);
    }
    {
        const v2u w = d.ckv;
        f32x4 x = (f32x4){__uint_as_float(w.x << 16), __uint_as_float(w.x & 0xffff0000u), __uint_as_float(w.y << 16), __uint_as_float(w.y & 0xffff0000u)};
        const float ms = wave_sum((x.x * x.x + x.y * x.y) + (x.z * x.z + x.w * x.w)) * (1.f / 256.f);
        const float rstd = __builtin_amdgcn_rsqf(ms + NORM_EPS);
        x = x * rstd * kvg;
        *(LAS v2u*)(W + rr * CLP + lane * 8) = (v2u){pk2(x.x, x.y), pk2(x.z, x.w)};
    }
    LAS bf16* ar = (LAS bf16*)(W + PW_ACT) + ((lane >> 3) * 8 + (rr & 7)) * 8 + (lane & 7);
    const float x0 = shiftf(d.a0, pv[0], mu[0]); ar[0] = (bf16)f2bf(2.f * sigmoidf_(2.f * x0) - 1.f);
    ar[512] = (bf16)f2bf(shiftf(d.a1, pv[1], mu[1]));
    ar[1024] = (bf16)f2bf(sigmoidf_(shiftf(d.a2, pv[2], mu[2])));
    ar[1536] = (bf16)f2bf(sigmoidf_(shiftf(d.a3, pv[3], mu[3])));
    float x4;
    if (lane < 32) x4 = sigmoidf_(shiftf(d.a4, pv[4], mu[4])); else x4 = l == 1 ? shiftf(d.a4, pv[4], mu[4]) : 0.f;
    ar[2048] = (bf16)f2bf(x4);
}
__device__ __forceinline__ void phase_post(const Ctx& C, int l, bool doA) {
    int lane_ = lane_now(); const int lane = lane_, g = lane >> 4, cc = lane & 15;
    const int gw = C.bid * NWAVES + C.wid, NGW = C.G * NWAVES;
    const float* mup = C.I(I_MU) + l * 1824;
    const float mu[5] = {mup[1536 + lane], mup[1600 + lane], mup[1664 + lane], mup[1728 + lane], lane < 32 ? mup[1792 + lane] : (l == 1 ? C.I(I_MUV)[lane - 32] : 0.f)};
    const f32x4 kvg = *(const f32x4*)(C.I(I_KVN) + l * 256 + lane * 4); const float ig = C.I(I_IDXG)[l * 64 + lane], ib = C.I(I_IDXB)[l * 64 + lane];
    const bf16* wkv = (const bf16*)(C.ws + WS_WKV) + (size_t)l * 128 * 256 + (size_t)cc * 256 + 8 * g;
#define POST_PREV(prow_, has_, pv_) do { const bf16* zp_ = C.Z() + (size_t)(prow_) * ZC; \
        pv_[0] = zp_[C_XW + lane]; pv_[1] = zp_[C_XA + lane]; pv_[2] = zp_[C_XG + lane]; pv_[3] = zp_[C_XG + 64 + lane]; pv_[4] = lane < 32 ? zp_[C_XG + 128 + lane] : (l == 1 ? zp_[C_XV + lane - 32] : (unsigned short)0); \
        if (!(has_)) { pv_[0] = 0; pv_[1] = 0; pv_[2] = 0; pv_[3] = 0; pv_[4] = 0; } } while (0)
#define POST_NEXT(pv_, d_) do { pv_[0] = d_.a0; pv_[1] = d_.a1; pv_[2] = d_.a2; pv_[3] = d_.a3; pv_[4] = d_.a4; } while (0)
#define POST_KV(row0_, cl_) do { const int kvrow0 = (row0_); \
        bf16x8 Af[8]; \
        _Pragma("unroll") for (int ks = 0; ks < 8; ++ks) Af[ks] = *(const LAS bf16x8*)((cl_) + cc * CLP + (32 * ks + 8 * g) * 2); \
        const bool ismeta = kvrow0 >= MAINR; const int bq = ismeta ? 0 : kvrow0 >> 13; const int pb = ismeta ? kvrow0 - MAINR : NMETA + (kvrow0 & 8191); \
        _Pragma("unroll 2") for (int nt = 0; nt < 8; ++nt) { \
            bf16x8 Bf[8]; \
            _Pragma("unroll") for (int ks = 0; ks < 8; ++ks) Bf[ks] = *(const bf16x8*)(wkv + (size_t)nt * 16 * 256 + 32 * ks); \
            f32x4 acc = (f32x4){0.f, 0.f, 0.f, 0.f}; \
            _Pragma("unroll") for (int ks = 0; ks < 8; ++ks) acc = mfma16(Af[ks], Bf[ks], acc); \
            bf16* dst = (nt < 4 ? C.KATT() : C.VATT()) + (nt & 3) * 16 + cc; \
            _Pragma("unroll") for (int r = 0; r < 4; ++r) { const int p = pb + 4 * g + r; float v = acc[r]; \
                if (nt == 0) { const float o = dpp_f<0x128>(v); const float cs = C.COS()[p * 8 + (cc & 7)], sn = C.SIN()[p * 8 + (cc & 7)]; v = cc < 8 ? v * cs - o * sn : v * cs + o * sn; } \
                const bf16 vb = (bf16)f2bf(v); \
                if (!ismeta) dst[((size_t)bq * TPAD + p) * 64] = vb; \
                else { _Pragma("unroll") for (int bb = 0; bb < NB; ++bb) dst[((size_t)bb * TPAD + p) * 64] = vb; } } } } while (0)
    LAS unsigned char* W = C.lds + C.wid * PW_BYTES;
    for (int grp = gw; grp < MAINR / 16; grp += NGW) {
        const int row0 = grp * 16, bq = row0 >> 13, pb = NMETA + (row0 & 8191);
        unsigned short pv[5];
        { const int s0 = row0 & 8191; POST_PREV(s0 == 0 ? MAINR + 15 : row0 - 1, true, pv); }
        PostLd d0, d1, e0, e1; post_load(C, l, row0, lane, d0); post_load(C, l, row0 + 1, lane, d1);
#define POST_FLUSH(rr_) do { asm volatile("s_waitcnt lgkmcnt(0)" ::: "memory"); bf16* ag = C.ACT() + (size_t)grp * (16 * ACTC) + ((rr_) & 8) * 8; \
            _Pragma("unroll") for (int it = 0; it < 5; ++it) { const int q = it * 64 + lane; *(v4u*)(ag + ((q >> 3) * 16 + (q & 7)) * 8) = *(const LAS v4u*)(W + PW_ACT + q * 16); } \
            asm volatile("s_waitcnt lgkmcnt(0)" ::: "memory"); } while (0)
#pragma unroll 1
        for (int rr = 0; rr < 16; rr += 4) {
            post_load(C, l, row0 + rr + 2, lane, e0); post_load(C, l, row0 + rr + 3, lane, e1);
            post_compute_f(C, l, row0 + rr, rr, lane, d0, pv, mu, kvg, ig, ib, W); POST_NEXT(pv, d0);
            post_compute_f(C, l, row0 + rr + 1, rr + 1, lane, d1, pv, mu, kvg, ig, ib, W); POST_NEXT(pv, d1);
            if (rr + 4 < 16) { post_load(C, l, row0 + rr + 4, lane, d0); post_load(C, l, row0 + rr + 5, lane, d1); }
            post_compute_f(C, l, row0 + rr + 2, rr + 2, lane, e0, pv, mu, kvg, ig, ib, W); POST_NEXT(pv, e0);
            post_compute_f(C, l, row0 + rr + 3, rr + 3, lane, e1, pv, mu, kvg, ig, ib, W); POST_NEXT(pv, e1);
            if ((rr & 7) == 4) POST_FLUSH(rr);
        }
#undef POST_FLUSH
        {
            bf16* kg = C.KI() + (size_t)bq * TPAD * 64;
#pragma unroll
            for (int it = 0; it < 2; ++it) { const int q = it * 64 + lane, d8 = q >> 4, r = q & 15;
                *(v4u*)(kg + ((size_t)((pb >> 5) * 4 + (d8 >> 1)) * 64 + (d8 & 1) * 32 + (pb & 31) + r) * 8) = *(const LAS v4u*)(W + PW_KI + q * 16); }
        }
        {
            bf16x8 Af[8];
#pragma unroll
            for (int ks = 0; ks < 8; ++ks) Af[ks] = *(const LAS bf16x8*)(W + cc * CLP + (32 * ks + 8 * g) * 2);
            _Pragma("unroll 4") for (int nt = 0; nt < 8; ++nt) {
                bf16x8 Bf[8];
#pragma unroll
                for (int ks = 0; ks < 8; ++ks) Bf[ks] = *(const bf16x8*)(wkv + (size_t)nt * 16 * 256 + 32 * ks);
                f32x4 acc = (f32x4){0.f, 0.f, 0.f, 0.f};
#pragma unroll
                for (int ks = 0; ks < 8; ++ks) acc = mfma16(Af[ks], Bf[ks], acc);
#pragma unroll
                for (int r = 0; r < 4; ++r) { const int p = pb + 4 * g + r; float v = acc[r];
                    if (nt == 0) { const float o = dpp_f<0x128>(v); const float cs = C.COS()[p * 8 + (cc & 7)], sn = C.SIN()[p * 8 + (cc & 7)]; v = cc < 8 ? v * cs - o * sn : v * cs + o * sn; }
                    *(LAS bf16*)(W + PW_ACT + (nt < 4 ? 0 : 2048) + ((4 * g + r) * 64 + (nt & 3) * 16 + cc) * 2) = (bf16)f2bf(v); } }
            asm volatile("s_waitcnt lgkmcnt(0)" ::: "memory");
#pragma unroll
            for (int it = 0; it < 4; ++it) { const int q = it * 64 + lane;
                bf16* dst = (q < 128 ? C.KATT() : C.VATT()) + ((size_t)bq * TPAD + pb) * 64 + (q & 127) * 8;
                *(v4u*)dst = *(const LAS v4u*)(W + PW_ACT + q * 16); }
            asm volatile("s_waitcnt lgkmcnt(0)" ::: "memory");
        }
    }
    if (C.bid == C.G - 1) {
        LAS unsigned char* clm = C.lds + NWAVES * PW_BYTES;
        const int r0 = MAINR + 2 * C.wid;
        unsigned short pv[5]; POST_PREV(r0 == MAINR ? r0 : r0 - 1, r0 != MAINR, pv);
        PostLd d0, d1; post_load(C, l, r0, lane, d0); post_load(C, l, r0 + 1, lane, d1);
        post_compute(C, l, r0, lane, d0, pv, mu, kvg, ig, ib, clm + (2 * C.wid) * CLP); POST_NEXT(pv, d0);
        post_compute(C, l, r0 + 1, lane, d1, pv, mu, kvg, ig, ib, clm + (2 * C.wid + 1) * CLP);
        asm volatile("s_waitcnt lgkmcnt(0)" ::: "memory");
        __syncthreads();
        if (C.wid == 0) POST_KV(MAINR, clm);
    }
#undef POST_PREV
#undef POST_NEXT
#undef POST_KV
}

__device__ __forceinline__ void prep_copy(LAS unsigned char* sl, unsigned char* ops, int lane) {
#pragma unroll
    for (int i = 0; i < 12; ++i) *(v4u*)(ops + (i * 64 + lane) * 16) = *(const LAS v4u*)(sl + (i * 64 + lane) * 16);
    asm volatile("s_waitcnt lgkmcnt(0)" ::: "memory");
}
struct PrepIn { bf16x8 Af[10]; v2u wr[4], wk[4], wv[4], wf[4], pwr, pwk, pwv; };
__device__ __forceinline__ void prep_load_in(const Ctx& C, int l, int bh, int cidx, int lane, PrepIn& o) {
    const int g = lane >> 4, c = lane & 15, b = bh >> 3, h = bh & 7;
    const int row0 = cidx == 0 ? MAINR : b * SEQ + 16 * (cidx - 1);
    const int ch0 = h * 64 + 4 * c;
    const bf16* zb = C.Z() + C_R + ch0;
    const bf16* act = C.ACT() + (size_t)(row0 >> 4) * (16 * ACTC) + lane * 8;
#pragma unroll
    for (int ks = 0; ks < 10; ++ks) o.Af[ks] = *(const bf16x8*)(act + 512 * ks);
#pragma unroll
    for (int r = 0; r < 4; ++r) { const size_t row = row0 + 4 * g + r;
        o.wr[r] = __builtin_nontemporal_load((const v2u*)(zb + row * ZC)); o.wk[r] = __builtin_nontemporal_load((const v2u*)(zb + row * ZC + 512)); o.wv[r] = __builtin_nontemporal_load((const v2u*)(zb + row * ZC + 1024));
        o.wf[r] = l == 1 ? *(const v2u*)(C.VF() + row * 512 + ch0) : (v2u){0u, 0u}; }
    bool hasprev = true; int prow;
    if (g > 0) prow = row0 + 4 * g - 1; else if (cidx == 0) { hasprev = false; prow = row0; } else prow = cidx == 1 ? MAINR + 15 : row0 - 1;
    o.pwr = *(const v2u*)(zb + (size_t)prow * ZC); o.pwk = *(const v2u*)(zb + (size_t)prow * ZC + 512); o.pwv = *(const v2u*)(zb + (size_t)prow * ZC + 1024);
    if (!hasprev) { o.pwr = (v2u){0u, 0u}; o.pwk = o.pwr; o.pwv = o.pwr; }
}
template <bool SHARED>
__device__ __forceinline__ unsigned char* prep_unit(const Ctx& C, int l, int bh, int bhl, int cidx, LAS unsigned char* sl, unsigned char* prev_ops, PrepIn& in, const bool have_in, const int nbh, const int ncidx) {
    int lane_ = lane_now(); const int lane = lane_, g = lane >> 4, c = lane & 15;
    const int b = bh >> 3, h = bh & 7;
    const int row0 = cidx == 0 ? MAINR : b * SEQ + 16 * (cidx - 1);
    const bf16x8 zero8 = (bf16x8){0, 0, 0, 0, 0, 0, 0, 0};
    const f32x4 z4 = (f32x4){0.f, 0.f, 0.f, 0.f};
    f32x4 aw[4], aa[4], ag[4], av[4];
    const int ch0 = h * 64 + 4 * c;
    const bf16* zb = C.Z() + C_R + ch0;
    v2u (&wr)[4] = in.wr; v2u (&wk)[4] = in.wk; v2u (&wv)[4] = in.wv; v2u (&wf)[4] = in.wf; v2u& pwr = in.pwr; v2u& pwk = in.pwk; v2u& pwv = in.pwv;
    const bf16* wl = C.WLT() + (size_t)l * 512 * ACTC + (size_t)(h * 4) * (10 * 512) + lane * 8;
    bf16x8 (&Af)[10] = in.Af; bf16x8 BfA[10], BfB[10];
#define PREP_LDB(Bf, n) do { if (SHARED) { _Pragma("unroll") for (int ks = 0; ks < 10; ++ks) Bf[ks] = *(const LAS bf16x8*)(C.lds + (((n) * 10 + ks) * 64 + lane) * 16); } \
        else { _Pragma("unroll") for (int ks = 0; ks < 10; ++ks) Bf[ks] = *(const bf16x8*)(wl + ((n) * 10 + ks) * 512); } } while (0)
#define PREP_MM(Bf, n) do { aw[n] = mfma16(Af[1], Bf[1], mfma16(Af[0], Bf[0], z4)); aa[n] = mfma16(Af[3], Bf[3], mfma16(Af[2], Bf[2], z4)); \
        { f32x4 t = z4; _Pragma("unroll") for (int ks = 4; ks < 9; ++ks) t = mfma16(Af[ks], Bf[ks], t); ag[n] = t; } av[n] = mfma16(Af[9], Bf[9], z4); } while (0)
    if (SHARED) {
        __syncthreads();
#pragma unroll
        for (int i = 0; i < 5; ++i) { const int blk = C.wid + 8 * i;
            __builtin_amdgcn_global_load_lds((const unsigned*)(wl - lane * 8 + blk * 512 + lane * 8), (LAS unsigned*)(C.lds + blk * 1024), 16, 0, 0); }
    }
    if (!have_in) prep_load_in(C, l, bh, cidx, lane, in);
    if (!SHARED) { PREP_LDB(BfA, 0); PREP_LDB(BfB, 1); }
    asm volatile("" ::: "memory");
    if (prev_ops) prep_copy(sl, prev_ops, lane);
    asm volatile("" ::: "memory");
    if (SHARED) { asm volatile("s_waitcnt vmcnt(0)" ::: "memory"); __syncthreads(); PREP_LDB(BfA, 0); PREP_LDB(BfB, 1); }
    PREP_MM(BfA, 0);
    asm volatile("" ::: "memory");
    PREP_LDB(BfA, 2);
    asm volatile("" ::: "memory");
    PREP_MM(BfB, 1);
    asm volatile("" ::: "memory");
    PREP_LDB(BfB, 3);
    const f32x4 w0v = *(const f32x4*)(C.I(I_W0) + l * 512 + ch0), a0v = *(const f32x4*)(C.I(I_A0) + l * 512 + ch0);
    const f32x4 v0v = l == 1 ? *(const f32x4*)(C.I(I_V0) + ch0) : z4;
    const f32x4 mur = *(const f32x4*)(C.I(I_MU) + l * 1824 + ch0), muk = *(const f32x4*)(C.I(I_MU) + l * 1824 + 512 + ch0), muv = *(const f32x4*)(C.I(I_MU) + l * 1824 + 1024 + ch0);
    const f32x4 kkc = *(const f32x4*)(C.I(I_KK) + l * 512 + ch0), kac = *(const f32x4*)(C.I(I_KA) + l * 512 + ch0), rkc = *(const f32x4*)(C.I(I_RK) + l * 512 + ch0);
    const f32x4 lnw = *(const f32x4*)(C.I(I_LNW) + l * 512 + ch0), lnb = *(const f32x4*)(C.I(I_LNB) + l * 512 + ch0);
    asm volatile("" ::: "memory");
    PREP_MM(BfA, 2);
    PREP_MM(BfB, 3);
    asm volatile("" ::: "memory");
    if (SHARED) { asm volatile("s_waitcnt lgkmcnt(0)" ::: "memory"); __syncthreads(); }
#undef PREP_LDB
#undef PREP_MM
    float At[4][4], Bt[4][4], Kt[4][4], Vv[4][4], gam[4];
    unsigned char* ops = C.ws + WS_OPS + ((size_t)bhl * NCHUNK + cidx) * OPSB;
    {
        float lw[4][4], cum[4][4];
#pragma unroll
        for (int r = 0; r < 4; ++r)
#pragma unroll
            for (int n = 0; n < 4; ++n) lw[r][n] = -0.6065306597126334f * sigmoidf_(w0v[n] + aw[n][r]);
#pragma unroll
        for (int n = 0; n < 4; ++n) { cum[0][n] = lw[0][n]; cum[1][n] = cum[0][n] + lw[1][n]; cum[2][n] = cum[1][n] + lw[2][n]; cum[3][n] = cum[2][n] + lw[3][n];
            const float tot = cum[3][n];
            const u2v r16 = __builtin_amdgcn_permlane16_swap(__float_as_uint(tot), __float_as_uint(tot), false, false);
            const float x16 = __uint_as_float((g & 1) ? r16.x : r16.y), pr2 = tot + x16;
            const u2v r32 = __builtin_amdgcn_permlane32_swap(__float_as_uint(pr2), __float_as_uint(pr2), false, false);
            const float off = ((g & 1) ? x16 : 0.f) + ((g & 2) ? __uint_as_float(r32.x) : 0.f);
#pragma unroll
            for (int r = 0; r < 4; ++r) cum[r][n] += off;
            gam[n] = 0.f; }
        float pr[4], pk[4], pv[4]; unpack4(pwr, pr); unpack4(pwk, pk); unpack4(pwv, pv);
        float ecp[4];
#pragma unroll
        for (int n = 0; n < 4; ++n) ecp[n] = __expf(cum[0][n] - lw[0][n]);
#pragma unroll
        for (int r = 0; r < 4; ++r) {
            float rr[4], kr[4], vr[4], vf[4]; unpack4(wr[r], rr); unpack4(wk[r], kr); unpack4(wv[r], vr); unpack4(wf[r], vf);
            float rs[4], ks[4], vs[4], kk[4], ss = 0.f;
#pragma unroll
            for (int n = 0; n < 4; ++n) { rs[n] = rr[n] + (pr[n] - rr[n]) * mur[n]; ks[n] = kr[n] + (pk[n] - kr[n]) * muk[n]; vs[n] = vr[n] + (pv[n] - vr[n]) * muv[n];
                pr[n] = rr[n]; pk[n] = kr[n]; pv[n] = vr[n]; kk[n] = ks[n] * kkc[n]; ss += kk[n] * kk[n]; }
            ss = row16_sum(ss);
            const float inv = __builtin_amdgcn_rcpf(fmaxf(__builtin_amdgcn_sqrtf(ss), 1e-12f));
            float k2[4], v2[4], Rt[4], Gp[4], BGp[4], rks = 0.f;
#pragma unroll
            for (int n = 0; n < 4; ++n) { const float a = sigmoidf_(a0v[n] + aa[n][r]); kk[n] *= inv; k2[n] = ks[n] * (1.f + (a - 1.f) * kac[n]);
                const float bb = kk[n] * a; v2[n] = l == 0 ? vs[n] : vs[n] + (vf[n] - vs[n]) * sigmoidf_(v0v[n] + av[n][r]);
                rks += rs[n] * k2[n] * rkc[n];
                const float ec = __expf(cum[r][n]), en = __builtin_amdgcn_rcpf(ec), ep = ecp[n]; ecp[n] = ec; if (r == 3) gam[n] = ec;
                At[r][n] = -kk[n] * ep; Bt[r][n] = bb * en; Kt[r][n] = k2[n] * en; Rt[n] = rs[n] * ec; Vv[r][n] = v2[n]; }
            rks = row16_sum(rks);
#pragma unroll
            for (int n = 0; n < 4; ++n) { const float gg = ag[n][r]; Gp[n] = lnw[n] * gg; BGp[n] = (lnb[n] + rks * v2[n]) * gg; }
            { const int t = 4 * g + r;
              *(LAS s16x4*)(sl + O_W + (t * 64 + 4 * c) * 2) = pack4f(At[r][0], At[r][1], At[r][2], At[r][3]);
              *(LAS s16x4*)(sl + O_B + (t * 64 + 4 * c) * 2) = pack4f(Bt[r][0], Bt[r][1], Bt[r][2], Bt[r][3]);
              *(LAS s16x4*)(sl + O_K + (t * 64 + 4 * c) * 2) = pack4f(Kt[r][0], Kt[r][1], Kt[r][2], Kt[r][3]);
              *(LAS s16x4*)(sl + O_R + (t * 64 + 4 * c) * 2) = pack4f(Rt[0], Rt[1], Rt[2], Rt[3]);
              *(s16x4*)(ops + OPS_G + (t * 64 + 4 * c) * 2) = pack4f(Gp[0], Gp[1], Gp[2], Gp[3]);
              *(s16x4*)(ops + OPS_BG + (t * 64 + 4 * c) * 2) = pack4f(BGp[0], BGp[1], BGp[2], BGp[3]); }
            if (l == 0) *(v2u*)(C.VF() + (size_t)(row0 + 4 * g + r) * 512 + ch0) = (v2u){pk2(vs[0], vs[1]), pk2(vs[2], vs[3])};
        }
    }
    asm volatile("" ::: "memory");
    if (ncidx >= 0) prep_load_in(C, l, nbh, ncidx, lane, in);
    asm volatile("" ::: "memory");
#pragma unroll
    for (int n = 0; n < 4; ++n) { const int j = 4 * c + n;
        *(LAS s16x4*)(sl + O_AT + (j * 16 + 4 * g) * 2) = pack4f(At[0][n], At[1][n], At[2][n], At[3][n]);
        *(LAS s16x4*)(sl + O_BK + (j * 32 + 4 * g) * 2) = pack4f(Bt[0][n], Bt[1][n], Bt[2][n], Bt[3][n]);
        *(LAS s16x4*)(sl + O_BK + (j * 32 + 16 + 4 * g) * 2) = pack4f(Kt[0][n], Kt[1][n], Kt[2][n], Kt[3][n]);
        *(LAS s16x4*)(sl + O_VT + (j * 16 + 4 * g) * 2) = pack4f(Vv[0][n], Vv[1][n], Vv[2][n], Vv[3][n]); }
    if (g == 3) *(LAS f32x4*)(sl + O_GAM + 4 * c * 4) = (f32x4){gam[0], gam[1], gam[2], gam[3]};
    asm volatile("s_waitcnt lgkmcnt(0)" ::: "memory");
    {
        f32x4 aab = z4, aak = z4, arb = z4, ark = z4;
#pragma unroll
        for (int ks = 0; ks < 2; ++ks) {
            const bf16x8 Aa = *(const LAS bf16x8*)(sl + O_W + (c * 64 + 32 * ks + 8 * g) * 2), Ar = *(const LAS bf16x8*)(sl + O_R + (c * 64 + 32 * ks + 8 * g) * 2);
            const bf16x8 Bb = *(const LAS bf16x8*)(sl + O_B + (c * 64 + 32 * ks + 8 * g) * 2), Bk = *(const LAS bf16x8*)(sl + O_K + (c * 64 + 32 * ks + 8 * g) * 2);
            aab = mfma16(Aa, Bb, aab); aak = mfma16(Aa, Bk, aak); arb = mfma16(Ar, Bb, arb); ark = mfma16(Ar, Bk, ark);
        }
        asm volatile("" ::: "memory");
        f32x4 mk;
#pragma unroll
        for (int r = 0; r < 4; ++r) { const int t = 4 * g + r; const bool lo = c < t, li = c <= t;
            *(LAS float*)(sl + O_B + (t * 16 + c) * 4) = lo ? aab[r] : 0.f;
            mk[r] = lo ? aak[r] : 0.f;
            *(LAS bf16*)(sl + O_ARK + (t * 32 + c) * 2) = (bf16)f2bf(li ? arb[r] : 0.f);
            *(LAS bf16*)(sl + O_ARK + (t * 32 + 16 + c) * 2) = (bf16)f2bf(li ? ark[r] : 0.f); }
        *(LAS s16x4*)(sl + O_K + (c * 16 + 4 * g) * 2) = pack4(mk);
    }
    asm volatile("s_waitcnt lgkmcnt(0)" ::: "memory");
    {
        float X[16];
#pragma unroll
        for (int t = 0; t < 16; ++t) { float acc = (t == c) ? 1.f : 0.f;
#pragma unroll
            for (int s4 = 0; s4 < (t + 3) / 4; ++s4) { const f32x4 a4 = *(const LAS f32x4*)(sl + O_B + (t * 16 + 4 * s4) * 4);
#pragma unroll
                for (int e = 0; e < 4; ++e) if (4 * s4 + e < t) acc += a4[e] * X[4 * s4 + e]; }
            X[t] = acc; }
#pragma unroll
        for (int t = 0; t < 16; ++t) *(LAS bf16*)(sl + O_K + 512 + (t * 16 + c) * 2) = (bf16)f2bf(X[t]);
    }
    asm volatile("s_waitcnt lgkmcnt(0)" ::: "memory");
    {
        const bf16x8 Top = g < 2 ? *(const LAS bf16x8*)(sl + O_K + 512 + (c * 16 + 8 * g) * 2) : zero8;
#pragma unroll
        for (int n = 0; n < 4; ++n) { const bf16x8 Bop = g < 2 ? *(const LAS bf16x8*)(sl + O_AT + ((16 * n + c) * 16 + 8 * g) * 2) : zero8;
            const f32x4 wacc = mfma16(Top, Bop, z4);
#pragma unroll
            for (int r = 0; r < 4; ++r) *(LAS bf16*)(sl + O_W + ((4 * g + r) * 64 + 16 * n + c) * 2) = (bf16)f2bf(wacc[r]); }
        const bf16x8 Bop = g < 2 ? *(const LAS bf16x8*)(sl + O_K + (c * 16 + 8 * g) * 2) : zero8;
        const f32x4 ta = mfma16(Top, Bop, z4);
#pragma unroll
        for (int r = 0; r < 4; ++r) *(LAS bf16*)(sl + O_TA + ((4 * g + r) * 16 + c) * 2) = (bf16)f2bf(ta[r]);
    }
    asm volatile("s_waitcnt lgkmcnt(0)" ::: "memory");
    return ops;
}

__device__ __forceinline__ void phase_prep(const Ctx& C, int l, int half) {
    const int gw = C.bid * NWAVES + C.wid, NGW = C.G * NWAVES;
    LAS unsigned char* sl = C.lds + C.wid * SLOT;
    unsigned char* pops = nullptr; PrepIn pin;
    if (gw < 16 * 512) prep_load_in(C, l, 16 * half + (gw >> 9), gw & 511, lane_now(), pin);
    for (int u = gw; u < 16 * 512; u += NGW) { const int bhl = u >> 9, cidx = u & 511, nu = u + NGW;
        pops = prep_unit<false>(C, l, 16 * half + bhl, bhl, cidx, sl, pops, pin, true, 16 * half + (nu >> 9), nu < 16 * 512 ? (nu & 511) : -1); }
    if (pops) prep_copy(sl, pops, lane_now());
}

struct OpsSet { v4u d[10]; };
struct GbSet { v4u d[4]; };
struct VtSet { v2u v4[4]; };
constexpr int RING_SLOT = 11520, YB_OFF = 8 * RING_SLOT, YB_SLOT = 4096;
__device__ __forceinline__ int swz(int x) { return x + ((x >> 7) << 4); }

__device__ __forceinline__ void ld_ops(OpsSet& s, const unsigned char* ops, int c, int lane) {
    const unsigned char* p = ops + (size_t)(c < NCHUNK ? c : NCHUNK - 1) * OPSB + lane * 16;
#pragma unroll
    for (int i = 0; i < 10; ++i) s.d[i] = *(const v4u*)(p + i * 1024);
}
__device__ __forceinline__ void st_ops(const OpsSet& s, LAS unsigned char* ring, int c, int lane) {
    LAS unsigned char* p = ring + (c & 7) * RING_SLOT + lane * 16 + (lane >> 3) * 16;
#pragma unroll
    for (int i = 0; i < 10; ++i) *(LAS v4u*)(p + i * 1152) = s.d[i];
}
__device__ __forceinline__ void ld_gb(GbSet& s, const unsigned char* ops, int c, int lane) {
    const int t = lane >> 2, cg = lane & 3;
    const unsigned char* p = ops + (size_t)(c < NCHUNK ? c : NCHUNK - 1) * OPSB + (t * 64 + 16 * cg) * 2;
    s.d[0] = *(const v4u*)(p + OPS_G); s.d[1] = *(const v4u*)(p + OPS_G + 16); s.d[2] = *(const v4u*)(p + OPS_BG); s.d[3] = *(const v4u*)(p + OPS_BG + 16);
}
__device__ __forceinline__ void ld_vt(VtSet& s, const unsigned char* ops, int j, int wid, int lane) {
    const int g = lane >> 4, c = lane & 15;
#pragma unroll
    for (int u = 0; u < 4; ++u) { const int ch = 4 * j + u; const unsigned char* p = ops + (size_t)(ch < NCHUNK ? ch : NCHUNK - 1) * OPSB + OPS_VT + (16 * wid + c) * 32;
        s.v4[u] = *(const v2u*)(p + g * 8); }
}
__device__ __forceinline__ void out_stage(const Ctx& C, const GbSet& s, LAS unsigned char* ybuf, int b, int hh, int c, int lane) {
    const int t = lane >> 2, cg = lane & 3;
    const int row = (c == 0 ? MAINR : b * SEQ + 16 * (c - 1)) + t;
    const LAS float* yp = (const LAS float*)(ybuf + (c & 7) * YB_SLOT) + t * 64 + 16 * cg;
    f32x4 y[4];
#pragma unroll
    for (int i = 0; i < 4; ++i) y[i] = *(const LAS f32x4*)(yp + 4 * i);
    float s1 = 0.f;
#pragma unroll
    for (int i = 0; i < 4; ++i) s1 += (y[i].x + y[i].y) + (y[i].z + y[i].w);
    s1 = quad_sum(s1);
    const float mean = s1 * (1.f / 64.f); float s2 = 0.f;
#pragma unroll
    for (int i = 0; i < 4; ++i) { y[i] = y[i] - mean; s2 += (y[i].x * y[i].x + y[i].y * y[i].y) + (y[i].z * y[i].z + y[i].w * y[i].w); }
    s2 = quad_sum(s2);
    const float rstd = __builtin_amdgcn_rsqf(s2 * (1.f / 64.f) + GN_EPS);
    v4u o[2];
#pragma unroll
    for (int k = 0; k < 2; ++k) {
        const v4u gw = s.d[k], bw = s.d[2 + k]; unsigned ow[4];
#pragma unroll
        for (int e = 0; e < 4; ++e) { const f32x4 yy = y[2 * k + (e >> 1)]; const float ya = (e & 1) ? yy.z : yy.x, yb = (e & 1) ? yy.w : yy.y;
            const float g0 = __uint_as_float(gw[e] << 16), g1 = __uint_as_float(gw[e] & 0xffff0000u), b0 = __uint_as_float(bw[e] << 16), b1 = __uint_as_float(bw[e] & 0xffff0000u);
            ow[e] = pk2(ya * rstd * g0 + b0, yb * rstd * g1 + b1); }
        o[k] = (v4u){ow[0], ow[1], ow[2], ow[3]};
    }
    bf16* dst = C.U() + (size_t)row * DM + 512 + hh * 64 + 16 * cg;
    *(v4u*)dst = o[0]; *(v4u*)(dst + 8) = o[1];
}

struct ChEarly { bf16x8 Wp[2], Rp[2]; s16x4 TAop; };
struct ChLate { bf16x8 ARKp, BKp[4]; f32x4 gam[4]; };
__device__ __forceinline__ void chain_load_e(ChEarly& o, const LAS unsigned char* p1, const LAS unsigned char* p2, const int so) {
#pragma unroll
    for (int ks = 0; ks < 2; ++ks) {
        o.Wp[ks] = cat8(*(const LAS s16x4*)(p1 + so + 64 * ks), *(const LAS s16x4*)(p1 + so + 64 * ks + 32));
        o.Rp[ks] = cat8(*(const LAS s16x4*)(p1 + so + 2304 + 64 * ks), *(const LAS s16x4*)(p1 + so + 2304 + 64 * ks + 32)); }
    o.TAop = *(const LAS s16x4*)(p2 + so + 10368);
}
__device__ __forceinline__ void chain_load_l(ChLate& o, const LAS unsigned char* p3, const LAS unsigned char* p4, const int so) {
    o.ARKp = cat8(*(const LAS s16x4*)(p3 + so + 9216), *(const LAS s16x4*)(p3 + so + 9216 + 32));
#pragma unroll
    for (int q = 0; q < 4; ++q) { o.BKp[q] = cat8(*(const LAS s16x4*)(p3 + so + 4608 + 1152 * q), *(const LAS s16x4*)(p3 + so + 4608 + 1152 * q + 32));
        o.gam[q] = *(const LAS f32x4*)(p4 + so + 9728 + 76 * 16 + 64 * q + (q >= 2 ? 16 : 0)); }
}
__device__ __forceinline__ f32x4 chain_compute(const ChEarly& e, const ChLate& o, const v2u v4w, f32x4 (&ST)[4]) {
    const s16x4 V4 = __builtin_bit_cast(s16x4, v4w); const s16x4 zero4 = (s16x4){0, 0, 0, 0};
    const bf16x8 TAop = cat8(e.TAop, zero4), Vb = cat8(V4, zero4);
    const f32x4 z4 = (f32x4){0.f, 0.f, 0.f, 0.f};
    const bf16x8 Bk0 = cat8(pack4(ST[0]), pack4(ST[1])), Bk1 = cat8(pack4(ST[2]), pack4(ST[3]));
    f32x4 U = mfma16(e.Wp[0], Bk0, z4); U = mfma16(e.Wp[1], Bk1, U); U = mfma16(TAop, Vb, U);
    f32x4 Y = mfma16(e.Rp[0], Bk0, z4); Y = mfma16(e.Rp[1], Bk1, Y);
    const bf16x8 UV = cat8(pack4(U), V4);
    Y = mfma16(o.ARKp, UV, Y);
#pragma unroll
    for (int q = 0; q < 4; ++q) { ST[q] = mfma16(o.BKp[q], UV, ST[q]); ST[q] = ST[q] * o.gam[q]; }
    return Y;
}

#define WAIT_LAST() do { unsigned sp_ = 0; while (__hip_atomic_load(flagw, __ATOMIC_RELAXED, __HIP_MEMORY_SCOPE_AGENT) < 2u && ++sp_ < (1u << 20)) __builtin_amdgcn_s_sleep(8); \
    __builtin_amdgcn_fence(__ATOMIC_ACQUIRE, "agent"); asm volatile("s_waitcnt vmcnt(0)" ::: "memory"); } while (0)
#define WG_BAR() do { asm volatile("s_waitcnt lgkmcnt(0)" ::: "memory"); __builtin_amdgcn_s_barrier(); asm volatile("" ::: "memory"); } while (0)
#define YSTORE(ch, Yv) do { _Pragma("unroll") for (int r = 0; r < 4; ++r) *(LAS float*)(ybuf + ((ch) & 7) * YB_SLOT + ((4 * (lane >> 4) + r) * 64 + 16 * wid + (lane & 15)) * 4) = (Yv)[r]; } while (0)
#define CHAIN_IT(j, VTU, HB) do { \
    ChEarly ea, eb; ChLate la; f32x4 Yv; \
    chain_load_e(ea, p1 + HB, p2 + HB, 0); \
    chain_load_l(la, p3 + HB, p4 + HB, 0); chain_load_e(eb, p1 + HB, p2 + HB, RING_SLOT); \
    Yv = chain_compute(ea, la, VTU.v4[0], ST); YSTORE(4 * (j) + 0, Yv); \
    chain_load_l(la, p3 + HB, p4 + HB, RING_SLOT); chain_load_e(ea, p1 + HB, p2 + HB, 2 * RING_SLOT); \
    Yv = chain_compute(eb, la, VTU.v4[1], ST); YSTORE(4 * (j) + 1, Yv); \
    chain_load_l(la, p3 + HB, p4 + HB, 2 * RING_SLOT); chain_load_e(eb, p1 + HB, p2 + HB, 3 * RING_SLOT); \
    Yv = chain_compute(ea, la, VTU.v4[2], ST); YSTORE(4 * (j) + 2, Yv); \
    chain_load_l(la, p3 + HB, p4 + HB, 3 * RING_SLOT); \
    Yv = chain_compute(eb, la, VTU.v4[3], ST); YSTORE(4 * (j) + 3, Yv); \
    ld_vt(VTU, ops, (j) + 2, wid, lane); WG_BAR(); } while (0)
#define LOAD_IT(j, OSW, OSI, GBO, GBI) do { \
    const int co = 4 * ((j) - 1) + lw; if ((j) >= 1 && co < NCHUNK) out_stage(C, GBO, ybuf, b, hh, co, lane); \
    const int cn = 4 * ((j) + 1) + lw; if (cn < NCHUNK) st_ops(OSW, ring, cn, lane); \
    ld_ops(OSI, ops, 4 * ((j) + 3) + lw, lane); ld_gb(GBI, ops, cn, lane); WG_BAR(); } while (0)

__device__ __forceinline__ void chain_phase(const Ctx& C, int bh, int bhl, unsigned* flagw) {
    int lane_ = lane_now(); const int lane = lane_, wid = C.wid;
    const int b = bh >> 3, hh = bh & 7;
    LAS unsigned char* ring = C.lds; LAS unsigned char* ybuf = C.lds + YB_OFF;
    const unsigned char* ops = C.ws + WS_OPS + (size_t)bhl * NCHUNK * OPSB;
    constexpr int NIT = 132;
    if (wid < 4) {
        f32x4 ST[4];
#pragma unroll
        for (int q = 0; q < 4; ++q) ST[q] = (f32x4){0.f, 0.f, 0.f, 0.f};
        VtSet vt0, vt1;
        ld_vt(vt0, ops, 0, wid, lane); ld_vt(vt1, ops, 1, wid, lane);
        WG_BAR();
        __builtin_amdgcn_s_setprio(3);
        const int g_ = lane >> 4, c_ = lane & 15;
        const LAS unsigned char* p1 = ring + c_ * 144 + 8 * g_;
        const LAS unsigned char* p2 = ring + c_ * 32 + 8 * g_ + (c_ >> 2) * 16;
        const LAS unsigned char* p3 = ring + c_ * 64 + 8 * g_ + (c_ >> 1) * 16;
        const LAS unsigned char* p4 = ring + 16 * g_;
#pragma unroll 1
        for (int j = 0; j < NIT; j += 2) {
            if (j == 96) WAIT_LAST();
#ifndef NOCHAIN
            CHAIN_IT(j, vt0, 0); CHAIN_IT(j + 1, vt1, 4 * RING_SLOT);
#endif
        }
        __builtin_amdgcn_s_setprio(0);
    } else {
        const int lw = wid - 4;
        OpsSet os0, os1, os2; GbSet gb0, gb1, gb2;
        ld_ops(os0, ops, lw, lane); ld_ops(os1, ops, 4 + lw, lane); ld_ops(os2, ops, 8 + lw, lane); ld_gb(gb0, ops, lw, lane); st_ops(os0, ring, lw, lane);
        gb1 = gb0; gb2 = gb0;
        WG_BAR();
#pragma unroll 1
        for (int j = 0; j < NIT; j += 3) {
            if (j == 96) WAIT_LAST();
#ifndef NOLOADER
            LOAD_IT(j, os1, os0, gb2, gb1); LOAD_IT(j + 1, os2, os1, gb0, gb2); LOAD_IT(j + 2, os0, os2, gb1, gb0);
#endif
        }
    }
}

constexpr int SCW = 8224;
constexpr int LDS_HIST = 8 * SCW * 2;
constexpr int LDS_IDX = LDS_HIST + 8 * 256 * 4;
constexpr int LDS_MISC = LDS_IDX + 8 * 256 * 2;
static_assert(LDS_MISC + 64 <= LDS_BYTES && 8 * 18432 <= LDS_BYTES && 8 * 10240 + 8 * 4096 <= LDS_MISC, "lds map");

__device__ __forceinline__ unsigned mbcnt64(unsigned long long m) { return __builtin_amdgcn_mbcnt_hi((unsigned)(m >> 32), __builtin_amdgcn_mbcnt_lo((unsigned)m, 0u)); }

__device__ __forceinline__ void find_bin(LAS unsigned* hist, unsigned target, int lane, unsigned& bin, unsigned& above) {
    const v4u c = *(LAS v4u*)(hist + 4 * lane);
    const unsigned t = c.x + c.y + c.z + c.w;
    const unsigned inc = wave_scan_incl(t);
    const unsigned total = lane_bcast(inc, 63);
    const unsigned sufx = total - inc;
    const bool found = (sufx < target) && (target <= sufx + t);
    unsigned mybin = 0, myab = 0;
    if (found) { unsigned a = sufx;
        if (a + c.w >= target) { mybin = 4 * lane + 3; myab = a; } else { a += c.w;
        if (a + c.z >= target) { mybin = 4 * lane + 2; myab = a; } else { a += c.z;
        if (a + c.y >= target) { mybin = 4 * lane + 1; myab = a; } else { a += c.y; mybin = 4 * lane; myab = a; } } } }
    const unsigned long long m = __ballot(found);
    const int src = m ? (int)__builtin_ctzll(m) : 0;
    bin = lane_bcast(mybin, src); above = lane_bcast(myab, src);
}

__device__ __forceinline__ void attn_unit(const Ctx& C, int l, int b, int qt) {
    const int lane = lane_now(), wid = C.wid, tid = wid * 64 + lane;
    const int p0 = 8 * qt, nk = p0 + 8, ntile = (nk + 31) >> 5, nkp = ntile * 32;
    LAS u16* SC = (LAS u16*)C.lds; LAS unsigned* HIST = (LAS unsigned*)(C.lds + LDS_HIST); LAS u16* IDX = (LAS u16*)(C.lds + LDS_IDX);
    for (int i = tid; i < 8 * 256; i += NT) HIST[i] = 0u;
    __syncthreads();
    const bf16* Z = C.Z();
    {
        const int r = lane & 31, half = lane >> 5;
        const int rowq = row_of(b, p0 + (r >> 2));
        bf16x8 Af[4];
#pragma unroll
        for (int s = 0; s < 4; ++s) Af[s] = *(const bf16x8*)(Z + (size_t)rowq * ZC + C_QI + (r & 3) * 64 + 16 * s + 8 * half);
        float wi[4][4];
#pragma unroll
        for (int g = 0; g < 4; ++g) { const int rg = row_of(b, p0 + 2 * g + half);
#pragma unroll
            for (int hh = 0; hh < 4; ++hh) wi[g][hh] = bf2f(Z[(size_t)rg * ZC + C_WI + hh]) * 0.0625f; }
        const unsigned char* kib = (const unsigned char*)(C.KI() + (size_t)b * TPAD * 64); const unsigned klane = (unsigned)lane * 16u;
        const unsigned char* kib2 = (const unsigned char*)(C.KI() + (size_t)((b + 1) & 3) * TPAD * 64);
#define SC_LOAD2(P, ka_, kb_) do { const int ka__ = (ka_), kb__ = (kb_); _Pragma("unroll") for (int s = 0; s < 4; ++s) { P[0][s] = *(const bf16x8*)(kib + ((unsigned)ka__ * 4096u + 1024u * s + klane)); P[1][s] = *(const bf16x8*)(kib + ((unsigned)kb__ * 4096u + 1024u * s + klane)); } } while (0)
#define SC_LOAD(P, kt_) do { _Pragma("unroll") for (int s = 0; s < 4; ++s) { P[0][s] = *(const bf16x8*)(kib + ((unsigned)(kt_) * 4096u + 1024u * s + klane)); P[1][s] = *(const bf16x8*)(kib + ((unsigned)((kt_) + 8) * 4096u + 1024u * s + klane)); \
    if (PROBE == 6) { bf16x8 d0 = *(const bf16x8*)(kib2 + ((unsigned)(kt_) * 4096u + 1024u * s + klane)), d1 = *(const bf16x8*)(kib2 + ((unsigned)((kt_) + 8) * 4096u + 1024u * s + klane)); asm volatile("" :: "v"(d0), "v"(d1)); } } } while (0)
#define SC_MFMA(acc, Bq) do { _Pragma("unroll") for (int e = 0; e < 16; ++e) acc[e] = 0.f; \
            _Pragma("unroll") for (int s = 0; s < 4; ++s) acc = __builtin_amdgcn_mfma_f32_32x32x16_bf16(Af[s], Bq[s], acc, 0, 0, 0); } while (0)
#define SC_KEY2(a_, b_) ({ const h2v hh_ = __builtin_convertvector((f32x2h){(a_), (b_)}, h2v); const unsigned w_ = __builtin_bit_cast(unsigned, hh_); \
            const s2v m_ = __builtin_bit_cast(s2v, w_) >> 15; w_ ^ (__builtin_bit_cast(unsigned, m_) | 0x80008000u); })
#define SC_SCORES(acc) float scv[4]; \
            _Pragma("unroll") for (int g = 0; g < 4; ++g) { \
                const float r0 = relu_i(acc[4 * g + 0]), r1 = relu_i(acc[4 * g + 1]), r2 = relu_i(acc[4 * g + 2]), r3 = relu_i(acc[4 * g + 3]); \
                scv[g] = __builtin_fmaf(wi[g][3], r3, __builtin_fmaf(wi[g][2], r2, __builtin_fmaf(wi[g][1], r1, wi[g][0] * r0))); } \
            const unsigned w01 = SC_KEY2(scv[0], scv[1]), w23 = SC_KEY2(scv[2], scv[3]);
#define SC_EMIT_FULL() do { \
                SC[(0 + half) * SCW + key] = (u16)w01; SC[(2 + half) * SCW + key] = (u16)(w01 >> 16); SC[(4 + half) * SCW + key] = (u16)w23; SC[(6 + half) * SCW + key] = (u16)(w23 >> 16); \
                atomicAdd((unsigned*)(HIST + (0 + half) * 256 + ((w01 >> 8) & 0xffu)), 1u); atomicAdd((unsigned*)(HIST + (2 + half) * 256 + (w01 >> 24)), 1u); \
                atomicAdd((unsigned*)(HIST + (4 + half) * 256 + ((w23 >> 8) & 0xffu)), 1u); atomicAdd((unsigned*)(HIST + (6 + half) * 256 + (w23 >> 24)), 1u); } while (0)
#define SC_VALU_FAST(acc, kt_) do { const int key = (kt_) * 32 + r; SC_SCORES(acc) SC_EMIT_FULL(); } while (0)
#define SC_VALU(acc, kt_) do { const int kt__ = (kt_); if (kt__ < ntile) { const int key = kt__ * 32 + r; SC_SCORES(acc) \
            if (kt__ * 32 + 31 <= p0) SC_EMIT_FULL(); \
            else { \
                _Pragma("unroll") for (int g = 0; g < 4; ++g) { const unsigned wp = g < 2 ? w01 : w23; unsigned k16 = (g & 1) ? (wp >> 16) : (wp & 0xffffu); \
                    const int qq = 2 * g + half; const bool valid = key <= p0 + qq; \
                    if (!valid) k16 = 0u; \
                    SC[qq * SCW + key] = (u16)k16; \
                    if (valid) atomicAdd((unsigned*)(HIST + qq * 256 + (k16 >> 8)), 1u); } } } } while (0)
        bf16x8 P0[2][4], P1[2][4], P2[2][4];
        _Pragma("unroll 1") for (int rep7 = 0, n7 = (PROBE == 7 ? launder2() : 1); rep7 < n7; ++rep7) {
        LAS unsigned* HISTsave = HIST; if (rep7) HIST = (LAS unsigned*)(C.lds + 144384);
        const int nst = (ntile + 7) >> 3, nfull = (p0 + 1) >> 5, jfull = nfull > wid ? (nfull - wid + 7) >> 3 : 0;
#define TIDX(j) (wid + 8 * (j))
#define TSAFE(j) ((j) < nst ? TIDX(j) : wid)
        SC_LOAD2(P0, TSAFE(0), TSAFE(1)); SC_LOAD2(P1, TSAFE(2), TSAFE(3));
        int j = 0;
        for (; j + 6 <= jfull; j += 6) {
            f32x16 acc0, acc1;
            SC_LOAD2(P2, TSAFE(j + 4), TSAFE(j + 5));
            SC_MFMA(acc0, P0[0]); SC_MFMA(acc1, P0[1]); SC_VALU_FAST(acc0, TIDX(j)); SC_VALU_FAST(acc1, TIDX(j + 1));
            SC_LOAD2(P0, TSAFE(j + 6), TSAFE(j + 7));
            SC_MFMA(acc0, P1[0]); SC_MFMA(acc1, P1[1]); SC_VALU_FAST(acc0, TIDX(j + 2)); SC_VALU_FAST(acc1, TIDX(j + 3));
            SC_LOAD2(P1, TSAFE(j + 8), TSAFE(j + 9));
            SC_MFMA(acc0, P2[0]); SC_MFMA(acc1, P2[1]); SC_VALU_FAST(acc0, TIDX(j + 4)); SC_VALU_FAST(acc1, TIDX(j + 5));
        }
        for (; j < nst; j += 6) {
            f32x16 acc0, acc1;
            SC_LOAD2(P2, TSAFE(j + 4), TSAFE(j + 5));
            SC_MFMA(acc0, P0[0]); SC_MFMA(acc1, P0[1]); SC_VALU(acc0, TSAFE(j)); if (j + 1 < nst) SC_VALU(acc1, TIDX(j + 1));
            SC_LOAD2(P0, TSAFE(j + 6), TSAFE(j + 7));
            SC_MFMA(acc0, P1[0]); SC_MFMA(acc1, P1[1]); if (j + 2 < nst) SC_VALU(acc0, TIDX(j + 2)); if (j + 3 < nst) SC_VALU(acc1, TIDX(j + 3));
            SC_LOAD2(P1, TSAFE(j + 8), TSAFE(j + 9));
            SC_MFMA(acc0, P2[0]); SC_MFMA(acc1, P2[1]); if (j + 4 < nst) SC_VALU(acc0, TIDX(j + 4)); if (j + 5 < nst) SC_VALU(acc1, TIDX(j + 5));
        }
#undef TIDX
#undef TSAFE
        HIST = HISTsave; }
#undef SC_LOAD
#undef SC_LOAD2
#undef SC_MFMA
#undef SC_VALU
#undef SC_VALU_FAST
#undef SC_SCORES
#undef SC_EMIT_FULL
#undef SC_KEY2
    }
    __syncthreads();
    const int q = wid, p = p0 + q, nvalid = p + 1, nsel = nvalid < 256 ? nvalid : 256;
    LAS u16* sc = SC + q * SCW; LAS unsigned* hist = HIST + q * 256; LAS u16* idx = IDX + q * 256;
    if (nvalid <= 256) { for (int i = lane; i < nvalid; i += 64) idx[i] = (u16)i; }
    else {
        unsigned b1, ab1; find_bin(hist, 256u, lane, b1, ab1);
        _Pragma("unroll 1") for (int rep8 = 0, n8 = (PROBE == 8 ? launder2() : 1); rep8 < n8; ++rep8) {
        asm volatile("s_waitcnt lgkmcnt(0)" ::: "memory");
        { unsigned z_ = 0u; asm volatile("" : "+v"(z_)); *(LAS v4u*)(hist + 4 * lane) = (v4u){z_, z_, z_, z_}; }
        asm volatile("s_waitcnt lgkmcnt(0)" ::: "memory");
        const int niter = (nkp + 255) >> 8;
        {   v2u cur = 4 * lane < nkp ? *(LAS v2u*)(sc + 4 * lane) : (v2u){0u, 0u};
            for (int it = 0; it < niter; ++it) { const int in = (it + 1) * 256 + 4 * lane; const v2u nxt = in < nkp ? *(LAS v2u*)(sc + in) : (v2u){0u, 0u};
                const unsigned k0 = cur.x & 0xffffu, k1 = cur.x >> 16, k2 = cur.y & 0xffffu, k3 = cur.y >> 16;
                if ((k0 >> 8) == b1) atomicAdd((unsigned*)(hist + (k0 & 255u)), 1u);
                if ((k1 >> 8) == b1) atomicAdd((unsigned*)(hist + (k1 & 255u)), 1u);
                if ((k2 >> 8) == b1) atomicAdd((unsigned*)(hist + (k2 & 255u)), 1u);
                if ((k3 >> 8) == b1) atomicAdd((unsigned*)(hist + (k3 & 255u)), 1u);
                cur = nxt; } }
        asm volatile("s_waitcnt lgkmcnt(0)" ::: "memory");
        unsigned b2, ab2; find_bin(hist, 256u - ab1, lane, b2, ab2);
        const unsigned T16 = (b1 << 8) | b2; const unsigned need_eq = 256u - ab1 - ab2;
        unsigned eq_base = 0u;
        LAS unsigned* bmp = (LAS unsigned*)sc;
        unsigned c0 = lane < nkp ? sc[lane] : 0u, c1 = 64 + lane < nkp ? sc[64 + lane] : 0u, c2 = 128 + lane < nkp ? sc[128 + lane] : 0u, c3 = 192 + lane < nkp ? sc[192 + lane] : 0u;
        for (int it = 0; it < niter; ++it) { const int nb = (it + 1) * 256 + lane;
            const unsigned n0 = nb < nkp ? sc[nb] : 0u, n1 = nb + 64 < nkp ? sc[nb + 64] : 0u, n2 = nb + 128 < nkp ? sc[nb + 128] : 0u, n3 = nb + 192 < nkp ? sc[nb + 192] : 0u;
            const unsigned k[4] = {c0, c1, c2, c3};
            unsigned long long mt[4];
#pragma unroll
            for (int j = 0; j < 4; ++j) mt[j] = __ballot(k[j] > T16);
            if (__ballot(k[0] == T16 || k[1] == T16 || k[2] == T16 || k[3] == T16)) {
#pragma unroll
                for (int j = 0; j < 4; ++j) { const bool eq = k[j] == T16; const unsigned long long me = __ballot(eq);
                    mt[j] |= __ballot(eq && (eq_base + mbcnt64(me)) < need_eq); eq_base += (unsigned)__popcll(me); }
            }
            if (lane == 0) { *(LAS v4u*)(bmp + it * 8) = (v4u){(unsigned)mt[0], (unsigned)(mt[0] >> 32), (unsigned)mt[1], (unsigned)(mt[1] >> 32)};
                             *(LAS v4u*)(bmp + it * 8 + 4) = (v4u){(unsigned)mt[2], (unsigned)(mt[2] >> 32), (unsigned)mt[3], (unsigned)(mt[3] >> 32)}; }
            c0 = n0; c1 = n1; c2 = n2; c3 = n3; }
        asm volatile("s_waitcnt lgkmcnt(0)" ::: "memory");
        {
            const int ndw = niter * 8;
            v4u d4 = (v4u){0u, 0u, 0u, 0u};
            if (4 * lane < ndw) d4 = *(const LAS v4u*)(bmp + 4 * lane);
            const unsigned cnt = (unsigned)(__builtin_popcount(d4.x) + __builtin_popcount(d4.y) + __builtin_popcount(d4.z) + __builtin_popcount(d4.w));
            const unsigned inc = wave_scan_incl(cnt);
            unsigned pos = inc - cnt; const unsigned tot = lane_bcast(inc, 63);
            const unsigned dt = ndw > 256 ? bmp[256] : 0u;
#pragma unroll
            for (int w = 0; w < 4; ++w) { unsigned d = d4[w]; while (d) { const unsigned bit = (unsigned)__builtin_ctz(d); if (pos < 256u) idx[pos] = (u16)((4 * lane + w) * 32 + bit); ++pos; d &= d - 1u; } }
            if (lane == 0) { unsigned d = dt, ps = tot; while (d) { const unsigned bit = (unsigned)__builtin_ctz(d); if (ps < 256u) idx[ps] = (u16)(8192u + bit); ++ps; d &= d - 1u; } }
        }
        }
    }
    asm volatile("s_waitcnt lgkmcnt(0)" ::: "memory");
    if (p < NMETA && b != 0) return;
    const int row = row_of(b, p);
    if (nsel < 256) { for (int i = nsel + lane; i < 256; i += 64) idx[i] = (u16)0; asm volatile("s_waitcnt lgkmcnt(0)" ::: "memory"); }
    _Pragma("unroll 1") for (int rep9 = 0, n9 = (PROBE == 9 ? launder2() : 1); rep9 < n9; ++rep9)
    {
        const int g = lane >> 4, c = lane & 15;
        const bf16x8 zero8 = (bf16x8){0, 0, 0, 0, 0, 0, 0, 0};
        bf16x8 qB[2];
#pragma unroll
        for (int ks = 0; ks < 2; ++ks) qB[ks] = c < 8 ? *(const bf16x8*)(Z + (size_t)row * ZC + C_Q + c * 64 + 32 * ks + 8 * g) : zero8;
        const unsigned char* kbase = (const unsigned char*)(C.KATT() + (size_t)b * TPAD * 64);
        f32x4 S[16];
        {
            bf16x8 Kf0[8][2], Kf1[8][2];
#pragma unroll
            for (int t4 = 0; t4 < 8; ++t4) { const int slot = 16 * t4 + c; const int kix = (int)idx[slot];
                const unsigned ko = (unsigned)kix * 128u + 16u * (unsigned)g; Kf0[t4][0] = *(const bf16x8*)(kbase + ko); Kf0[t4][1] = *(const bf16x8*)(kbase + ko + 64u); }
#pragma unroll
            for (int t4 = 0; t4 < 8; ++t4) { const int slot = 16 * (8 + t4) + c; const int kix = (int)idx[slot];
                const unsigned ko = (unsigned)kix * 128u + 16u * (unsigned)g; Kf1[t4][0] = *(const bf16x8*)(kbase + ko); Kf1[t4][1] = *(const bf16x8*)(kbase + ko + 64u); }
#pragma unroll
            for (int t4 = 0; t4 < 8; ++t4) { f32x4 a = mfma16(Kf0[t4][0], qB[0], (f32x4){0.f, 0.f, 0.f, 0.f}); S[t4] = mfma16(Kf0[t4][1], qB[1], a); }
#pragma unroll
            for (int t4 = 0; t4 < 8; ++t4) { f32x4 a = mfma16(Kf1[t4][0], qB[0], (f32x4){0.f, 0.f, 0.f, 0.f}); S[8 + t4] = mfma16(Kf1[t4][1], qB[1], a); }
            asm volatile("" ::: "memory");
        }
        LAS unsigned char* VL = (LAS unsigned char*)sc;
        const unsigned char* vbase = (const unsigned char*)(C.VATT() + (size_t)b * TPAD * 64);
        const unsigned tr_base = (unsigned)(size_t)VL + (unsigned)(((4 * g + ((lane & 15) >> 2)) * 64 + 4 * (lane & 3)) * 2);
        v4u vv0[16], vv1[16];
#define V_GATHER(vv, hf, i0, i1) do { _Pragma("unroll") for (int i = (i0); i < (i1); ++i) { const int e = i * 64 + lane; const int sl = (hf) * 128 + (e >> 3); const int kix = (int)idx[sl]; \
            vv[i] = *(const v4u*)(vbase + ((unsigned)kix * 128u + (unsigned)(e & 7) * 16u)); } } while (0)
        V_GATHER(vv0, 0, 0, 16);
        asm volatile("" ::: "memory");
        if (nsel < 256) {
#pragma unroll
            for (int kt = 0; kt < 16; ++kt)
#pragma unroll
                for (int r = 0; r < 4; ++r) { const int slot = 16 * kt + 4 * g + r; if (slot >= nsel) S[kt][r] = -INFINITY; }
        }
        float mx = -INFINITY;
#pragma unroll
        for (int kt = 0; kt < 16; ++kt)
#pragma unroll
            for (int r = 0; r < 4; ++r) mx = fmaxf(mx, S[kt][r]);
        mx = xor16_max(mx); mx = xor32_max(mx);
        const float sl2 = 0.125f * 1.4426950408889634f, m2 = mx * sl2;
        float sum = 0.f;
#pragma unroll
        for (int kt = 0; kt < 16; ++kt)
#pragma unroll
            for (int r = 0; r < 4; ++r) { const float e = __builtin_amdgcn_exp2f(__builtin_fmaf(S[kt][r], sl2, -m2)); S[kt][r] = e; sum += e; }
        sum = xor16_sum(sum); sum = xor32_sum(sum);
        const float inv = __builtin_amdgcn_rcpf(sum);
        f32x4 O[4];
#pragma unroll
        for (int dt = 0; dt < 4; ++dt) O[dt] = (f32x4){0.f, 0.f, 0.f, 0.f};
        asm volatile("" ::: "memory");
        V_GATHER(vv1, 1, 0, 8);
        asm volatile("" ::: "memory");
#define PV_HALF(vv, hf) do { \
            _Pragma("unroll") for (int i = 0; i < 16; ++i) *(LAS v4u*)(VL + (i * 64 + lane) * 16) = vv[i]; \
            if ((hf) == 0) { asm volatile("" ::: "memory"); V_GATHER(vv1, 1, 8, 16); } \
            asm volatile("s_waitcnt lgkmcnt(0)" ::: "memory"); \
            _Pragma("unroll") for (int kk = 0; kk < 4; ++kk) { \
                const bf16x8 Bp = cat8(pack4(S[(hf) * 8 + 2 * kk]), pack4(S[(hf) * 8 + 2 * kk + 1])); \
                s16x4 lo0, hi0, lo1, hi1, lo2, hi2, lo3, hi3; \
                asm volatile("ds_read_b64_tr_b16 %0, %8 offset:%c9\n\tds_read_b64_tr_b16 %1, %8 offset:%c10\n\tds_read_b64_tr_b16 %2, %8 offset:%c11\n\tds_read_b64_tr_b16 %3, %8 offset:%c12\n\t" \
                             "ds_read_b64_tr_b16 %4, %8 offset:%c13\n\tds_read_b64_tr_b16 %5, %8 offset:%c14\n\tds_read_b64_tr_b16 %6, %8 offset:%c15\n\tds_read_b64_tr_b16 %7, %8 offset:%c16\n\ts_waitcnt lgkmcnt(0)" \
                             : "=&v"(lo0), "=&v"(hi0), "=&v"(lo1), "=&v"(hi1), "=&v"(lo2), "=&v"(hi2), "=&v"(lo3), "=&v"(hi3) \
                             : "v"(tr_base), "i"(kk * 4096), "i"(kk * 4096 + 2048), "i"(kk * 4096 + 32), "i"(kk * 4096 + 32 + 2048), "i"(kk * 4096 + 64), "i"(kk * 4096 + 64 + 2048), "i"(kk * 4096 + 96), "i"(kk * 4096 + 96 + 2048) : "memory"); \
                O[0] = mfma16(cat8(lo0, hi0), Bp, O[0]); O[1] = mfma16(cat8(lo1, hi1), Bp, O[1]); O[2] = mfma16(cat8(lo2, hi2), Bp, O[2]); O[3] = mfma16(cat8(lo3, hi3), Bp, O[3]); } \
            asm volatile("" ::: "memory"); } while (0)
        PV_HALF(vv0, 0);
        PV_HALF(vv1, 1);
#undef V_GATHER
#undef PV_HALF
        if (c < 8) {
#pragma unroll
            for (int dt = 0; dt < 4; ++dt) { const f32x4 o = O[dt] * inv; *(v2u*)(C.U() + (size_t)row * DM + c * 64 + 16 * dt + 4 * g) = (v2u){pk2(o.x, o.y), pk2(o.z, o.w)}; }
        }
    }
}

constexpr int NUNITS = 1026 * NB;
__device__ __forceinline__ void phase_seq(const Ctx& C, int l, int half) {
    unsigned* ctr = C.CTL() + 64 + 64 * l;
    unsigned* done = C.CTL() + 64 * 8 + 64 * (2 * l + half);
    unsigned* flagw = C.CTL() + 64 * (40 + 2 * l + half);
    if (C.bid == 16 || C.bid == 17) {
        const int bhl = (C.bid - 16) * 8 + C.wid;
        { PrepIn pin1; unsigned char* po = prep_unit<false>(C, l, 16 * half + bhl, bhl, 512, C.lds + C.wid * SLOT, nullptr, pin1, false, 0, -1); prep_copy(C.lds + C.wid * SLOT, po, lane_now()); }
        asm volatile("s_waitcnt vmcnt(0)" ::: "memory"); __syncthreads();
        if (C.wid == 0 && lane_now() == 0) { __builtin_amdgcn_fence(__ATOMIC_RELEASE, "agent"); asm volatile("s_waitcnt vmcnt(0)" ::: "memory"); __hip_atomic_fetch_add(flagw, 1u, __ATOMIC_RELAXED, __HIP_MEMORY_SCOPE_AGENT); }
        __syncthreads();
    }
    if (C.bid < 16) { _Pragma("unroll 1") for (int rep4 = 0, n4 = (PROBE == 4 ? launder2() : 1); rep4 < n4; ++rep4) { chain_phase(C, 16 * half + C.bid, C.bid, flagw); __syncthreads(); }
        if (C.wid == 0 && lane_now() == 0) __hip_atomic_fetch_add(done, 1u, __ATOMIC_RELAXED, __HIP_MEMORY_SCOPE_AGENT); }
    LAS unsigned* shu = (LAS unsigned*)(C.lds + LDS_MISC);
    _Pragma("unroll 1") for (int rep5 = 0, n5 = ((PROBE == 5 && half == 1) ? launder2() : 1); rep5 < n5; ++rep5) {
    int bpref = (int)(((unsigned)__builtin_amdgcn_s_getreg((3 << 11) | 20) & 7u) >> 1);
    unsigned* cb = C.CTL() + 64 * (16 + 8 * l + 4 * rep5);
    auto fetch = [&](int& bp) -> unsigned {
        if (half == 0 && __hip_atomic_load(done, __ATOMIC_RELAXED, __HIP_MEMORY_SCOPE_AGENT) >= 16u) return 0xffffffffu;
        for (int t = 0; t < 4; ++t) { const unsigned u = atomicAdd(cb + bp, 1u); if (u < 1026u) return u | ((unsigned)bp << 16); bp = (bp + 1) & 3; }
        return 0xffffffffu; };
    unsigned nxt = 0xffffffffu;
    if (C.wid == 0 && lane_now() == 0) shu[0] = fetch(bpref);
    __syncthreads();
    for (;;) {
        const unsigned u = shu[0];
        __syncthreads();
        if (u == 0xffffffffu) break;
        if (C.wid == 0 && lane_now() == 0) nxt = fetch(bpref);
        const int qt = 1025 - (int)(u & 0xffffu), b = (int)(u >> 16);
        if (!(qt < 2 && b != 0)) attn_unit(C, l, b, qt);
        __syncthreads();
        if (C.wid == 0 && lane_now() == 0) shu[0] = nxt;
        __syncthreads();
    }
    }
    if (half == 0) {
        if (C.wid == 0 && lane_now() == 0) { while (__hip_atomic_load(done, __ATOMIC_RELAXED, __HIP_MEMORY_SCOPE_AGENT) < 16u) __builtin_amdgcn_s_sleep(8); }
        __syncthreads();
    }
}

template <int ACT>
__device__ __forceinline__ void meta_gemm(const Ctx& C, const bf16* A, const bf16* Bt, int K, int N, bf16* O, int ldc) {
    int lane_ = lane_now(); const int lane = lane_, g = lane >> 4, c = lane & 15, wid = C.wid;
    LAS float* red = (LAS float*)C.lds;
    const int kw = K / NWAVES;
    for (int unit = C.bid; unit < N / 16; unit += C.G) {
        const bf16* ap = A + (size_t)(MAINR + c) * K + wid * kw + 8 * g; const bf16* bp = Bt + (size_t)(unit * 16 + c) * K + wid * kw + 8 * g;
        f32x4 acc = (f32x4){0.f, 0.f, 0.f, 0.f};
        for (int k0 = 0; k0 < kw; k0 += 128) {
            bf16x8 af[4], bfr[4];
#pragma unroll
            for (int s = 0; s < 4; ++s) { af[s] = *(const bf16x8*)(ap + k0 + 32 * s); bfr[s] = *(const bf16x8*)(bp + k0 + 32 * s); }
#pragma unroll
            for (int s = 0; s < 4; ++s) acc = mfma16(af[s], bfr[s], acc);
        }
        *(LAS f32x4*)(red + (wid * 64 + lane) * 4) = acc;
        __syncthreads();
        if (wid == 0) {
            f32x4 t = acc;
#pragma unroll
            for (int w = 1; w < NWAVES; ++w) t = t + *(const LAS f32x4*)(red + (w * 64 + lane) * 4);
#pragma unroll
            for (int r = 0; r < 4; ++r) { float v = t[r]; if (ACT == 2) { v = fmaxf(v, 0.f); v = v * v; }
                O[(size_t)(MAINR + 4 * g + r) * ldc + unit * 16 + c] = (bf16)f2bf(v); }
        }
        __syncthreads();
    }
}

template <int ACT, bool OUT8>
__device__ __forceinline__ void meta_gemm8(const Ctx& C, const unsigned char* A, const unsigned char* Bt, int K, int N, void* Ov, int ldc, float omul, float hmul) {
    int lane_ = lane_now(); const int lane = lane_, g = lane >> 4, c = lane & 15, wid = C.wid;
    LAS float* red = (LAS float*)C.lds;
    const int kw = K / NWAVES;
    for (int unit = C.bid; unit < N / 16; unit += C.G) {
        const unsigned char* ap = A + (size_t)(MAINR + c) * K + wid * kw + 8 * g; const unsigned char* bp = Bt + (size_t)(unit * 16 + c) * K + wid * kw + 8 * g;
        f32x4 acc = (f32x4){0.f, 0.f, 0.f, 0.f};
#pragma unroll
        for (int k0 = 0; k0 < kw; k0 += 128) {
            long af[4], bfr[4];
#pragma unroll
            for (int s = 0; s < 4; ++s) { af[s] = *(const long*)(ap + k0 + 32 * s); bfr[s] = *(const long*)(bp + k0 + 32 * s); }
#pragma unroll
            for (int s = 0; s < 4; ++s) acc = __builtin_amdgcn_mfma_f32_16x16x32_fp8_fp8(af[s], bfr[s], acc, 0, 0, 0);
        }
        *(LAS f32x4*)(red + (wid * 64 + lane) * 4) = acc;
        __syncthreads();
        if (wid == 0) {
            f32x4 t = acc;
#pragma unroll
            for (int w = 1; w < NWAVES; ++w) t = t + *(const LAS f32x4*)(red + (w * 64 + lane) * 4);
#pragma unroll
            for (int r = 0; r < 4; ++r) { float v = t[r] * omul; if (ACT == 2) { v = fmaxf(v, 0.f); v = v * v; }
                if (OUT8) ((unsigned char*)Ov)[(size_t)(MAINR + 4 * g + r) * ldc + unit * 16 + c] = (unsigned char)(pk4_fp8(v * hmul, 0.f, 0.f, 0.f) & 0xffu);
                else ((bf16*)Ov)[(size_t)(MAINR + 4 * g + r) * ldc + unit * 16 + c] = (bf16)f2bf(v); }
        }
        __syncthreads();
    }
}

#define XLAS __attribute__((address_space(3)))
#define XB_TMO      128
#define XB_XCNT(j)  (256  + 64 * (j))
#define XB_XSUB(j)  (1280 + 64 * (j))
#define XB_XGEN(j)  (2304 + 64 * (j))
#define XB_TOP      3328
#define XB_TOPGEN   3392
#define XCD_BAR_WORDS 3456
#define XB_SPIN_CAP (1u << 18)

__device__ __forceinline__ unsigned xb_ld(unsigned* p)              { return __hip_atomic_load(p, __ATOMIC_RELAXED, __HIP_MEMORY_SCOPE_AGENT); }
__device__ __forceinline__ unsigned xb_add(unsigned* p, unsigned v) { return __hip_atomic_fetch_add(p, v, __ATOMIC_RELAXED, __HIP_MEMORY_SCOPE_AGENT); }
__device__ __forceinline__ unsigned xb_xcc_id() { return (unsigned)__builtin_amdgcn_s_getreg((3 << 11) | 20) & 0xFu; }
#define XB_SPIN(cond, bar) do { unsigned _sp = 0; while (cond) { __builtin_amdgcn_s_sleep(1); \
    if ((++_sp & 255u) == 0u) { if (xb_ld(&(bar)[XB_TMO])) break; if (_sp > XB_SPIN_CAP) { atomicAdd(&(bar)[XB_TMO], 1u); break; } } } } while (0)

struct XcdBarrier {
    unsigned* bar; unsigned x;
    int w; bool first;
    volatile XLAS unsigned* st;
};

__device__ __forceinline__ XcdBarrier xcd_barrier_post(unsigned* bar, volatile XLAS unsigned* st, int wid0) {
    XcdBarrier b; b.bar = bar; b.x = xb_xcc_id(); b.st = st; b.w = wid0; b.first = wid0 == 0 && lane_now() == 0;
    if (b.first) (void)xb_add(&bar[XB_XCNT(b.x)], 1u);
    return b;
}
__device__ __forceinline__ void xcd_barrier_complete(unsigned* bar, unsigned x, unsigned& nloc, unsigned& nx) {
    const unsigned G = gridDim.x * gridDim.y * gridDim.z;
    unsigned sum, cnt, mine, sp = 0u;
    for (;;) {
        sum = 0u; cnt = 0u; mine = 0u;
#pragma unroll
        for (unsigned j = 0; j < 16; ++j) { const unsigned c = xb_ld(&bar[XB_XCNT(j)]); sum += c; cnt += (c > 0u) ? 1u : 0u; mine = (j == x) ? c : mine; }
        if (sum == G) break;
        __builtin_amdgcn_s_sleep(1);
        if ((++sp & 255u) == 0u) { if (xb_ld(&bar[XB_TMO])) break; if (sp > XB_SPIN_CAP) { atomicAdd(&bar[XB_TMO], 1u); break; } }
    }
    nloc = mine > 0u ? mine : 1u; nx = cnt > 0u ? cnt : 1u;
}

__device__ __forceinline__ void xcd_barrier(const XcdBarrier& b) {
    asm volatile("s_waitcnt vmcnt(0)" ::: "memory");
    __syncthreads();
    if (b.w == 0 && lane_now() == 0) {
        unsigned* bar = b.bar;
        __builtin_amdgcn_s_waitcnt(0);
        unsigned nloc = b.st[0], nx = b.st[1];
        if (nloc == 0u) { xcd_barrier_complete(bar, b.x, nloc, nx); b.st[0] = nloc; b.st[1] = nx; }
        const unsigned old = xb_add(&bar[XB_XSUB(b.x)], 1u);
        const unsigned gen = old / nloc;
        if (old + 1u == (gen + 1u) * nloc) {
            __builtin_amdgcn_fence(__ATOMIC_RELEASE, "agent");
            asm volatile("s_waitcnt vmcnt(0)" ::: "memory");
            const unsigned og = xb_add(&bar[XB_TOP], 1u);
            const unsigned tg = og / nx;
            if (og + 1u == (tg + 1u) * nx) xb_add(&bar[XB_TOPGEN], 1u);
            else XB_SPIN(xb_ld(&bar[XB_TOPGEN]) == tg, bar);
            __builtin_amdgcn_fence(__ATOMIC_ACQUIRE, "agent");
            xb_add(&bar[XB_XGEN(b.x)], 1u);
            asm volatile("s_waitcnt vmcnt(0)" ::: "memory");
        } else {
            XB_SPIN(xb_ld(&bar[XB_XGEN(b.x)]) == gen, bar);
            __builtin_amdgcn_fence(__ATOMIC_ACQUIRE, "agent");
            asm volatile("s_waitcnt vmcnt(0)" ::: "memory");
        }
    }
    __syncthreads();
}

__global__ void __launch_bounds__(NT, 2) fwd_kernel(Args args) {
    extern __shared__ __attribute__((aligned(16))) unsigned char lds_raw[];
    Ctx C; C.ppass = 0; C.in = args.in; C.out = args.out; C.ws = args.ws; C.lds = (LAS unsigned char*)lds_raw;
    int wid0 = __builtin_amdgcn_readfirstlane(threadIdx.x >> 6); asm volatile("" : "+s"(wid0));
    C.wid = wid0; C.lane = lane_now(); C.tid = wid0 * 64 + C.lane; C.G = gridDim.x; C.bid = blockIdx.x;
    const int lo = args.ph_lo, hi = args.ph_hi;
    int ph = 0;
    volatile XLAS unsigned* bst = (volatile XLAS unsigned*)(C.lds + LDS_BYTES - 64);
    if (C.tid < 2) bst[C.tid] = 0u;
    __syncthreads();
    const XcdBarrier bar = xcd_barrier_post(C.CTL() + 4096, bst, wid0);
#define REPLOOP _Pragma("unroll 1") for (int rep = 0, nrep_ = launder2(); rep < nrep_; ++rep)
#define NOREP for (int rep = 0; rep < 1; ++rep)
#if PROBE == 1 || PROBE == 11 || PROBE == 12
#define REP1 REPLOOP
#else
#define REP1 NOREP
#endif
#if PROBE == 2
#define REP2 REPLOOP
#else
#define REP2 NOREP
#endif
#if PROBE == 3
#define REP3 REPLOOP
#else
#define REP3 NOREP
#endif
#ifndef PHSEL
#define PHSEL 0xffff
#endif
#define PHASE_BEGIN if (ph >= lo && ph < hi) { { const int l_ = lane_now(); C.lane = l_; C.wid = wid0; C.tid = wid0 * 64 + l_; }
#define PHASE_END(last) if (ph + 1 < hi && !(last)) xcd_barrier(bar); } ++ph;

    PHASE_BEGIN if (PHSEL & (1 << 0)) { phase_prologue(C); phase_norm<false, false>(C, C.I(I_X), nullptr, nullptr, nullptr, C.I(I_NMPRE), C.I(I_META)); } PHASE_END(false)
    for (int l = 0; l < NL; ++l) {
        PHASE_BEGIN if (PHSEL & (1 << 2)) { REP3 { pg8::Gemm g{C.U(), (const bf16*)(C.ws + WS_WIN) + (size_t)l * ZC * 1024, MAINR, ZC, 1024}; pg8::StaticOrder S; S.init(MAINR, ZC, C.G, C.bid);
            pg8::EpiBf16<0> E{C.Z(), ZC}; pg8::gemm_phase<pg8::EpiBf16<0>, pg8::StaticOrder, true, true>(C.lds, g, S, E, C.tid); __syncthreads(); } meta_gemm<0>(C, C.U(), (const bf16*)(C.ws + WS_WIN) + (size_t)l * ZC * 1024, 1024, ZC, C.Z(), ZC); } PHASE_END(false)
        PHASE_BEGIN if (PHSEL & (1 << 3)) { REP2 phase_post(C, l, rep == 0); } PHASE_END(false)
        PHASE_BEGIN if (PHSEL & (1 << 4)) { REP1 { C.ppass = rep; phase_prep(C, l, 0); C.ppass = 0; } } PHASE_END(false)
        PHASE_BEGIN if (PHSEL & (1 << 10)) phase_seq(C, l, 0); PHASE_END(true)
        PHASE_BEGIN if (PHSEL & (1 << 4)) { REP1 { C.ppass = rep; phase_prep(C, l, 1); C.ppass = 0; } } PHASE_END(false)
        PHASE_BEGIN if (PHSEL & (1 << 10)) phase_seq(C, l, 1); PHASE_END(false)
        PHASE_BEGIN if (PHSEL & (1 << 5)) { REP3 { pg8::Gemm g{C.U(), (const bf16*)(C.ws + WS_WO) + (size_t)l * 1024 * 1024, MAINR, DM, 1024}; pg8::StaticOrder S; S.init(MAINR, DM, C.G, C.bid);
            pg8::EpiBf16<0> E{C.Z(), DM}; pg8::gemm_phase<pg8::EpiBf16<0>, pg8::StaticOrder, true, true>(C.lds, g, S, E, C.tid); __syncthreads(); } meta_gemm<0>(C, C.U(), (const bf16*)(C.ws + WS_WO) + (size_t)l * 1024 * 1024, 1024, DM, C.Z(), DM); } PHASE_END(false)
        PHASE_BEGIN if (PHSEL & (1 << 6)) { void* hmid = (l + 1 == NL) ? (void*)(C.ws + WS_HMID) : (void*)C.out;
            if (l == 0) phase_norm<false, true>(C, C.I(I_X), hmid, C.Z(), C.I(I_NMPOST) + l * DM, C.I(I_NFPRE) + l * DM, nullptr, true);
            else phase_norm<true, true>(C, C.out, hmid, C.Z(), C.I(I_NMPOST) + l * DM, C.I(I_NFPRE) + l * DM, nullptr, true); } PHASE_END(false)
        PHASE_BEGIN if (PHSEL & (1 << 7)) { REP3 { pg8::Gemm g{(const bf16*)C.U(), (const bf16*)(C.ws + WS_WUP + (size_t)l * FF * 1024), MAINR, FF, 512}; pg8::StaticOrder S; S.init(MAINR, FF, C.G, C.bid);
            pg8::EpiFp8<2> E{C.ws + WS_HID, FF, S8_H}; pg8::gemm_phase<pg8::EpiFp8<2>, pg8::StaticOrder, true, true, true, E8_WU, E8_X>(C.lds, g, S, E, C.tid); __syncthreads(); }
            meta_gemm8<2, true>(C, (const unsigned char*)C.U(), C.ws + WS_WUP + (size_t)l * FF * 1024, 1024, FF, C.ws + WS_HID, FF, 1.f / (S8_X * S8_WU), S8_H); } PHASE_END(false)
        PHASE_BEGIN if (PHSEL & (1 << 8)) { REP3 { pg8::Gemm g{(const bf16*)(C.ws + WS_HID), (const bf16*)(C.ws + WS_WDN + (size_t)l * DM * FF), MAINR, DM, FF / 2}; pg8::StaticOrder S; S.init(MAINR, DM, C.G, C.bid);
            pg8::EpiBf16<0> E{(bf16*)(C.ws + WS_TMP2), DM}; pg8::gemm_phase<pg8::EpiBf16<0>, pg8::StaticOrder, true, true, true, E8_WD, E8_H>(C.lds, g, S, E, C.tid); __syncthreads(); }
            meta_gemm8<0, false>(C, C.ws + WS_HID, C.ws + WS_WDN + (size_t)l * DM * FF, FF, DM, C.ws + WS_TMP2, DM, 1.f / (S8_H * S8_WD), 1.f); } PHASE_END(false)
        PHASE_BEGIN if (PHSEL & (1 << 9)) { if (l + 1 < NL) phase_norm<true, true>(C, C.out, C.out, (const bf16*)(C.ws + WS_TMP2), C.I(I_NFPOST) + l * DM, C.I(I_NMPRE) + (l + 1) * DM);
            else phase_norm<true, false>(C, C.ws + WS_HMID, C.out, (const bf16*)(C.ws + WS_TMP2), C.I(I_NFPOST) + l * DM, nullptr); } PHASE_END(l + 1 == NL)
    }
}

extern "C" void kernel_launch(void* const* d_in, const int* in_sizes, int n_in, void* d_out, int out_size, void* d_ws, size_t ws_size, hipStream_t stream) {
    static int grid = 0;
    if (grid == 0) {
        if (n_in != 30 || out_size != NB * SEQ * DM || ws_size < WS_END) { fprintf(stderr, "kernel_launch: unexpected shapes (n_in %d out %d ws %zu need %zu)\n", n_in, out_size, ws_size, (size_t)WS_END); grid = -1; return; }
        int dev = 0, cus = 0, per_cu = 0;
        (void)hipGetDevice(&dev); (void)hipDeviceGetAttribute(&cus, hipDeviceAttributeMultiprocessorCount, dev);
        (void)hipFuncSetAttribute((const void*)fwd_kernel, hipFuncAttributeMaxDynamicSharedMemorySize, LDS_BYTES);
        (void)hipOccupancyMaxActiveBlocksPerMultiprocessor(&per_cu, (const void*)fwd_kernel, NT, LDS_BYTES);
        (void)hipGetLastError();
        grid = cus;
        fprintf(stderr, "kernel_launch: cus %d per_cu %d ws %zu\n", cus, per_cu, ws_size);
    }
    if (grid < 0) return;
    (void)hipMemsetAsync((char*)d_ws + WS_CTL, 0, CTL_BYTES, stream);
    Args a{};
    for (int i = 0; i < 30; ++i) a.in[i] = (const float*)d_in[i];
    a.out = (float*)d_out; a.ws = (unsigned char*)d_ws;
    a.ph_lo = 0; a.ph_hi = 1000;
    void* kargs[] = {&a};
    hipError_t e = hipLaunchCooperativeKernel((const void*)fwd_kernel, dim3(grid), dim3(NT), kargs, LDS_BYTES, stream);
    if (e != hipSuccess) fprintf(stderr, "kernel_launch: cooperative launch failed: %s\n", hipGetErrorString(e));
}
```
